# Optimizing an MI355X kernel written in HIP

```python
import math
import jax, jax.numpy as jnp
from jax import lax
import numpy as np

D_MODEL = 2048
BATCH = 2
SEQ = 4096
DEPTH = 1

HEAD_DIM = 128
D_MIX = D_MODEL
FOX_HEADS = 8
NSA_HEADS = 8
NSA_KV_HEADS = 2
NSA_GROUP = NSA_HEADS // NSA_KV_HEADS
CMP_LEN = 32
CMP_STRIDE = 16
CMP_HIDDEN = 2 * HEAD_DIM
SLC_LEN = 64
SLC_TOPK = 16
WINDOW = 512
Q_BLOCK = 128
D_FF = ((8 * D_MODEL // 3 + 255) // 256) * 256
ROPE_THETA = 10000.0
NORM_EPS = 1e-6
MASK_VALUE = -1e30
SEL_BONUS = 1e6
D_IN = (3 * FOX_HEADS * HEAD_DIM + FOX_HEADS + NSA_HEADS * HEAD_DIM
        + 6 * NSA_KV_HEADS * HEAD_DIM + 3 * NSA_HEADS)

kernel_name = "hymba_fox_nsa_adaln_block"


def _rmsnorm(x, g):
    xf = x.astype(jnp.float32)
    y = xf * lax.rsqrt(jnp.mean(xf * xf, axis=-1, keepdims=True) + NORM_EPS)
    return y.astype(x.dtype) * g


def _modulate(h, shift, scale):
    return h * (1 + scale[:, None, :]) + shift[:, None, :]


def _rope(x, pos):
    d = x.shape[-1]
    inv_freq = ROPE_THETA ** (-jnp.arange(0, d, 2, dtype=jnp.float32) / d)
    ang = pos.astype(jnp.float32)[..., None] * inv_freq
    cos = jnp.cos(ang)[:, :, None, :].astype(x.dtype)
    sin = jnp.sin(ang)[:, :, None, :].astype(x.dtype)
    x1, x2 = jnp.split(x, 2, axis=-1)
    return jnp.concatenate([x1 * cos - x2 * sin, x2 * cos + x1 * sin], axis=-1)


def _masked_softmax(s, mask):
    s = jnp.where(mask, s.astype(jnp.float32), MASK_VALUE)
    m = jnp.max(s, axis=-1, keepdims=True)
    e = jnp.where(mask, jnp.exp(s - m), 0.0)
    return e / jnp.maximum(jnp.sum(e, axis=-1, keepdims=True), 1e-30)


def _split_points():
    sizes = ([FOX_HEADS * HEAD_DIM] * 3 + [FOX_HEADS] + [NSA_HEADS * HEAD_DIM]
             + [NSA_KV_HEADS * HEAD_DIM] * 6 + [3 * NSA_HEADS])
    points, acc = [], 0
    for s in sizes[:-1]:
        acc += s
        points.append(acc)
    return points


def _fox_attention(q, k, v, log_f):
    B, S, H, D = q.shape
    cum = jnp.cumsum(log_f, axis=1).transpose(0, 2, 1)
    kpos = jnp.arange(S)
    scale = D ** -0.5

    def block(i):
        start = i * Q_BLOCK
        qb = lax.dynamic_slice_in_dim(q, start, Q_BLOCK, axis=1)
        cb = lax.dynamic_slice_in_dim(cum, start, Q_BLOCK, axis=2)
        qpos = start + jnp.arange(Q_BLOCK)
        s = jnp.einsum('bqhd,bkhd->bhqk', qb, k).astype(jnp.float32) * scale
        s = s + (cb[..., :, None] - cum[..., None, :])
        mask = (kpos[None, :] <= qpos[:, None])[None, None]
        p = _masked_softmax(s, mask)
        return jnp.einsum('bhqk,bkhd->bqhd', p.astype(v.dtype), v)

    out = lax.map(block, jnp.arange(S // Q_BLOCK))
    return out.transpose(1, 0, 2, 3, 4).reshape(B, S, H, D)


def _compress(x, cmp_pos, w1, w2, idx):
    B, _, G, D = x.shape
    blk = x[:, idx] + cmp_pos[None, None, :, None, :]
    blk = blk.transpose(0, 1, 3, 2, 4).reshape(B, idx.shape[0], G, CMP_LEN * D)
    return jax.nn.gelu(blk @ w1) @ w2


def _nsa_attention(q, k_c, v_c, k_s, v_s, k_w, v_w, gates, positions,
                   cmp_pos, w_kc1, w_kc2, w_vc1, w_vc2):
    B, S, H, D = q.shape
    G, R = NSA_KV_HEADS, NSA_GROUP
    scale = D ** -0.5
    q = _rope(q, positions)
    k_s = _rope(k_s, positions)
    k_w = _rope(k_w, positions)

    n_cmp = (S - CMP_LEN) // CMP_STRIDE + 1
    cmp_idx = jnp.arange(n_cmp)[:, None] * CMP_STRIDE + jnp.arange(CMP_LEN)[None, :]
    cmp_end = cmp_idx[:, -1]
    kc = _rope(_compress(k_c, cmp_pos, w_kc1, w_kc2, cmp_idx), positions[:, cmp_end])
    vc = _compress(v_c, cmp_pos, w_vc1, w_vc2, cmp_idx)

    n_slc = S // SLC_LEN
    n_sel = min(SLC_TOPK, n_slc)
    cs = jnp.arange(n_cmp) * CMP_STRIDE
    ss = jnp.arange(n_slc) * SLC_LEN
    ov = (jnp.minimum(cs[:, None] + CMP_LEN, ss[None, :] + SLC_LEN)
          - jnp.maximum(cs[:, None], ss[None, :]))
    overlap = jnp.clip(ov, 0).astype(jnp.float32) / CMP_STRIDE

    k_sb = k_s.reshape(B, n_slc, SLC_LEN, G, D).transpose(0, 3, 1, 2, 4)
    v_sb = v_s.reshape(B, n_slc, SLC_LEN, G, D).transpose(0, 3, 1, 2, 4)
    pad = ((0, 0), (WINDOW, 0), (0, 0), (0, 0))
    k_wp = jnp.pad(k_w, pad)
    v_wp = jnp.pad(v_w, pad)
    q_g = q.reshape(B, S, G, R, D)
    gates_g = gates.reshape(B, S, G, R, 3)
    b_idx = jnp.arange(B)[:, None, None, None]
    g_idx = jnp.arange(G)[None, :, None, None]
    blk_ids = jnp.arange(n_slc)

    def block(i):
        start = i * Q_BLOCK
        qb = lax.dynamic_slice_in_dim(q_g, start, Q_BLOCK, axis=1)
        qpos = start + jnp.arange(Q_BLOCK)

        s_c = jnp.einsum('bqgrd,bcgd->bgrqc', qb, kc) * scale
        mask_c = (cmp_end[None, :] <= qpos[:, None])[None, None, None]
        p_c = _masked_softmax(s_c, mask_c)
        o_c = jnp.einsum('bgrqc,bcgd->bqgrd', p_c.astype(vc.dtype), vc)

        imp = jnp.einsum('bgrqc,cn->bgqn', p_c, overlap)
        cur = qpos // SLC_LEN
        forced = ((blk_ids[None, :] == 0) | (blk_ids[None, :] == cur[:, None])
                  | (blk_ids[None, :] == cur[:, None] - 1))
        causal_blk = blk_ids[None, :] <= cur[:, None]
        score = jnp.where(forced[None, None], SEL_BONUS, imp)
        score = jnp.where(causal_blk[None, None], score, -SEL_BONUS)
        _, sel = lax.top_k(score, n_sel)
        ks_sel = k_sb[b_idx, g_idx, sel].reshape(B, G, Q_BLOCK, n_sel * SLC_LEN, D)
        vs_sel = v_sb[b_idx, g_idx, sel].reshape(B, G, Q_BLOCK, n_sel * SLC_LEN, D)
        tok = (sel[..., None] * SLC_LEN + jnp.arange(SLC_LEN)).reshape(B, G, Q_BLOCK, -1)
        mask_s = (tok <= qpos[None, None, :, None])[:, :, None]
        s_s = jnp.einsum('bqgrd,bgqnd->bgrqn', qb, ks_sel) * scale
        p_s = _masked_softmax(s_s, mask_s)
        o_s = jnp.einsum('bgrqn,bgqnd->bqgrd', p_s.astype(vs_sel.dtype), vs_sel)

        kw = lax.dynamic_slice_in_dim(k_wp, start, Q_BLOCK + WINDOW, axis=1)
        vw = lax.dynamic_slice_in_dim(v_wp, start, Q_BLOCK + WINDOW, axis=1)
        kpos = start - WINDOW + jnp.arange(Q_BLOCK + WINDOW)
        mask_w = ((kpos[None, :] <= qpos[:, None]) & (qpos[:, None] - kpos[None, :] < WINDOW)
                  & (kpos[None, :] >= 0))[None, None, None]
        s_w = jnp.einsum('bqgrd,bkgd->bgrqk', qb, kw) * scale
        p_w = _masked_softmax(s_w, mask_w)
        o_w = jnp.einsum('bgrqk,bkgd->bqgrd', p_w.astype(vw.dtype), vw)

        gb = lax.dynamic_slice_in_dim(gates_g, start, Q_BLOCK, axis=1)
        o = gb[..., 0:1] * o_c + gb[..., 1:2] * o_s + gb[..., 2:3] * o_w
        return o.reshape(B, Q_BLOCK, H, D)

    out = lax.map(block, jnp.arange(S // Q_BLOCK))
    return out.transpose(1, 0, 2, 3, 4).reshape(B, S, H, D)


def _hybrid_mixer(u, positions, w_in, b_fgate, cmp_pos, w_kc1, w_kc2, w_vc1, w_vc2,
                  beta_fox, beta_nsa, w_out):
    B, S, _ = u.shape
    z = u @ w_in
    (q_f, k_f, v_f, f_logit, q_n, k_c, v_c, k_s, v_s, k_w, v_w, g_n) = jnp.split(
        z, _split_points(), axis=-1)
    fh = lambda t: t.reshape(B, S, FOX_HEADS, HEAD_DIM)
    nq = lambda t: t.reshape(B, S, NSA_HEADS, HEAD_DIM)
    nkv = lambda t: t.reshape(B, S, NSA_KV_HEADS, HEAD_DIM)
    log_f = jax.nn.log_sigmoid((f_logit + b_fgate).astype(jnp.float32))
    o_f = _fox_attention(fh(q_f), fh(k_f), fh(v_f), log_f)
    gates = jax.nn.sigmoid(g_n.reshape(B, S, NSA_HEADS, 3))
    o_n = _nsa_attention(nq(q_n), nkv(k_c), nkv(v_c), nkv(k_s), nkv(v_s), nkv(k_w), nkv(v_w),
                         gates, positions, cmp_pos, w_kc1, w_kc2, w_vc1, w_vc2)
    y_f = _rmsnorm(o_f.reshape(B, S, FOX_HEADS * HEAD_DIM), beta_fox)
    y_n = _rmsnorm(o_n.reshape(B, S, NSA_HEADS * HEAD_DIM), beta_nsa)
    return jnp.concatenate([y_f, y_n], axis=-1) @ w_out


def _swiglu(u, w_gate, w_up, w_down):
    return (jax.nn.silu(u @ w_gate) * (u @ w_up)) @ w_down


def setup_inputs(seed: int = 0) -> dict:
    key = jax.random.key(seed)
    ks = jax.random.split(key, 24)
    f32 = jnp.float32
    nrm = lambda k, shape, s: jax.random.normal(k, shape, f32) * s
    L = DEPTH
    x = jax.random.normal(ks[0], (BATCH, SEQ, D_MODEL), f32)
    c = jax.random.normal(ks[1], (BATCH, D_MODEL), f32)
    offset = jax.random.randint(ks[2], (BATCH, 1), 0, 1024, dtype=jnp.int32)
    positions = offset + jnp.arange(SEQ, dtype=jnp.int32)[None, :]
    return {
        "x": x,
        "c": c,
        "positions": positions,
        "w_ada": nrm(ks[3], (L, D_MODEL, 6 * D_MODEL), 0.5 * D_MODEL ** -0.5),
        "b_ada": nrm(ks[4], (L, 6 * D_MODEL), 0.02),
        "norm_attn": 1.0 + nrm(ks[5], (L, D_MODEL), 0.02),
        "norm_ffn": 1.0 + nrm(ks[6], (L, D_MODEL), 0.02),
        "w_in": nrm(ks[7], (L, D_MODEL, D_IN), D_MODEL ** -0.5),
        "b_fgate": 2.0 + nrm(ks[8], (L, FOX_HEADS), 0.5),
        "cmp_pos": nrm(ks[9], (L, CMP_LEN, HEAD_DIM), 0.02),
        "w_kc1": nrm(ks[10], (L, CMP_LEN * HEAD_DIM, CMP_HIDDEN), (CMP_LEN * HEAD_DIM) ** -0.5),
        "w_kc2": nrm(ks[11], (L, CMP_HIDDEN, HEAD_DIM), CMP_HIDDEN ** -0.5),
        "w_vc1": nrm(ks[12], (L, CMP_LEN * HEAD_DIM, CMP_HIDDEN), (CMP_LEN * HEAD_DIM) ** -0.5),
        "w_vc2": nrm(ks[13], (L, CMP_HIDDEN, HEAD_DIM), CMP_HIDDEN ** -0.5),
        "beta_fox": 1.0 + nrm(ks[14], (L, FOX_HEADS * HEAD_DIM), 0.02),
        "beta_nsa": 1.0 + nrm(ks[15], (L, NSA_HEADS * HEAD_DIM), 0.02),
        "w_out": nrm(ks[16], (L, D_MIX, D_MODEL), D_MIX ** -0.5),
        "w_gate": nrm(ks[17], (L, D_MODEL, D_FF), D_MODEL ** -0.5),
        "w_up": nrm(ks[18], (L, D_MODEL, D_FF), D_MODEL ** -0.5),
        "w_down": nrm(ks[19], (L, D_FF, D_MODEL), D_FF ** -0.5),
        "final_norm": 1.0 + nrm(ks[20], (D_MODEL,), 0.02),
    }


def reference(x, c, positions, w_ada, b_ada, norm_attn, norm_ffn, w_in, b_fgate, cmp_pos,
              w_kc1, w_kc2, w_vc1, w_vc2, beta_fox, beta_nsa, w_out, w_gate, w_up, w_down,
              final_norm):
    h = x
    for l in range(DEPTH):
        mod = jax.nn.silu(c) @ w_ada[l] + b_ada[l]
        sh1, sc1, g1, sh2, sc2, g2 = jnp.split(mod, 6, axis=-1)
        u = _modulate(_rmsnorm(h, norm_attn[l]), sh1, sc1)
        y = _hybrid_mixer(u, positions, w_in[l], b_fgate[l], cmp_pos[l], w_kc1[l], w_kc2[l],
                          w_vc1[l], w_vc2[l], beta_fox[l], beta_nsa[l], w_out[l])
        h = h + g1[:, None, :] * y
        u = _modulate(_rmsnorm(h, norm_ffn[l]), sh2, sc2)
        h = h + g2[:, None, :] * _swiglu(u, w_gate[l], w_up[l], w_down[l])
    return _rmsnorm(h, final_norm)
```

```cpp
#include <hip/hip_runtime.h>
#include <hip/hip_cooperative_groups.h>
#include <stdint.h>
#include <cstdio>
namespace cg = cooperative_groups;

#define DI __device__ __forceinline__
typedef unsigned short bf16_t;
typedef short bf16x8 __attribute__((ext_vector_type(8)));
typedef short s16x4 __attribute__((ext_vector_type(4)));
typedef float f32x4 __attribute__((ext_vector_type(4)));
typedef float f32x16 __attribute__((ext_vector_type(16)));
typedef unsigned u32x2 __attribute__((ext_vector_type(2)));
typedef unsigned u32x4 __attribute__((ext_vector_type(4)));

#ifndef DRY_MODE
#define DRY_MODE 0
#endif
#ifndef ATTN_PREFETCH
#define ATTN_PREFETCH 0
#endif
#ifndef N_LAUNCH_MODE
#define N_LAUNCH_MODE 1
#endif

constexpr int T_TOK = 8192, SEQ = 4096, DM = 2048, DFF = 5632, DIN = 5664;
constexpr int NPH = 13;
constexpr float LOG2E = 1.4426950408889634f;
constexpr float QK_C1 = 0.08838834764831845f * 1.4426950408889634f;

constexpr size_t al256(size_t x) { return (x + 255) & ~(size_t)255; }
constexpr size_t OFF_WIN_HI = 0;
constexpr size_t OFF_WIN_LO = OFF_WIN_HI + al256((size_t)5888 * 2048 * 2);
constexpr size_t OFF_WOUT = OFF_WIN_LO + al256((size_t)1280 * 2048 * 2);
constexpr size_t OFF_WGU = OFF_WOUT + al256((size_t)2048 * 2048 * 2);
constexpr size_t OFF_WDN = OFF_WGU + al256((size_t)11264 * 2048 * 2);
constexpr size_t OFF_W1K_HI = OFF_WDN + al256((size_t)2048 * 5632 * 2);
constexpr size_t OFF_W1K_LO = OFF_W1K_HI + al256((size_t)256 * 4096 * 2);
constexpr size_t OFF_W1V = OFF_W1K_LO + al256((size_t)256 * 4096 * 2);
constexpr size_t OFF_MOD = OFF_W1V + al256((size_t)256 * 4096 * 2);
constexpr size_t OFF_COS = OFF_MOD + al256((size_t)2 * 12288 * 4);
constexpr size_t OFF_SIN = OFF_COS + al256((size_t)8192 * 64 * 4);
constexpr size_t OFF_BIAS1 = OFF_SIN + al256((size_t)8192 * 64 * 4);
constexpr size_t OFF_U_HI = OFF_BIAS1 + al256((size_t)2 * 16 * 256 * 4);
constexpr size_t OFF_LOGF = OFF_U_HI + al256((size_t)8192 * 2048 * 2);
constexpr size_t OFF_CUM = OFF_LOGF + al256((size_t)8192 * 8 * 4);
constexpr size_t OFF_GATES = OFF_CUM + al256((size_t)16 * 4096 * 4);
constexpr size_t KCIN_BYTES = al256((size_t)(4 * 4096 + 64) * 128 * 2);
constexpr size_t OFF_KCIN_HI = OFF_GATES + al256((size_t)8192 * 24 * 4);
constexpr size_t OFF_KCIN_LO = OFF_KCIN_HI + KCIN_BYTES;
constexpr size_t OFF_VCIN = OFF_KCIN_LO + KCIN_BYTES;
constexpr size_t KV4_BYTES = (size_t)4 * 4096 * 128 * 2;
constexpr size_t OFF_KS = OFF_VCIN + KCIN_BYTES;
constexpr size_t OFF_VST = OFF_KS + KV4_BYTES;
constexpr size_t OFF_KW = OFF_VST + KV4_BYTES;
constexpr size_t OFF_VWT = OFF_KW + KV4_BYTES;
constexpr size_t OFF_H1P_K = OFF_VWT + KV4_BYTES;
constexpr size_t OFF_H1P_V = OFF_H1P_K + (size_t)16 * 1024 * 256 * 4;
constexpr size_t OFF_KC_HI = OFF_H1P_V + (size_t)8 * 1024 * 256 * 4;
constexpr size_t OFF_KC_LO = OFF_KC_HI + (size_t)4 * 256 * 128 * 2;
constexpr size_t OFF_VCT = OFF_KC_LO + (size_t)4 * 256 * 128 * 2;
constexpr size_t OFF_SEL = OFF_VCT + (size_t)4 * 256 * 128 * 2;
constexpr size_t OFF_OF32 = OFF_SEL + (size_t)4 * 4096 * 8;
constexpr size_t OFF_ON32 = OFF_OF32 + (size_t)8192 * 1024 * 4;
constexpr size_t OFF_H1 = OFF_OF32;
constexpr size_t OFF_RA = OFF_ON32 + (size_t)8192 * 1024 * 4;
constexpr size_t OFF_U_LO = OFF_RA;
constexpr size_t OFF_QF = OFF_U_LO + (size_t)8192 * 2048 * 2;
constexpr size_t OFF_KF = OFF_QF + (size_t)8192 * 1024 * 2;
constexpr size_t OFF_VFT = OFF_KF + (size_t)8192 * 1024 * 2;
constexpr size_t OFF_QN_HI = OFF_VFT + (size_t)8192 * 1024 * 2;
constexpr size_t OFF_QN_LO = OFF_QN_HI + (size_t)8192 * 1024 * 2;
constexpr size_t OFF_ACT = OFF_RA;
constexpr size_t OFF_KNORM = OFF_QN_LO + (size_t)8192 * 1024 * 2;
constexpr size_t OFF_BAR = OFF_KNORM + 8192;
constexpr size_t WS_END = OFF_BAR + 16384;

struct Params {
  const float *x, *c; const int* pos;
  const float *w_ada, *b_ada, *norm_attn, *norm_ffn, *w_in, *b_fgate, *cmp_pos, *w_kc1, *w_kc2, *w_vc1, *w_vc2,
      *beta_fox, *beta_nsa, *w_out, *w_gate, *w_up, *w_down, *final_norm;
  float* out; char* ws;
};

extern __shared__ __attribute__((aligned(16))) char g_smem[];
constexpr int LDS_BYTES = 143360;

__device__ const float c_inv_freq[64] = {
1.000000000e+00f,8.659643531e-01f,7.498942614e-01f,6.493816376e-01f,5.623413324e-01f,4.869675338e-01f,4.216965139e-01f,3.651741147e-01f,3.162277639e-01f,2.738419771e-01f,2.371373773e-01f,2.053525001e-01f,1.778279394e-01f,1.539926529e-01f,1.333521307e-01f,1.154782027e-01f,1.000000015e-01f,8.659642935e-02f,7.498941571e-02f,6.493816525e-02f,5.623413250e-02f,4.869675264e-02f,4.216965288e-02f,3.651741147e-02f,3.162277490e-02f,2.738419734e-02f,2.371373773e-02f,2.053525113e-02f,1.778279431e-02f,1.539926510e-02f,1.333521493e-02f,1.154782064e-02f,9.999999776e-03f,8.659643121e-03f,7.498941850e-03f,6.493816152e-03f,5.623413250e-03f,4.869675264e-03f,4.216964822e-03f,3.651741194e-03f,3.162277630e-03f,2.738419687e-03f,2.371373586e-03f,2.053524833e-03f,1.778279431e-03f,1.539926510e-03f,1.333521446e-03f,1.154781901e-03f,1.000000047e-03f,8.659643354e-04f,7.498942432e-04f,6.493816618e-04f,5.623413017e-04f,4.869675322e-04f,4.216965172e-04f,3.651741426e-04f,3.162277571e-04f,2.738419571e-04f,2.371373703e-04f,2.053525095e-04f,1.778279402e-04f,1.539926452e-04f,1.333521504e-04f,1.154782003e-04f};

DI unsigned short f2bf(float x) { unsigned u = __float_as_uint(x); u += 0x7fffu + ((u >> 16) & 1u); return (unsigned short)(u >> 16); }
DI float bf2f(unsigned short h) { return __uint_as_float(((unsigned)h) << 16); }
typedef float f32x2 __attribute__((ext_vector_type(2)));
typedef __bf16 bf16v2 __attribute__((ext_vector_type(2)));
DI unsigned pack2(float a, float b) { const f32x2 v = {a, b}; return __builtin_bit_cast(unsigned, __builtin_convertvector(v, bf16v2)); }
DI void split2(float a, float b, unsigned& hi, unsigned& lo) {
  hi = pack2(a, b);
  lo = pack2(a - __uint_as_float(hi << 16), b - __uint_as_float(hi & 0xffff0000u));
}
DI float lo_of(float x) { return x - bf2f(f2bf(x)); }
DI float wave_sum(float v) {
#pragma unroll
  for (int o = 32; o > 0; o >>= 1) v += __shfl_xor(v, o);
  return v;
}
DI float xmax32(float v) { auto r = __builtin_amdgcn_permlane32_swap(__float_as_uint(v), __float_as_uint(v), false, false); return fmaxf(__uint_as_float(r[0]), __uint_as_float(r[1])); }
DI float xsum32(float v) { auto r = __builtin_amdgcn_permlane32_swap(__float_as_uint(v), __float_as_uint(v), false, false); return __uint_as_float(r[0]) + __uint_as_float(r[1]); }
DI float fexp2(float x) { return __builtin_amdgcn_exp2f(x); }
DI float sigmoidf_(float x) { return 1.f / (1.f + __expf(-x)); }
DI float siluf_(float x) { return x / (1.f + __expf(-x)); }
DI float silu_fast(float x) { return x * __builtin_amdgcn_rcpf(1.f + __builtin_amdgcn_exp2f(-LOG2E * x)); }
DI float gelu_tanh(float x) { float u = 0.7978845608028654f * (x + 0.044715f * x * x * x); float e = __expf(2.f * u); float t = 1.f - 2.f / (e + 1.f); return 0.5f * x * (1.f + t); }
DI float log_sigmoid(float x) { return fminf(x, 0.f) - log1pf(__expf(-fabsf(x))); }
DI f32x16 mfma32(bf16x8 a, bf16x8 b, f32x16 c) { return __builtin_amdgcn_mfma_f32_32x32x16_bf16(a, b, c, 0, 0, 0); }
DI f32x16 zero16() { f32x16 z;
#pragma unroll
  for (int i = 0; i < 16; ++i) z[i] = 0.f; return z; }
DI int perm_gu(int w) { const int r = w & 31; return (w & 96) + ((r >> 2) & 1) * 16 + (r >> 3) * 4 + (r & 3); }
DI int perm128(int d) { return ((d >> 4) & 3) * 32 + (d >> 6) * 16 + (d & 15); }

#define FOR_JOBS(job, njobs) \
  for (int _r = 0, job; _r * (int)gridDim.x < (njobs); ++_r) \
    if ((job = _r * (int)gridDim.x + ((_r & 1) ? ((int)gridDim.x - 1 - (int)blockIdx.x) : (int)blockIdx.x)) < (njobs))

constexpr int BM = 256, BK = 64, HALF = 128, HTB = HALF * BK * 2;
DI int lds_byte(int r, int c) { int st = (r >> 4) * 2 + (c >> 5), rr = r & 15, cc = c & 31, ob = rr * 64 + cc * 2; return st * 1024 + (ob ^ (((ob >> 9) & 1) << 5)); }
DI void stage_rc(int b, int& R, int& C) { int st = b / 1024, sb = b % 1024, swz = sb ^ (((sb >> 9) & 1) << 5); R = (st >> 1) * 16 + swz / 64; C = (st & 1) * 32 + (swz % 64) / 2; }

DI const char* uptr(const char* p) {
  const unsigned long long v = (unsigned long long)p;
  const unsigned lo = __builtin_amdgcn_readfirstlane((unsigned)v), hi = __builtin_amdgcn_readfirstlane((unsigned)(v >> 32));
  return (const char*)(((unsigned long long)hi << 32) | lo);
}
struct GemmOp { const bf16_t *A0, *A1, *A2, *B0, *B1, *B2; int lda, ldb, nt, shift; };

template <class Epi>
DI void gemm_tile(const GemmOp& g, int brow, int bcol, const Epi& epi) {
#define SA(b, h) (g_smem + ((b) * 2 + (h)) * HTB)
#define SB(b, h) (g_smem + (4 + (b) * 2 + (h)) * HTB)
  int tid = threadIdx.x; asm volatile("" : "+v"(tid));
  const int wid = tid >> 6, lane = tid & 63, wr = wid >> 2, wc = wid & 3, fr = lane & 15, fq = lane >> 4;
  int r0, c0, r1, c1; stage_rc(tid * 16, r0, c0); stage_rc(tid * 16 + 8192, r1, c1);
  const unsigned oa0 = (unsigned)(r0 * g.lda + c0) * 2u, oa1 = (unsigned)(r1 * g.lda + c1) * 2u, ob0 = (unsigned)(r0 * g.ldb + c0) * 2u, ob1 = (unsigned)(r1 * g.ldb + c1) * 2u;
  const int mask = (1 << g.shift) - 1;
#define STAGE_A(P, half, kt) do { const int _s = (kt) >> g.shift; const char* _b = uptr((const char*)((_s == 0 ? g.A0 : (_s == 1 ? g.A1 : g.A2)) + (size_t)(brow + (half) * HALF) * g.lda + (size_t)((kt) & mask) * BK)); \
    __builtin_amdgcn_global_load_lds((const unsigned*)(_b + oa0), (unsigned*)((P) + tid * 16), 16, 0, 0); \
    __builtin_amdgcn_global_load_lds((const unsigned*)(_b + oa1), (unsigned*)((P) + tid * 16 + 8192), 16, 0, 0); } while (0)
#define STAGE_B(P, half, kt) do { const int _s = (kt) >> g.shift; const char* _b = uptr((const char*)((_s == 0 ? g.B0 : (_s == 1 ? g.B1 : g.B2)) + (size_t)(bcol + (half) * HALF) * g.ldb + (size_t)((kt) & mask) * BK)); \
    __builtin_amdgcn_global_load_lds((const unsigned*)(_b + ob0), (unsigned*)((P) + tid * 16), 16, 0, 0); \
    __builtin_amdgcn_global_load_lds((const unsigned*)(_b + ob1), (unsigned*)((P) + tid * 16 + 8192), 16, 0, 0); } while (0)
#define LDA(dst, b, h) for (int m = 0; m < 4; ++m) for (int k = 0; k < 2; ++k) \
    dst[m][k] = *reinterpret_cast<const bf16x8*>(SA(b, h) + lds_byte(wr * 64 + m * 16 + fr, k * 32 + fq * 8))
#define LDB(dst, b, h) for (int n = 0; n < 2; ++n) for (int k = 0; k < 2; ++k) \
    dst[n][k] = *reinterpret_cast<const bf16x8*>(SB(b, h) + lds_byte(wc * 32 + n * 16 + fr, k * 32 + fq * 8))
#define MMA(ai, bj, At_, Bt_) do { __builtin_amdgcn_s_setprio(1); \
    for (int m = 0; m < 4; ++m) for (int n = 0; n < 2; ++n) for (int k = 0; k < 2; ++k) \
      acc[ai][bj][m][n] = __builtin_amdgcn_mfma_f32_16x16x32_bf16(Bt_[n][k], At_[m][k], acc[ai][bj][m][n], 0, 0, 0); \
    __builtin_amdgcn_s_setprio(0); } while (0)
#define WAIT_V(n) asm volatile("s_waitcnt vmcnt(" #n ")" ::: "memory")
#define WAIT_L(n) asm volatile("s_waitcnt lgkmcnt(" #n ")" ::: "memory")
#define BAR __builtin_amdgcn_s_barrier()
#define SCHED __builtin_amdgcn_sched_barrier(0)
  f32x4 acc[2][2][4][2] = {};
  bf16x8 At[4][2], B0[2][2], B1[2][2];
  const int nt = g.nt;
  STAGE_B(SB(0, 0), 0, 0); STAGE_A(SA(0, 0), 0, 0);
  STAGE_B(SB(0, 1), 1, 0); STAGE_A(SA(0, 1), 1, 0);
  if (wr == 1) BAR;
  WAIT_V(4); BAR;
  STAGE_B(SB(1, 0), 0, 1); STAGE_A(SA(1, 0), 0, 1); STAGE_B(SB(1, 1), 1, 1);
  WAIT_V(6); BAR;
  for (int t = 0; t < nt - 2; t += 2) {
    LDB(B0, 0, 0); SCHED; LDA(At, 0, 0); STAGE_A(SA(1, 1), 1, t + 1);
    WAIT_L(8); BAR; WAIT_L(0); MMA(0, 0, At, B0); BAR; SCHED;
    LDB(B1, 0, 1); STAGE_B(SB(0, 0), 0, t + 2);
    BAR; WAIT_L(0); MMA(0, 1, At, B1); BAR;
    LDA(At, 0, 1); STAGE_A(SA(0, 0), 0, t + 2);
    BAR; WAIT_L(0); MMA(1, 0, At, B0); BAR; SCHED;
    STAGE_B(SB(0, 1), 1, t + 2);
    WAIT_V(6); BAR; MMA(1, 1, At, B1); BAR;
    LDB(B0, 1, 0); SCHED; LDA(At, 1, 0); STAGE_A(SA(0, 1), 1, t + 2);
    WAIT_L(8); BAR; WAIT_L(0); MMA(0, 0, At, B0); BAR; SCHED;
    LDB(B1, 1, 1); STAGE_B(SB(1, 0), 0, t + 3);
    BAR; WAIT_L(0); MMA(0, 1, At, B1); BAR;
    LDA(At, 1, 1); STAGE_A(SA(1, 0), 0, t + 3);
    BAR; WAIT_L(0); MMA(1, 0, At, B0); BAR; SCHED;
    STAGE_B(SB(1, 1), 1, t + 3);
    WAIT_V(6); BAR; MMA(1, 1, At, B1); BAR;
  }
  { LDB(B0, 0, 0); LDA(At, 0, 0); STAGE_A(SA(1, 1), 1, nt - 1);
    BAR; WAIT_L(0); MMA(0, 0, At, B0); BAR;
    LDB(B1, 0, 1); BAR; WAIT_L(0); MMA(0, 1, At, B1); BAR;
    LDA(At, 0, 1); WAIT_V(4); BAR; WAIT_L(0); MMA(1, 0, At, B0); MMA(1, 1, At, B1); BAR; }
  { LDB(B0, 1, 0); LDA(At, 1, 0); WAIT_V(2); BAR; WAIT_L(0); MMA(0, 0, At, B0); BAR;
    LDB(B1, 1, 1); WAIT_V(0); BAR; WAIT_L(0); MMA(0, 1, At, B1); BAR;
    LDA(At, 1, 1); BAR; WAIT_L(0); MMA(1, 0, At, B0); MMA(1, 1, At, B1); BAR; }
  if (wr == 0) BAR;
  { int t2 = tid; asm volatile("" : "+v"(t2)); const int w2 = t2 >> 6, l2 = t2 & 63; epi(acc, brow, bcol, w2 >> 2, w2 & 3, l2 & 15, l2 >> 4); }
  __syncthreads();
#undef SA
#undef SB
}

typedef f32x4 AccT[2][2][4][2];

struct EpiInproj {
  const Params* p; int pn;
  DI void operator()(const AccT& acc, int brow, int bcol, int wr, int wc, int fr, int fq) const {
    char* ws = p->ws;
    const float* cs = (const float*)(ws + OFF_COS); const float* sn = (const float*)(ws + OFF_SIN);
#pragma unroll
    for (int ai = 0; ai < 2; ++ai)
#pragma unroll
      for (int m = 0; m < 4; ++m) {
        const int token = brow + ai * 128 + wr * 64 + m * 16 + fr;
        const int b = token >> 12, s = token & 4095;
        const int d0 = wc * 16 + fq * 4;
#pragma unroll
        for (int bj = 0; bj < 2; ++bj) {
          f32x4 v0 = acc[ai][bj][m][0], v1 = acc[ai][bj][m][1];
          if (pn < 8) {
            bf16_t* dst = (bf16_t*)(ws + (pn < 4 ? OFF_QF : OFF_KF)) + (size_t)token * 1024 + (pn & 3) * 256 + bj * 128 + d0;
            *(u32x2*)dst = (u32x2){pack2(v0[0], v0[1]), pack2(v0[2], v0[3])};
            *(u32x2*)(dst + 64) = (u32x2){pack2(v1[0], v1[1]), pack2(v1[2], v1[3])};
          } else if (pn == 22) {
            if (bj == 0 && wc == 0) {
#pragma unroll
              for (int n = 0; n < 2; ++n)
#pragma unroll
                for (int j = 0; j < 4; ++j) {
                  const int col = n * 16 + fq * 4 + j; const float val = acc[ai][0][m][n][j];
                  if (col < 8) ((float*)(ws + OFF_LOGF))[token * 8 + col] = log_sigmoid(val + p->b_fgate[col]);
                  else if (col < 32) ((float*)(ws + OFF_GATES))[token * 24 + col - 8] = sigmoidf_(val);
                }
            }
          } else {
            const bool rope = (pn >= 12 && pn < 16) || pn == 18 || pn == 20;
            if (rope) {
              const f32x4 cv = *(const f32x4*)(cs + (size_t)token * 64 + d0), sv = *(const f32x4*)(sn + (size_t)token * 64 + d0);
              const f32x4 y0 = v0 * cv - v1 * sv, y1 = v1 * cv + v0 * sv; v0 = y0; v1 = y1;
            }
            if (pn >= 12 && pn < 16) {
              const size_t o = (size_t)token * 1024 + (pn - 12) * 256 + bj * 128 + d0;
              bf16_t* dh = (bf16_t*)(ws + OFF_QN_HI) + o; bf16_t* dl = (bf16_t*)(ws + OFF_QN_LO) + o;
              unsigned h0, h1, h2, h3, l0, l1, l2, l3;
              split2(v0[0], v0[1], h0, l0); split2(v0[2], v0[3], h1, l1); split2(v1[0], v1[1], h2, l2); split2(v1[2], v1[3], h3, l3);
              *(u32x2*)dh = (u32x2){h0, h1}; *(u32x2*)(dh + 64) = (u32x2){h2, h3};
              *(u32x2*)dl = (u32x2){l0, l1}; *(u32x2*)(dl + 64) = (u32x2){l2, l3};
            } else {
              const size_t o = ((size_t)(b * 2 + bj) * 4096 + s) * 128 + d0;
              const size_t off = pn == 16 ? OFF_KCIN_HI : (pn == 17 ? OFF_VCIN : (pn == 18 ? OFF_KS : OFF_KW));
              bf16_t* dh = (bf16_t*)(ws + off) + o;
              unsigned h0, h1, h2, h3, l0, l1, l2, l3;
              split2(v0[0], v0[1], h0, l0); split2(v0[2], v0[3], h1, l1); split2(v1[0], v1[1], h2, l2); split2(v1[2], v1[3], h3, l3);
              *(u32x2*)dh = (u32x2){h0, h1}; *(u32x2*)(dh + 64) = (u32x2){h2, h3};
              if (pn == 16) {
                bf16_t* dl = (bf16_t*)(ws + OFF_KCIN_LO) + o;
                *(u32x2*)dl = (u32x2){l0, l1}; *(u32x2*)(dl + 64) = (u32x2){l2, l3};
              }
            }
          }
        }
      }
  }
};

struct EpiVT {
  bf16_t* dst; int nheads; int sec_row0;
  DI void operator()(const AccT& acc, int brow, int bcol, int wr, int wc, int fr, int fq) const {
#pragma unroll
    for (int ai = 0; ai < 2; ++ai)
#pragma unroll
      for (int m = 0; m < 4; ++m) {
        const int vr = brow - sec_row0 + ai * 128 + wr * 64 + m * 16 + fr;
        const int head = vr >> 7, d = vr & 127;
#pragma unroll
        for (int bj = 0; bj < 2; ++bj)
#pragma unroll
          for (int n = 0; n < 2; ++n) {
            const int tk = bcol + bj * 128 + wc * 32 + n * 16 + fq * 4;
            const int b = tk >> 12, s = tk & 4095;
            const f32x4 v = acc[ai][bj][m][n];
            *(u32x2*)(dst + ((size_t)(b * nheads + head) * 128 + d) * 4096 + s) = (u32x2){pack2(v[0], v[1]), pack2(v[2], v[3])};
          }
      }
  }
};

struct EpiF32 {
  float* dst; int ld;
  DI void operator()(const AccT& acc, int brow, int bcol, int wr, int wc, int fr, int fq) const {
#pragma unroll
    for (int ai = 0; ai < 2; ++ai)
#pragma unroll
      for (int m = 0; m < 4; ++m) {
        const int row = brow + ai * 128 + wr * 64 + m * 16 + fr;
#pragma unroll
        for (int bj = 0; bj < 2; ++bj)
#pragma unroll
          for (int n = 0; n < 2; ++n)
            *(f32x4*)(dst + (size_t)row * ld + bcol + bj * 128 + wc * 32 + n * 16 + fq * 4) = acc[ai][bj][m][n];
      }
  }
};

struct EpiResid {
  float* dst; const float* base; const float* gate;
  DI void operator()(const AccT& acc, int brow, int bcol, int wr, int wc, int fr, int fq) const {
#pragma unroll
    for (int ai = 0; ai < 2; ++ai)
#pragma unroll
      for (int m = 0; m < 4; ++m) {
        const int row = brow + ai * 128 + wr * 64 + m * 16 + fr;
        const int b = row >> 12;
#pragma unroll
        for (int bj = 0; bj < 2; ++bj)
#pragma unroll
          for (int n = 0; n < 2; ++n) {
            const int col = bcol + bj * 128 + wc * 32 + n * 16 + fq * 4;
            const f32x4 xv = *(const f32x4*)(base + (size_t)row * 2048 + col);
            const f32x4 gv = *(const f32x4*)(gate + b * 12288 + col);
            *(f32x4*)(dst + (size_t)row * 2048 + col) = xv + gv * acc[ai][bj][m][n];
          }
      }
  }
};

struct EpiSwiglu {
  bf16_t* act;
  DI void operator()(const AccT& acc, int brow, int bcol, int wr, int wc, int fr, int fq) const {
    const int pn = bcol >> 8;
#pragma unroll
    for (int ai = 0; ai < 2; ++ai)
#pragma unroll
      for (int m = 0; m < 4; ++m) {
        const int row = brow + ai * 128 + wr * 64 + m * 16 + fr;
        float r[8];
#pragma unroll
        for (int n = 0; n < 2; ++n) {
          const f32x4 gt = acc[ai][0][m][n], up = acc[ai][1][m][n];
#pragma unroll
          for (int j = 0; j < 4; ++j) r[n * 4 + j] = silu_fast(gt[j]) * up[j];
        }
        *(u32x4*)(act + (size_t)row * DFF + pn * 128 + wc * 32 + fq * 8) = (u32x4){pack2(r[0], r[1]), pack2(r[2], r[3]), pack2(r[4], r[5]), pack2(r[6], r[7])};
      }
  }
};

DI int map_win(int c, int& lo_row) {
  lo_row = -1;
  if (c < 2048) return (c & ~127) + perm128(c & 127);
  if (c < 3072) return c;
  if (c < 3080) return 5632 + (c - 3072);
  if (c < 4104) { int cc = c - 3080; int d = 3072 + (cc & ~127) + perm128(cc & 127); lo_row = d - 3072; return d; }
  if (c < 4360) { int cc = c - 4104; int d = 4096 + (cc & ~127) + perm128(cc & 127); lo_row = d - 3072; return d; }
  if (c < 4616) { int cc = c - 4360; return 4352 + (cc & ~127) + perm128(cc & 127); }
  if (c < 4872) { int cc = c - 4616; return 4608 + (cc & ~127) + perm128(cc & 127); }
  if (c < 5128) return 4864 + (c - 4872);
  if (c < 5384) { int cc = c - 5128; return 5120 + (cc & ~127) + perm128(cc & 127); }
  if (c < 5640) return 5376 + (c - 5384);
  return c;
}

struct TInfo { const float* src; bf16_t* dh; bf16_t* dl; int N, Kd, mat, k0, n0; };
constexpr int TJ_WIN = 16 * 89, TJ_WOUT = 16 * 32, TJ_WG = 16 * 88, TJ_WD = 44 * 32, TJ_W1 = 32 * 4;
constexpr int TE0 = TJ_WIN, TE1 = TE0 + TJ_WOUT, TE2 = TE1 + TJ_WG, TE3 = TE2 + TJ_WG, TE4 = TE3 + TJ_WD, TE5 = TE4 + TJ_W1, TE6 = TE5 + TJ_W1;
DI void tile_info(const Params& p, int t, TInfo& ti) {
  char* ws = p.ws; ti.dl = nullptr; int nn;
  if (t < TE0) { ti.mat = 0; ti.src = p.w_in; ti.N = DIN; ti.Kd = 2048; ti.dh = (bf16_t*)(ws + OFF_WIN_HI); ti.dl = (bf16_t*)(ws + OFF_WIN_LO); nn = 89; }
  else if (t < TE1) { t -= TE0; ti.mat = 1; ti.src = p.w_out; ti.N = 2048; ti.Kd = 2048; ti.dh = (bf16_t*)(ws + OFF_WOUT); nn = 32; }
  else if (t < TE2) { t -= TE1; ti.mat = 2; ti.src = p.w_gate; ti.N = DFF; ti.Kd = 2048; ti.dh = (bf16_t*)(ws + OFF_WGU); nn = 88; }
  else if (t < TE3) { t -= TE2; ti.mat = 3; ti.src = p.w_up; ti.N = DFF; ti.Kd = 2048; ti.dh = (bf16_t*)(ws + OFF_WGU); nn = 88; }
  else if (t < TE4) { t -= TE3; ti.mat = 4; ti.src = p.w_down; ti.N = 2048; ti.Kd = DFF; ti.dh = (bf16_t*)(ws + OFF_WDN); nn = 32; }
  else if (t < TE5) { t -= TE4; ti.mat = 5; ti.src = p.w_kc1; ti.N = 256; ti.Kd = 4096; ti.dh = (bf16_t*)(ws + OFF_W1K_HI); ti.dl = (bf16_t*)(ws + OFF_W1K_LO); nn = 4; }
  else { t -= TE5; ti.mat = 6; ti.src = p.w_vc1; ti.N = 256; ti.Kd = 4096; ti.dh = (bf16_t*)(ws + OFF_W1V); nn = 4; }
  ti.k0 = (t / nn) * 128; ti.n0 = (t % nn) * 64;
}
DI void tr_load(const TInfo& ti, int tid, f32x4 (&r)[4]) {
#pragma unroll
  for (int i = 0; i < 4; ++i) {
    const int idx = tid + i * 512, k = idx >> 4, col = ti.n0 + (idx & 15) * 4;
    r[i] = col < ti.N ? *(const f32x4*)(ti.src + (size_t)(ti.k0 + k) * ti.N + col) : (f32x4){0.f, 0.f, 0.f, 0.f};
  }
}
DI void tr_lds_write(float* tile, int tid, const f32x4 (&r)[4]) {
#pragma unroll
  for (int i = 0; i < 4; ++i) {
    const int idx = tid + i * 512, k = idx >> 4, c = (idx & 15) * 4;
#pragma unroll
    for (int j = 0; j < 4; ++j) tile[k * 65 + c + j] = r[i][j];
  }
}
DI void tr_store(const TInfo& ti, const float* tile, int tid) {
#pragma unroll
  for (int i = 0; i < 2; ++i) {
    const int idx = tid + i * 512, nr = idx >> 4, kc = idx & 15, col = ti.n0 + nr;
    if (col < ti.N) {
      int row, lrow = -1;
      if (ti.mat == 0) row = map_win(col, lrow);
      else if (ti.mat == 2) row = (col >> 7) * 256 + perm_gu(col & 127);
      else if (ti.mat == 3) row = (col >> 7) * 256 + 128 + perm_gu(col & 127);
      else { row = col; if (ti.mat == 5) lrow = col; }
      float v[8];
#pragma unroll
      for (int e = 0; e < 8; ++e) v[e] = tile[(kc * 8 + e) * 65 + nr];
      *(u32x4*)(ti.dh + (size_t)row * ti.Kd + ti.k0 + kc * 8) = (u32x4){pack2(v[0], v[1]), pack2(v[2], v[3]), pack2(v[4], v[5]), pack2(v[6], v[7])};
      if (lrow >= 0)
        *(u32x4*)(ti.dl + (size_t)lrow * ti.Kd + ti.k0 + kc * 8) = (u32x4){pack2(lo_of(v[0]), lo_of(v[1])), pack2(lo_of(v[2]), lo_of(v[3])), pack2(lo_of(v[4]), lo_of(v[5])), pack2(lo_of(v[6]), lo_of(v[7]))};
    }
  }
}
DI void transpose_all(const Params& p) {
  float* lds = (float*)g_smem;
  int tid = threadIdx.x; asm volatile("" : "+v"(tid));
  const int G = gridDim.x;
  int t0 = blockIdx.x, t1 = t0 + G;
  TInfo ia, ib; f32x4 ra[4], rb[4];
  if (t0 < TE6) { tile_info(p, t0, ia); tr_load(ia, tid, ra); }
  if (t1 < TE6) { tile_info(p, t1, ib); tr_load(ib, tid, rb); }
  while (t0 < TE6) {
    tr_lds_write(lds, tid, ra);
    __syncthreads();
    const TInfo cura = ia;
    const int t2 = t0 + 2 * G;
    if (t2 < TE6) { tile_info(p, t2, ia); tr_load(ia, tid, ra); }
    tr_store(cura, lds, tid);
    if (t1 >= TE6) break;
    tr_lds_write(lds + 128 * 65, tid, rb);
    __syncthreads();
    const TInfo curb = ib;
    const int t3 = t1 + 2 * G;
    if (t3 < TE6) { tile_info(p, t3, ib); tr_load(ib, tid, rb); }
    tr_store(curb, lds + 128 * 65, tid);
    t0 = t2; t1 = t3;
  }
  __syncthreads();
}

DI void mod_job(const Params& p, int job) {
  float* sc = (float*)g_smem;
  float* red = sc + 4096;
  const int tid = threadIdx.x, wave = tid >> 6, lane = tid & 63;
  for (int i = tid; i < 4096; i += 512) sc[i] = siluf_(p.c[i]);
  __syncthreads();
  const int n0 = job * 64, cgp = lane & 15, kr = lane >> 4;
  f32x4 a0 = {0.f, 0.f, 0.f, 0.f}, a1 = {0.f, 0.f, 0.f, 0.f};
#pragma unroll 8
  for (int k = wave * 4 + kr; k < 2048; k += 32) {
    const f32x4 wv = *(const f32x4*)(p.w_ada + (size_t)k * 12288 + n0 + cgp * 4);
    a0 += wv * sc[k]; a1 += wv * sc[2048 + k];
  }
#pragma unroll
  for (int j = 0; j < 4; ++j) {
    a0[j] += __shfl_xor(a0[j], 16); a0[j] += __shfl_xor(a0[j], 32);
    a1[j] += __shfl_xor(a1[j], 16); a1[j] += __shfl_xor(a1[j], 32);
  }
  if (kr == 0) {
#pragma unroll
    for (int j = 0; j < 4; ++j) { red[(wave * 2 + 0) * 64 + cgp * 4 + j] = a0[j]; red[(wave * 2 + 1) * 64 + cgp * 4 + j] = a1[j]; }
  }
  __syncthreads();
  if (tid < 128) {
    const int b = tid >> 6, col = tid & 63;
    float s = p.b_ada[n0 + col];
#pragma unroll
    for (int w = 0; w < 8; ++w) s += red[(w * 2 + b) * 64 + col];
    ((float*)(p.ws + OFF_MOD))[b * 12288 + n0 + col] = s;
  }
  __syncthreads();
}

DI void bias1_job(const Params& p, int j) {
  const int which = j >> 4, chunk = j & 15;
  const float* w1 = which ? p.w_vc1 : p.w_kc1;
  float* red = (float*)g_smem;
  const int tid = threadIdx.x, col = tid & 255, half = tid >> 8;
  float s = 0.f;
  const int kb = chunk * 256 + half * 128;
#pragma unroll 16
  for (int k = kb; k < kb + 128; ++k) s += p.cmp_pos[k] * w1[(size_t)k * 256 + col];
  red[tid] = s;
  __syncthreads();
  if (tid < 256) ((float*)(p.ws + OFF_BIAS1))[(which * 16 + chunk) * 256 + tid] = red[tid] + red[tid + 256];
  __syncthreads();
}

DI void rope_job(const Params& p, int job) {
  const int idx = job * 512 + threadIdx.x, token = idx >> 6, i = idx & 63;
  const float ang = (float)p.pos[token] * c_inv_freq[i];
  double t = (double)ang * 0.15915494309189535;
  t -= floor(t + 0.5);
  const float tf = (float)t;
  ((float*)(p.ws + OFF_COS))[idx] = __builtin_amdgcn_cosf(tf);
  ((float*)(p.ws + OFF_SIN))[idx] = __builtin_amdgcn_sinf(tf);
}

DI void phase0(const Params& p) {
  transpose_all(p);
  constexpr int J_MOD = 192, J_B1 = 32, J_ROPE = 1024;
  for (int job = blockIdx.x; job < J_MOD + J_B1 + J_ROPE; job += gridDim.x) {
    if (job < J_MOD) mod_job(p, job);
    else if (job < J_MOD + J_B1) bias1_job(p, job - J_MOD);
    else rope_job(p, job - J_MOD - J_B1);
  }
}

DI void rmsmod_phase(const float* src, const float* g, const float* mod, int sh_off, int sc_off, bf16_t* dhi, bf16_t* dlo) {
  const int wave = threadIdx.x >> 6, lane = threadIdx.x & 63;
  for (int row = blockIdx.x * 8 + wave; row < T_TOK; row += gridDim.x * 8) {
    const int b = row >> 12;
    const f32x4* xr = (const f32x4*)(src + (size_t)row * 2048);
    f32x4 v[8]; float ss = 0.f;
#pragma unroll
    for (int i = 0; i < 8; ++i) { v[i] = xr[lane + i * 64]; ss += v[i][0] * v[i][0] + v[i][1] * v[i][1] + v[i][2] * v[i][2] + v[i][3] * v[i][3]; }
    ss = wave_sum(ss);
    const float rstd = rsqrtf(ss * (1.f / 2048.f) + 1e-6f);
#pragma unroll
    for (int i = 0; i < 8; ++i) {
      const int col = (lane + i * 64) * 4;
      const f32x4 gv = *(const f32x4*)(g + col);
      const f32x4 sc = *(const f32x4*)(mod + b * 12288 + sc_off + col), sh = *(const f32x4*)(mod + b * 12288 + sh_off + col);
      f32x4 u = (v[i] * rstd) * gv; u = u * (1.f + sc) + sh;
      unsigned h0, h1, l0, l1; split2(u[0], u[1], h0, l0); split2(u[2], u[3], h1, l1);
      *(u32x2*)(dhi + (size_t)row * 2048 + col) = (u32x2){h0, h1};
      if (dlo) *(u32x2*)(dlo + (size_t)row * 2048 + col) = (u32x2){l0, l1};
    }
  }
}

DI void ymix_phase(const Params& p) {
  const int wave = threadIdx.x >> 6, lane = threadIdx.x & 63;
  bf16_t* ym = (bf16_t*)(p.ws + OFF_U_HI);
  for (int row = blockIdx.x * 8 + wave; row < T_TOK; row += gridDim.x * 8) {
#pragma unroll
    for (int part = 0; part < 2; ++part) {
      const f32x4* xr = (const f32x4*)((const float*)(p.ws + (part ? OFF_ON32 : OFF_OF32)) + (size_t)row * 1024);
      const float* beta = part ? p.beta_nsa : p.beta_fox;
      f32x4 v[4]; float ss = 0.f;
#pragma unroll
      for (int i = 0; i < 4; ++i) { v[i] = xr[lane + i * 64]; ss += v[i][0] * v[i][0] + v[i][1] * v[i][1] + v[i][2] * v[i][2] + v[i][3] * v[i][3]; }
      ss = wave_sum(ss);
      const float rstd = rsqrtf(ss * (1.f / 1024.f) + 1e-6f);
#pragma unroll
      for (int i = 0; i < 4; ++i) {
        const int col = (lane + i * 64) * 4;
        const f32x4 u = (v[i] * rstd) * *(const f32x4*)(beta + col);
        *(u32x2*)(ym + (size_t)row * 2048 + part * 1024 + col) = (u32x2){pack2(u[0], u[1]), pack2(u[2], u[3])};
      }
    }
  }
}

DI void final_phase(const Params& p) {
  const int wave = threadIdx.x >> 6, lane = threadIdx.x & 63;
  for (int row = blockIdx.x * 8 + wave; row < T_TOK; row += gridDim.x * 8) {
    f32x4* xr = (f32x4*)(p.out + (size_t)row * 2048);
    f32x4 v[8]; float ss = 0.f;
#pragma unroll
    for (int i = 0; i < 8; ++i) { v[i] = xr[lane + i * 64]; ss += v[i][0] * v[i][0] + v[i][1] * v[i][1] + v[i][2] * v[i][2] + v[i][3] * v[i][3]; }
    ss = wave_sum(ss);
    const float rstd = rsqrtf(ss * (1.f / 2048.f) + 1e-6f);
#pragma unroll
    for (int i = 0; i < 8; ++i) xr[lane + i * 64] = (v[i] * rstd) * *(const f32x4*)(p.final_norm + (lane + i * 64) * 4);
  }
}

typedef float f32x4_ __attribute__((ext_vector_type(4)));
DI void misc_job(const Params& p, int piece) {
  char* ws = p.ws;
  int tid = threadIdx.x; asm volatile("" : "+v"(tid));
  const int wave = tid >> 6, lane = tid & 63, fr = lane & 15, fq = lane >> 4;
  const bf16_t* A = (const bf16_t*)(ws + OFF_U_HI) + (size_t)(piece * 32 + fr) * 2048 + fq * 8 + wave * 256;
  const bf16_t* B = (const bf16_t*)(ws + OFF_WIN_HI) + (size_t)(5632 + fr) * 2048 + fq * 8 + wave * 256;
  f32x4 acc[2][2] = {};
#pragma unroll
  for (int k = 0; k < 8; ++k) {
    const bf16x8 a0 = *(const bf16x8*)(A + k * 32), a1 = *(const bf16x8*)(A + 16 * 2048 + k * 32);
    const bf16x8 b0 = *(const bf16x8*)(B + k * 32), b1 = *(const bf16x8*)(B + 16 * 2048 + k * 32);
    acc[0][0] = __builtin_amdgcn_mfma_f32_16x16x32_bf16(a0, b0, acc[0][0], 0, 0, 0);
    acc[0][1] = __builtin_amdgcn_mfma_f32_16x16x32_bf16(a0, b1, acc[0][1], 0, 0, 0);
    acc[1][0] = __builtin_amdgcn_mfma_f32_16x16x32_bf16(a1, b0, acc[1][0], 0, 0, 0);
    acc[1][1] = __builtin_amdgcn_mfma_f32_16x16x32_bf16(a1, b1, acc[1][1], 0, 0, 0);
  }
  f32x4* red = (f32x4*)g_smem;
#pragma unroll
  for (int q = 0; q < 4; ++q) red[(wave * 4 + q) * 64 + lane] = acc[q >> 1][q & 1];
  __syncthreads();
  if (tid < 256) {
    const int q = tid >> 6, l = tid & 63, mb = q >> 1, nb = q & 1, fr2 = l & 15, fq2 = l >> 4;
    f32x4 sum = red[q * 64 + l];
#pragma unroll
    for (int w = 1; w < 8; ++w) sum += red[(w * 4 + q) * 64 + l];
    const int col = nb * 16 + fr2;
#pragma unroll
    for (int j = 0; j < 4; ++j) {
      const int token = piece * 32 + mb * 16 + fq2 * 4 + j;
      if (col < 8) ((float*)(ws + OFF_LOGF))[token * 8 + col] = log_sigmoid(sum[j] + p.b_fgate[col]);
      else ((float*)(ws + OFF_GATES))[token * 24 + col - 8] = sigmoidf_(sum[j]);
    }
  }
  __syncthreads();
}
DI void inproj_heavy(const Params& p, int job) {
  char* ws = p.ws;
  const bf16_t* uhi = (const bf16_t*)(ws + OFF_U_HI); const bf16_t* ulo = (const bf16_t*)(ws + OFF_U_LO);
  const bf16_t* whi = (const bf16_t*)(ws + OFF_WIN_HI); const bf16_t* wlo = (const bf16_t*)(ws + OFF_WIN_LO);
  const int pn = 12 + job / 32, pm = job % 32;
  GemmOp g; g.lda = 2048; g.ldb = 2048;
  g.A0 = uhi; g.A1 = uhi; g.A2 = ulo; g.B0 = whi; g.B1 = wlo - (size_t)3072 * 2048; g.B2 = whi; g.nt = 96; g.shift = 5;
  EpiInproj e{&p, pn};
  gemm_tile(g, pm * 256, pn * 256, e);
}
DI void inproj_light(const Params& p, int L) {
  char* ws = p.ws;
  const bf16_t* uhi = (const bf16_t*)(ws + OFF_U_HI); const bf16_t* whi = (const bf16_t*)(ws + OFF_WIN_HI);
  GemmOp g; g.lda = 2048; g.ldb = 2048; g.nt = 32; g.shift = 5;
  if (L < 352) {
    const int t = L / 32, pm = L % 32;
    const int pn = t < 8 ? t : (t == 8 ? 17 : (t == 9 ? 18 : 20));
    g.A0 = g.A1 = g.A2 = uhi; g.B0 = g.B1 = g.B2 = whi;
    EpiInproj e{&p, pn};
    gemm_tile(g, pm * 256, pn * 256, e);
  } else {
    const int j = L - 352, rt = j / 32, tt = j % 32;
    int wrow; bf16_t* dst; int nh, sec0;
    if (rt < 4) { wrow = 2048 + rt * 256; dst = (bf16_t*)(ws + OFF_VFT); nh = 8; sec0 = 2048; }
    else if (rt == 4) { wrow = 4864; dst = (bf16_t*)(ws + OFF_VST); nh = 2; sec0 = 4864; }
    else { wrow = 5376; dst = (bf16_t*)(ws + OFF_VWT); nh = 2; sec0 = 5376; }
    g.A0 = g.A1 = g.A2 = whi; g.B0 = g.B1 = g.B2 = uhi;
    EpiVT e{dst, nh, sec0};
    gemm_tile(g, wrow, tt * 256, e);
  }
}
DI void inproj_phase(const Params& p, bool dry) {
  if (gridDim.x == 256) {
    const int c = blockIdx.x;
    if (c < 160) { inproj_heavy(p, c); inproj_light(p, c); }
    else { for (int i = 0; i < 4; ++i) inproj_light(p, 160 + (c - 160) * 4 + i); }
    if (!dry) misc_job(p, c);
  } else {
    FOR_JOBS(job, 160) inproj_heavy(p, job);
    FOR_JOBS(job, 544) inproj_light(p, job);
    FOR_JOBS(job, 256) misc_job(p, job);
  }
}

constexpr int KSTR = 272, VSTR = 264;
constexpr int ST_K = 0, ST_V = 128 * KSTR, ST_C = ST_V + 128 * VSTR, ST_SIZE = ST_C + 512;
constexpr int LDS_LIST = 2 * ST_SIZE;

DI bf16x8 pack8(const f32x16& x, int s) {
  u32x4 r;
  r[0] = pack2(x[8 * s + 0], x[8 * s + 1]); r[1] = pack2(x[8 * s + 2], x[8 * s + 3]);
  r[2] = pack2(x[8 * s + 4], x[8 * s + 5]); r[3] = pack2(x[8 * s + 6], x[8 * s + 7]);
  return __builtin_bit_cast(bf16x8, r);
}
DI bf16x8 ldv8(const char* p) {
  const u32x2 a = *(const u32x2*)p, b = *(const u32x2*)(p + 16);
  u32x4 r = {a[0], a[1], b[0], b[1]};
  return __builtin_bit_cast(bf16x8, r);
}

constexpr int AS_K = 0, AS_V = 32768, AS_C = 65536, AS_SIZE = 66048;
constexpr int LDS_LIST2 = 2 * AS_SIZE;
DI int pi23(int r) { return (r & ~12) | ((r & 4) << 1) | ((r & 8) >> 1); }
template <int MODE>
DI void attn_unit(const Params& p, int b, int hg, int qt, bool dry = false) {
  char* ws = p.ws;
  int tid = threadIdx.x; asm volatile("" : "+v"(tid));
  const int wave = tid >> 6, lane = tid & 63, l32 = lane & 31, hh = lane >> 5, rg = wave & 3, kh = wave >> 2;
  int token, head; const bf16_t *qrow, *kbase, *vbase; int kstride;
  if (MODE == 0) {
    token = qt * 128 + rg * 32 + l32; head = hg;
    qrow = (const bf16_t*)(ws + OFF_QF) + (size_t)(b * 4096 + token) * 1024 + head * 128;
    kbase = (const bf16_t*)(ws + OFF_KF) + (size_t)b * 4096 * 1024 + head * 128; kstride = 1024;
    vbase = (const bf16_t*)(ws + OFF_VFT) + (size_t)(b * 8 + head) * 128 * 4096;
  } else {
    if (MODE == 1) { token = qt * 32 + l32; head = hg * 4 + rg; }
    else { token = qt * 32 + rg * 8 + (l32 >> 2); head = hg * 4 + (l32 & 3); }
    qrow = (const bf16_t*)(ws + OFF_QN_HI) + (size_t)(b * 4096 + token) * 1024 + head * 128;
    kbase = (const bf16_t*)(ws + (MODE == 1 ? OFF_KW : OFF_KS)) + (size_t)(b * 2 + hg) * 4096 * 128; kstride = 128;
    vbase = (const bf16_t*)(ws + (MODE == 1 ? OFF_VWT : OFF_VST)) + (size_t)(b * 2 + hg) * 128 * 4096;
  }
  const int wtmin = MODE == 0 ? qt * 128 + rg * 32 : (MODE == 1 ? qt * 32 : qt * 32 + rg * 8), wtmax = wtmin + (MODE == 2 ? 7 : 31);
  int nst, kv_start = 0;
  int* list = (int*)(g_smem + LDS_LIST2);
  unsigned long long selmask = 0;
  if (MODE == 0) nst = qt + 1;
  else if (MODE == 1) { int lo = qt * 32 - 511; if (lo < 0) lo = 0; kv_start = lo & ~63; nst = (qt * 32 + 32 - kv_start + 127) >> 7; }
  else {
    const unsigned long long* sel = (const unsigned long long*)(ws + OFF_SEL) + (size_t)(b * 2 + hg) * 4096;
    selmask = sel[token];
    if (wave == 0) {
      const unsigned long long sm0 = sel[qt * 32 + l32];
      unsigned lo = (unsigned)sm0, hi = (unsigned)(sm0 >> 32);
#pragma unroll
      for (int o = 16; o > 0; o >>= 1) { lo |= __shfl_xor(lo, o); hi |= __shfl_xor(hi, o); }
      const unsigned long long um = ((unsigned long long)hi << 32) | lo;
      if ((um >> lane) & 1ull) list[1 + __popcll(um & ((1ull << lane) - 1ull))] = lane;
      if (lane == 0) list[0] = __popcll(um);
    }
    __syncthreads();
    nst = (list[0] + 1) >> 1;
  }
  bf16x8 qf[8];
#pragma unroll
  for (int ks = 0; ks < 8; ++ks) qf[ks] = *(const bf16x8*)(qrow + ks * 16 + hh * 8);
  float cumq = 0.f;
  const float* cumrow = nullptr;
  if (MODE == 0) { cumrow = (const float*)(ws + OFF_CUM) + (size_t)(b * 8 + head) * 4096; cumq = cumrow[token]; }

  f32x16 o[4];
#pragma unroll
  for (int i = 0; i < 4; ++i) o[i] = zero16();
  float mrun = -1e30f, lrun = 0.f;

  auto tile_base = [&](int it, int half) -> int {
    if (MODE == 2) { const int i = 2 * it + half; return i < list[0] ? list[1 + i] * 64 : -1; }
    return kv_start + it * 128 + half * 64;
  };
  const int rsub = lane >> 4, slot = lane & 15;
  unsigned koff[4], voff[4]; bool vhalf[4];
#pragma unroll
  for (int j = 0; j < 4; ++j) {
    const int row = (j * 8 + wave) * 4 + rsub;
    const int c = slot ^ (row & 15);
    koff[j] = (unsigned)(pi23(row & 63) * kstride + c * 8) * 2u;
    vhalf[j] = (c >> 3) != 0;
    voff[j] = MODE == 2 ? (unsigned)(row * 4096 + (c & 7) * 8) * 2u : (unsigned)(row * 4096 + c * 8) * 2u;
  }
  auto issue_stage = [&](int it, int buf) {
    if (DRY_MODE == 2 && dry) return;
    int kb0 = tile_base(it, 0), kb1 = tile_base(it, 1);
    if (kb1 < 0) kb1 = 0;
    char* sb = g_smem + buf * AS_SIZE;
    const char* kp0 = uptr((const char*)(kbase + (size_t)kb0 * kstride));
    const char* kp1 = uptr((const char*)(kbase + (size_t)kb1 * kstride));
    const char* vp0 = uptr((const char*)(vbase + kb0));
    const char* vp1 = uptr((const char*)(vbase + kb1));
#pragma unroll
    for (int j = 0; j < 4; ++j) {
      __builtin_amdgcn_global_load_lds((const unsigned*)((j >> 1 ? kp1 : kp0) + koff[j]), (unsigned*)(sb + AS_K + (j * 8 + wave) * 1024 + lane * 16), 16, 0, 0);
      const char* vsrc = MODE == 2 ? ((vhalf[j] ? vp1 : vp0) + voff[j]) : (vp0 + voff[j]);
      __builtin_amdgcn_global_load_lds((const unsigned*)vsrc, (unsigned*)(sb + AS_V + (j * 8 + wave) * 1024 + lane * 16), 16, 0, 0);
    }
    if (MODE == 0 && wave < 2) {
      const int key = (wave ? kb1 : kb0) + lane;
      __builtin_amdgcn_global_load_lds((const unsigned*)(cumrow + key), (unsigned*)(sb + AS_C + wave * 256 + lane * 4), 4, 0, 0);
    }
  };

  int it0 = 0;
  if (MODE == 0) {
    float q2 = 0.f;
#pragma unroll
    for (int ks = 0; ks < 8; ++ks)
#pragma unroll
      for (int e = 0; e < 8; ++e) { const float f = bf2f((unsigned short)qf[ks][e]); q2 += f * f; }
    q2 = xsum32(q2);
#pragma unroll
    for (int o2 = 16; o2 > 0; o2 >>= 1) q2 = fmaxf(q2, __shfl_xor(q2, o2));
    const float* kn = (const float*)(ws + OFF_KNORM) + (size_t)(b * 8 + head) * 128;
    float k2 = fmaxf(kn[lane], kn[lane + 64]);
#pragma unroll
    for (int o2 = 32; o2 > 0; o2 >>= 1) k2 = fmaxf(k2, __shfl_xor(k2, o2));
    float* qx = (float*)(g_smem + LDS_LIST2);
    if (lane == 0) qx[wave] = q2;
    __syncthreads();
    const float q2m = fmaxf(fmaxf(qx[0], qx[1]), fmaxf(qx[2], qx[3]));
    const float xub = sqrtf(q2m * k2) * (QK_C1 * 1.001f) + 0.01f;
    const float cend = lane < qt ? cumrow[lane * 128 + 127] : cumrow[qt * 128];
    const float bub = (cumrow[qt * 128] - cend) * LOG2E;
    const bool skip = lane < qt && (2.f * xub + bub < -160.f);
    const unsigned long long sk = __ballot(skip);
    it0 = (int)__builtin_ctzll(~sk);
    if (it0 > qt) it0 = qt;
    it0 = __builtin_amdgcn_readfirstlane(it0);
  }
#pragma unroll
  for (int ks = 0; ks < 8; ++ks) asm volatile("" :: "v"(qf[ks]));
  asm volatile("" :: "v"(cumq));
  issue_stage(it0, it0 & 1);
  for (int it = it0; it < nst; ++it) {
    asm volatile("s_waitcnt vmcnt(0)" ::: "memory");
    __builtin_amdgcn_s_barrier();
    if (it + 1 < nst) issue_stage(it + 1, (it + 1) & 1);
    const char* sb = g_smem + (it & 1) * AS_SIZE;
    const int kbh = tile_base(it, kh);
    bool active;
    if (MODE == 0) active = kbh <= wtmax;
    else if (MODE == 1) active = kbh <= wtmax && kbh + 63 >= wtmin - 511;
    else active = kbh >= 0;
    if (DRY_MODE == 1 && dry) active = false;
    const bool selbit = (MODE == 2 && kbh >= 0) ? ((selmask >> (kbh >> 6)) & 1ull) != 0 : true;
    if (MODE == 2) active = active && __any(selbit);
    if (active) {
      f32x16 stA = zero16(), stB = zero16();
      {
        const int row = kh * 64 + l32;
        const char* kp = sb + AS_K + row * 256;
        const int sw = row & 15;
#pragma unroll
        for (int ks = 0; ks < 8; ++ks) stA = mfma32(*(const bf16x8*)(kp + (((ks * 2 + hh) ^ sw) << 4)), qf[ks], stA);
#pragma unroll
        for (int ks = 0; ks < 8; ++ks) stB = mfma32(*(const bf16x8*)(kp + 32 * 256 + (((ks * 2 + hh) ^ sw) << 4)), qf[ks], stB);
      }
      const int tq0 = token - kbh - hh * 8;
      bf16x8 pk0, pk1;
#define ATTN_SOFTMAX(ST, KB2) do { \
        const int kmin = kbh + (KB2) * 32, kmax = kmin + 31; \
        if (MODE == 0) { \
          f32x16 cs16; \
          _Pragma("unroll") for (int gq = 0; gq < 4; ++gq) { \
            const f32x4 cs = *(const f32x4*)(sb + AS_C + (kh * 64 + (KB2) * 32 + (gq >> 1) * 16 + hh * 8 + (gq & 1) * 4) * 4); \
            cs16[gq * 4] = cs[0]; cs16[gq * 4 + 1] = cs[1]; cs16[gq * 4 + 2] = cs[2]; cs16[gq * 4 + 3] = cs[3]; } \
          ST = ST * QK_C1 + (cs16 * (-LOG2E) + cumq * LOG2E); \
        } else ST = ST * QK_C1; \
        bool need_mask; \
        if (MODE == 0) need_mask = kmax > wtmin; \
        else if (MODE == 1) need_mask = kmax > wtmin || wtmax - kmin >= 512; \
        else need_mask = (kbh >> 6) == (wtmin >> 6); \
        if (need_mask) { \
          _Pragma("unroll") for (int gq = 0; gq < 4; ++gq) _Pragma("unroll") for (int j = 0; j < 4; ++j) { \
            const int kofs = (KB2) * 32 + (gq >> 1) * 16 + (gq & 1) * 4 + j; \
            bool valid = kofs <= tq0; \
            if (MODE == 1) valid = valid && (tq0 - kofs < 512); \
            ST[gq * 4 + j] = valid ? ST[gq * 4 + j] : -1e30f; } } \
        float mx = ST[0]; \
        _Pragma("unroll") for (int r = 1; r < 16; ++r) mx = fmaxf(mx, ST[r]); \
        mx = xmax32(mx); \
        if (MODE == 2) mx = selbit ? mx : -1e30f; \
        const float mnew = (mx > mrun + 8.f) ? mx : mrun;        \
        if (__any(mnew != mrun)) { \
          const float alpha = fexp2(mrun - mnew); \
          lrun *= alpha; \
          _Pragma("unroll") for (int i = 0; i < 4; ++i) o[i] = o[i] * alpha; } \
        mrun = mnew; \
        const float msub = (mnew > -1e29f && selbit) ? mnew : 1e30f; \
        ST = ST - msub; \
        float rs = 0.f; \
        _Pragma("unroll") for (int r = 0; r < 16; ++r) { ST[r] = fexp2(ST[r]); rs += ST[r]; } \
        rs = xsum32(rs); \
        lrun += rs; \
        pk0 = pack8(ST, 0); pk1 = pack8(ST, 1); } while (0)
#define ATTN_PV(KB2) do { \
        _Pragma("unroll") for (int dblk = 0; dblk < 4; ++dblk) { \
          const int d = dblk * 32 + l32; \
          const char* vp = sb + AS_V + d * 256; \
          const int sw = d & 15; \
          o[dblk] = mfma32(*(const bf16x8*)(vp + (((kh * 8 + (KB2) * 4 + hh) ^ sw) << 4)), pk0, o[dblk]); \
          o[dblk] = mfma32(*(const bf16x8*)(vp + (((kh * 8 + (KB2) * 4 + 2 + hh) ^ sw) << 4)), pk1, o[dblk]); } } while (0)
      ATTN_SOFTMAX(stA, 0);
      ATTN_PV(0);
      ATTN_SOFTMAX(stB, 1);
      ATTN_PV(1);
#undef ATTN_SOFTMAX
#undef ATTN_PV
    }
  }
  __syncthreads();
  float* X = (float*)g_smem;
  if (kh == 1) {
#pragma unroll
    for (int i = 0; i < 4; ++i)
#pragma unroll
      for (int r = 0; r < 16; ++r) X[(rg * 66 + i * 16 + r) * 64 + lane] = o[i][r];
    X[(rg * 66 + 64) * 64 + lane] = mrun; X[(rg * 66 + 65) * 64 + lane] = lrun;
  }
  __syncthreads();
  float* Tt = (float*)(g_smem + 67584);
  if (kh == 0) {
    const float m1 = X[(rg * 66 + 64) * 64 + lane], l1 = X[(rg * 66 + 65) * 64 + lane];
    const float mf = fmaxf(mrun, m1);
    const float a0 = fexp2(mrun - mf), a1 = fexp2(m1 - mf);
    const float lt = lrun * a0 + l1 * a1;
    float inv = lt > 0.f ? 1.f / lt : 0.f;
    if (MODE != 0) inv *= ((const float*)(ws + OFF_GATES))[(size_t)(b * 4096 + token) * 24 + head * 3 + (MODE == 1 ? 2 : 1)];
    const float s0 = a0 * inv, s1 = a1 * inv;
    float* trow = Tt + (rg * 32 + l32) * 132;
#pragma unroll
    for (int i = 0; i < 4; ++i)
#pragma unroll
      for (int gq = 0; gq < 4; ++gq) {
        f32x4 v;
#pragma unroll
        for (int j = 0; j < 4; ++j) v[j] = o[i][gq * 4 + j] * s0 + X[(rg * 66 + i * 16 + gq * 4 + j) * 64 + lane] * s1;
        *(f32x4*)(trow + i * 32 + 8 * gq + 4 * hh) = v;
      }
  }
  __syncthreads();
  if (!dry) {
    float* obase = (float*)(ws + (MODE == 0 ? OFF_OF32 : OFF_ON32)) + (size_t)b * 4096 * 1024;
#pragma unroll
    for (int k = 0; k < 8; ++k) {
      const int R = wave * 16 + k * 2 + (lane >> 5), rgr = R >> 5, rr = R & 31, c4 = (lane & 31) * 4;
      int tk, hd;
      if (MODE == 0) { tk = qt * 128 + rgr * 32 + rr; hd = hg; }
      else if (MODE == 1) { tk = qt * 32 + rr; hd = hg * 4 + rgr; }
      else { tk = qt * 32 + rgr * 8 + (rr >> 2); hd = hg * 4 + (rr & 3); }
      float* dp = obase + (size_t)tk * 1024 + hd * 128 + c4;
      f32x4 v = *(const f32x4*)(Tt + R * 132 + c4);
      if (MODE == 2) v += *(const f32x4*)dp;
      *(f32x4*)dp = v;
    }
  }
  __syncthreads();
}

constexpr int CV_STR = 520;
constexpr int C_V = 0, C_K = 128 * CV_STR  , C_KLO = C_K + 128 * KSTR, C_EX = C_KLO + 128 * KSTR  ;
DI void cmp_unit(const Params& p, int b, int g, int qt, bool dry = false) {
  char* ws = p.ws;
  int tid = threadIdx.x; asm volatile("" : "+v"(tid));
  const int wave = tid >> 6, lane = tid & 63, l32 = lane & 31, hh = lane >> 5, rg = wave & 3, kh = wave >> 2;
  const int token = qt * 32 + l32, head = g * 4 + rg, bg = b * 2 + g;
  const bf16_t* qh = (const bf16_t*)(ws + OFF_QN_HI) + (size_t)(b * 4096 + token) * 1024 + head * 128;
  const bf16_t* ql = (const bf16_t*)(ws + OFF_QN_LO) + (size_t)(b * 4096 + token) * 1024 + head * 128;
  const bf16_t* kch = (const bf16_t*)(ws + OFF_KC_HI) + (size_t)bg * 256 * 128;
  const bf16_t* kcl = (const bf16_t*)(ws + OFF_KC_LO) + (size_t)bg * 256 * 128;
  const bf16_t* vct = (const bf16_t*)(ws + OFF_VCT) + (size_t)bg * 128 * 256;
  bf16x8 qfh[8], qfl[8];
#pragma unroll
  for (int ks = 0; ks < 8; ++ks) { qfh[ks] = *(const bf16x8*)(qh + ks * 16 + hh * 8); qfl[ks] = *(const bf16x8*)(ql + ks * 16 + hh * 8); }
#pragma unroll
  for (int i = 0; i < 8; ++i) {
    const int c = tid + i * 512, d = c >> 5, cc = c & 31;
    const u32x4 v = *(const u32x4*)(vct + (size_t)d * 256 + cc * 8);
    char* vd = g_smem + C_V + d * CV_STR + cc * 16;
    *(u32x2*)vd = (u32x2){v[0], v[1]}; *(u32x2*)(vd + 8) = (u32x2){v[2], v[3]};
  }
  f32x16 t4[4];
#pragma unroll
  for (int s = 0; s < 2; ++s) {
#pragma unroll
    for (int i = 0; i < 4; ++i) {
      const int c = tid + i * 512, rr = c >> 4, cc = c & 15;
      const int key = (rr >> 6) * 128 + s * 64 + (rr & 63);
      *(u32x4*)(g_smem + C_K + rr * KSTR + cc * 16) = *(const u32x4*)(kch + (size_t)key * 128 + cc * 8);
      *(u32x4*)(g_smem + C_KLO + rr * KSTR + cc * 16) = *(const u32x4*)(kcl + (size_t)key * 128 + cc * 8);
    }
    __syncthreads();
    {
      f32x16 st0 = zero16(), st1 = zero16();
      const int off = (kh * 64 + l32) * KSTR + hh * 16;
      const int tmaxu = qt * 32 + 31;
      const bool act0 = 16 * (kh * 128 + s * 64) + 31 <= tmaxu, act1 = 16 * (kh * 128 + s * 64 + 32) + 31 <= tmaxu;
      if (act0) {
#pragma unroll
        for (int ks = 0; ks < 8; ++ks) {
          const bf16x8 ah0 = *(const bf16x8*)(g_smem + C_K + off + ks * 32), al0 = *(const bf16x8*)(g_smem + C_KLO + off + ks * 32);
          st0 = mfma32(al0, qfh[ks], st0); st0 = mfma32(ah0, qfl[ks], st0); st0 = mfma32(ah0, qfh[ks], st0);
        }
      }
      if (act1) {
#pragma unroll
        for (int ks = 0; ks < 8; ++ks) {
          const bf16x8 ah1 = *(const bf16x8*)(g_smem + C_K + off + 32 * KSTR + ks * 32), al1 = *(const bf16x8*)(g_smem + C_KLO + off + 32 * KSTR + ks * 32);
          st1 = mfma32(al1, qfh[ks], st1); st1 = mfma32(ah1, qfl[ks], st1); st1 = mfma32(ah1, qfh[ks], st1);
        }
      }
#pragma unroll
      for (int r = 0; r < 16; ++r) {
        const int c = kh * 128 + s * 64 + (r & 3) + 8 * (r >> 2) + 4 * hh;
        st0[r] = ((16 * c + 31 <= token) && c < 255) ? st0[r] * QK_C1 : -1e30f;
        st1[r] = ((16 * (c + 32) + 31 <= token) && (c + 32) < 255) ? st1[r] * QK_C1 : -1e30f;
      }
      t4[s * 2 + 0] = st0; t4[s * 2 + 1] = st1;
    }
    __syncthreads();
  }
  float* ex = (float*)(g_smem + C_EX);
  float mx = -1e30f;
#pragma unroll
  for (int i = 0; i < 4; ++i)
#pragma unroll
    for (int r = 0; r < 16; ++r) mx = fmaxf(mx, t4[i][r]);
  mx = xmax32(mx);
  if (hh == 0) ex[(rg * 2 + kh) * 32 + l32] = mx;
  __syncthreads();
  const float mf = fmaxf(ex[(rg * 2 + 0) * 32 + l32], ex[(rg * 2 + 1) * 32 + l32]);
  float rs = 0.f;
#pragma unroll
  for (int i = 0; i < 4; ++i)
#pragma unroll
    for (int r = 0; r < 16; ++r) { const float t = t4[i][r]; const float pv = t > -1e29f ? fexp2(t - mf) : 0.f; t4[i][r] = pv; rs += pv; }
  rs = xsum32(rs);
  if (hh == 0) ex[256 + (rg * 2 + kh) * 32 + l32] = rs;
  __syncthreads();
  const float lt = ex[256 + (rg * 2 + 0) * 32 + l32] + ex[256 + (rg * 2 + 1) * 32 + l32];
  const float inv = lt > 0.f ? 1.f / lt : 0.f;
  float* Ap = (float*)(g_smem + C_K); float* Bp = Ap + 4 * 32 * 64;
#pragma unroll
  for (int i = 0; i < 4; ++i) {
#pragma unroll
    for (int r = 0; r < 16; ++r) t4[i][r] *= inv;
#pragma unroll
    for (int gq = 0; gq < 4; ++gq) {
      const int n = kh * 32 + (i >> 1) * 16 + (i & 1) * 8 + 2 * gq + hh;
      const float p0 = t4[i][gq * 4], p1 = t4[i][gq * 4 + 1], p2 = t4[i][gq * 4 + 2], p3 = t4[i][gq * 4 + 3];
      Ap[(rg * 32 + l32) * 64 + n] = 2.f * (p0 + p1 + p2) + p3;
      Bp[(rg * 32 + l32) * 64 + n] = p3;
    }
  }
  f32x16 o[4];
#pragma unroll
  for (int i = 0; i < 4; ++i) o[i] = zero16();
#pragma unroll
  for (int i = 0; i < 4; ++i) {
    const int keyb = kh * 128 + (i >> 1) * 64 + (i & 1) * 32;
    if (16 * keyb + 31 > qt * 32 + 31) continue;
    const bf16x8 pk0 = pack8(t4[i], 0), pk1 = pack8(t4[i], 1);
#pragma unroll
    for (int dblk = 0; dblk < 4; ++dblk) {
      const char* vp = g_smem + C_V + (dblk * 32 + l32) * CV_STR + (keyb + 4 * hh) * 2;
      o[dblk] = mfma32(ldv8(vp), pk0, o[dblk]);
      o[dblk] = mfma32(ldv8(vp + 32), pk1, o[dblk]);
    }
  }
  __syncthreads();
  float* X = (float*)(g_smem + C_V);
  if (kh == 1) {
#pragma unroll
    for (int i = 0; i < 4; ++i)
#pragma unroll
      for (int r = 0; r < 16; ++r) X[(rg * 64 + i * 16 + r) * 64 + lane] = o[i][r];
  }
  {
    const int n = lane;
#pragma unroll
    for (int i = 0; i < 4; ++i) {
      const int tok = wave * 4 + i, tk = qt * 32 + tok, cur = tk >> 6;
      float imp = 0.f;
#pragma unroll
      for (int r4 = 0; r4 < 4; ++r4) { imp += Ap[(r4 * 32 + tok) * 64 + n]; if (n > 0) imp += Bp[(r4 * 32 + tok) * 64 + n - 1]; }
      const bool causal = n <= cur, forced = n == 0 || n == cur || n == cur - 1;
      const float score = causal ? (forced ? 1e6f : imp) : -1e6f;
      int rank = 0;
#pragma unroll 4
      for (int j = 0; j < 64; ++j) { const float sj = __int_as_float(__builtin_amdgcn_readlane(__float_as_int(score), j)); rank += (sj > score || (sj == score && j < n)) ? 1 : 0; }
      const unsigned long long msk = __ballot(causal && rank < 16);
      if (lane == 0) ((unsigned long long*)(ws + OFF_SEL))[(size_t)bg * 4096 + tk] = msk;
    }
  }
  __syncthreads();
  float* Tt = (float*)(g_smem + C_K);
  if (kh == 0) {
    const float gt = ((const float*)(ws + OFF_GATES))[(size_t)(b * 4096 + token) * 24 + head * 3 + 0];
    float* trow = Tt + (rg * 32 + l32) * 132;
#pragma unroll
    for (int i = 0; i < 4; ++i)
#pragma unroll
      for (int gq = 0; gq < 4; ++gq) {
        f32x4 v;
#pragma unroll
        for (int j = 0; j < 4; ++j) v[j] = (o[i][gq * 4 + j] + X[(rg * 64 + i * 16 + gq * 4 + j) * 64 + lane]) * gt;
        *(f32x4*)(trow + i * 32 + 8 * gq + 4 * hh) = v;
      }
  }
  __syncthreads();
  if (!dry) {
    float* obase = (float*)(ws + OFF_ON32) + (size_t)b * 4096 * 1024;
#pragma unroll
    for (int k = 0; k < 8; ++k) {
      const int R = wave * 16 + k * 2 + (lane >> 5), rgr = R >> 5, rr = R & 31, c4 = (lane & 31) * 4;
      float* dp = obase + (size_t)(qt * 32 + rr) * 1024 + (g * 4 + rgr) * 128 + c4;
      *(f32x4*)dp = *(const f32x4*)dp + *(const f32x4*)(Tt + R * 132 + c4);
    }
  }
  __syncthreads();
}

DI void cumsum_job(const Params& p, int bh) {
  int tid = threadIdx.x; asm volatile("" : "+v"(tid));
  const int b = bh >> 3, h = bh & 7, wave = tid >> 6, lane = tid & 63;
  const float* lf = (const float*)(p.ws + OFF_LOGF) + (size_t)b * 4096 * 8 + h;
  float* cum = (float*)(p.ws + OFF_CUM) + (size_t)bh * 4096;
  float* wt = (float*)g_smem;
  float v[8]; float s = 0.f;
#pragma unroll
  for (int i = 0; i < 8; ++i) { s += lf[(size_t)(tid * 8 + i) * 8]; v[i] = s; }
  float inc = s;
#pragma unroll
  for (int o = 1; o < 64; o <<= 1) { const float t = __shfl_up(inc, o); if (lane >= o) inc += t; }
  if (lane == 63) wt[wave] = inc;
  __syncthreads();
  float base = inc - s;
  for (int w = 0; w < wave; ++w) base += wt[w];
#pragma unroll
  for (int i = 0; i < 8; ++i) cum[tid * 8 + i] = base + v[i];
  __syncthreads();
}

DI void knorm_job(const Params& p, int j) {
  int tid = threadIdx.x; asm volatile("" : "+v"(tid));
  const int pair = tid >> 1, half = tid & 1, tl = pair >> 3, h = pair & 7;
  const bf16_t* kp = (const bf16_t*)(p.ws + OFF_KF) + (size_t)(j * 32 + tl) * 1024 + h * 128 + half * 64;
  float ss = 0.f;
#pragma unroll
  for (int i = 0; i < 8; ++i) {
    const bf16x8 v = *(const bf16x8*)(kp + i * 8);
#pragma unroll
    for (int e = 0; e < 8; ++e) { const float f = bf2f((unsigned short)v[e]); ss += f * f; }
  }
  ss += __shfl_xor(ss, 1);
  float* nr = (float*)g_smem;
  if (half == 0) nr[pair] = ss;
  __syncthreads();
  if (tid < 8) {
    float m = 0.f;
    for (int t = 0; t < 32; ++t) m = fmaxf(m, nr[t * 8 + tid]);
    ((float*)(p.ws + OFF_KNORM))[((j >> 7) * 8 + tid) * 128 + (j & 127)] = m;
  }
  __syncthreads();
}
DI void gemm1_job(const Params& p, int j) {
  char* ws = p.ws;
  GemmOp g; g.lda = 2048; g.ldb = 4096;
  if (j < 64) {
    const int pm = j >> 4, split = j & 15;
    const bf16_t* ah = (const bf16_t*)(ws + OFF_KCIN_HI) + split * 256; const bf16_t* al = (const bf16_t*)(ws + OFF_KCIN_LO) + split * 256;
    const bf16_t* bh = (const bf16_t*)(ws + OFF_W1K_HI) + split * 256; const bf16_t* bl = (const bf16_t*)(ws + OFF_W1K_LO) + split * 256;
    g.A0 = ah; g.A1 = ah; g.A2 = al; g.B0 = bh; g.B1 = bl; g.B2 = bh; g.nt = 12; g.shift = 2;
    EpiF32 e{(float*)(ws + OFF_H1P_K) + (size_t)split * 1024 * 256, 256};
    gemm_tile(g, pm * 256, 0, e);
  } else {
    const int jj = j - 64, pm = jj >> 3, split = jj & 7;
    const bf16_t* ah = (const bf16_t*)(ws + OFF_VCIN) + split * 512; const bf16_t* bh = (const bf16_t*)(ws + OFF_W1V) + split * 512;
    g.A0 = g.A1 = g.A2 = ah; g.B0 = g.B1 = g.B2 = bh; g.nt = 8; g.shift = 3;
    EpiF32 e{(float*)(ws + OFF_H1P_V) + (size_t)split * 1024 * 256, 256};
    gemm_tile(g, pm * 256, 0, e);
  }
}

DI void gemm2_job(const Params& p, int j) {
  char* ws = p.ws;
  int tid = threadIdx.x; asm volatile("" : "+v"(tid));
  const bool isv = j >= 128; const int r0 = (j & 127) * 8;
  const float* part = (const float*)(ws + (isv ? OFF_H1P_V : OFF_H1P_K));
  const float* bias = (const float*)(ws + OFF_BIAS1) + (isv ? 16 * 256 : 0);
  const float* w2 = isv ? p.w_vc2 : p.w_kc2;
  float* hs = (float*)g_smem;
  float* w2s = hs + 2048;
  float* os = w2s;
  {
    const f32x4* w2v = (const f32x4*)w2;
#pragma unroll 16
    for (int i = 0; i < 16; ++i) ((f32x4*)w2s)[tid + i * 512] = w2v[tid + i * 512];
  }
  for (int idx = tid; idx < 2048; idx += 512) {
    const int row = idx >> 8, col = idx & 255;
    float s = 0.f;
#pragma unroll
    for (int c16 = 0; c16 < 16; ++c16) s += bias[c16 * 256 + col];
    const int nsp = isv ? 8 : 16;
    for (int sp = 0; sp < nsp; ++sp) s += part[((size_t)sp * 1024 + r0 + row) * 256 + col];
    hs[idx] = gelu_tanh(s);
  }
  __syncthreads();
  float a0 = 0.f, a1 = 0.f;
  {
    const int col = tid & 127, rp = tid >> 7;
#pragma unroll 8
    for (int k = 0; k < 256; ++k) { const float w = w2s[k * 128 + col]; a0 += hs[(rp * 2) * 256 + k] * w; a1 += hs[(rp * 2 + 1) * 256 + k] * w; }
  }
  __syncthreads();
  { const int col = tid & 127, rp = tid >> 7; os[(rp * 2) * 128 + col] = a0; os[(rp * 2 + 1) * 128 + col] = a1; }
  __syncthreads();
  if (!isv) {
    const int row = tid >> 6, i = tid & 63;
    const int rr = r0 + row, bg = rr >> 8, n = rr & 255;
    float y1 = 0.f, y2 = 0.f;
    if (n < 255) {
      const int tk = (bg >> 1) * 4096 + 16 * n + 31;
      const float cv = ((const float*)(ws + OFF_COS))[(size_t)tk * 64 + i], sv = ((const float*)(ws + OFF_SIN))[(size_t)tk * 64 + i];
      const float x1 = os[row * 128 + i], x2 = os[row * 128 + 64 + i];
      y1 = x1 * cv - x2 * sv; y2 = x2 * cv + x1 * sv;
    }
    bf16_t* kh_ = (bf16_t*)(ws + OFF_KC_HI) + (size_t)rr * 128; bf16_t* kl_ = (bf16_t*)(ws + OFF_KC_LO) + (size_t)rr * 128;
    kh_[i] = f2bf(y1); kh_[i + 64] = f2bf(y2); kl_[i] = f2bf(lo_of(y1)); kl_[i + 64] = f2bf(lo_of(y2));
  } else {
    for (int idx = tid; idx < 1024; idx += 512) {
      const int row = idx & 7, d = idx >> 3;
      const int rr = r0 + row, bg = rr >> 8, n = rr & 255;
      ((bf16_t*)(ws + OFF_VCT))[((size_t)bg * 128 + d) * 256 + n] = n < 255 ? f2bf(os[row * 128 + d]) : (bf16_t)0;
    }
  }
  __syncthreads();
}

DI void phase3(const Params& p) {
  FOR_JOBS(job, 96) gemm1_job(p, job);
  for (int job = (int)gridDim.x - 1 - (int)blockIdx.x; job < 16; job += gridDim.x) cumsum_job(p, job);
  for (int job = (int)gridDim.x - 1 - (int)blockIdx.x; job < 256; job += gridDim.x) knorm_job(p, job);
}
DI void phase4(const Params& p, bool dry) {
  if (!dry) { FOR_JOBS(job, 256) gemm2_job(p, job); }
  unsigned* qctr = (unsigned*)(p.ws + OFF_BAR) + (dry ? 3616 : 3600);
  volatile int* qslot = (volatile int*)(g_smem + 143360 - 32);
  for (;;) {
    if (threadIdx.x == 0) *qslot = (int)__hip_atomic_fetch_add(qctr, 1u, __ATOMIC_RELAXED, __HIP_MEMORY_SCOPE_AGENT);
    __syncthreads();
    const int u = *qslot;
    __syncthreads();
    if (u >= 1024) break;
    if (u < 512) { const int qt = 31 - (u >> 4), bh = u & 15; attn_unit<0>(p, bh >> 3, bh & 7, qt, dry); }
    else { const int v = u - 512; const int qt = 127 - (v >> 2), bg = v & 3; attn_unit<1>(p, bg >> 1, bg & 1, qt, dry); }
  }
}
DI void phase5(const Params& p, bool dry) {
  FOR_JOBS(job, 512) { const int qt = job >> 2, bg = job & 3; cmp_unit(p, bg >> 1, bg & 1, qt, dry); }
}
DI void phase6(const Params& p, bool dry) {
  unsigned* qctr = (unsigned*)(p.ws + OFF_BAR) + (dry ? 3648 : 3632);
  volatile int* qslot = (volatile int*)(g_smem + 143360 - 32);
  for (;;) {
    if (threadIdx.x == 0) *qslot = (int)__hip_atomic_fetch_add(qctr, 1u, __ATOMIC_RELAXED, __HIP_MEMORY_SCOPE_AGENT);
    __syncthreads();
    const int job = *qslot;
    __syncthreads();
    if (job >= 512) break;
    const int qt = 127 - (job >> 2), bg = job & 3; attn_unit<2>(p, bg >> 1, bg & 1, qt, dry);
  }
}

DI void outproj_phase(const Params& p) {
  char* ws = p.ws;
  FOR_JOBS(job, 256) {
    const int pn = job >> 5, pm = job & 31;
    GemmOp g; g.lda = 2048; g.ldb = 2048; g.nt = 32; g.shift = 5;
    g.A0 = g.A1 = g.A2 = (const bf16_t*)(ws + OFF_U_HI); g.B0 = g.B1 = g.B2 = (const bf16_t*)(ws + OFF_WOUT);
    EpiResid e{(float*)(ws + OFF_H1), p.x, (const float*)(ws + OFF_MOD) + 4096};
    gemm_tile(g, pm * 256, pn * 256, e);
  }
}
DI void gateup_phase(const Params& p) {
  char* ws = p.ws;
  FOR_JOBS(job, 44 * 32) {
    const int pn = job >> 5, pm = job & 31;
    GemmOp g; g.lda = 2048; g.ldb = 2048; g.nt = 32; g.shift = 5;
    g.A0 = g.A1 = g.A2 = (const bf16_t*)(ws + OFF_U_HI); g.B0 = g.B1 = g.B2 = (const bf16_t*)(ws + OFF_WGU);
    EpiSwiglu e{(bf16_t*)(ws + OFF_ACT)};
    gemm_tile(g, pm * 256, pn * 256, e);
  }
}
DI void down_phase(const Params& p) {
  char* ws = p.ws;
  FOR_JOBS(job, 256) {
    const int pn = job >> 5, pm = job & 31;
    GemmOp g; g.lda = DFF; g.ldb = DFF; g.nt = 88; g.shift = 20;
    g.A0 = g.A1 = g.A2 = (const bf16_t*)(ws + OFF_ACT); g.B0 = g.B1 = g.B2 = (const bf16_t*)(ws + OFF_WDN);
    EpiResid e{p.out, (const float*)(ws + OFF_H1), (const float*)(ws + OFF_MOD) + 10240};
    gemm_tile(g, pm * 256, pn * 256, e);
  }
}


#define XB_TMO      128
#define XB_XCNT(j)  (256  + 64 * (j))
#define XB_XSUB(j)  (1280 + 64 * (j))
#define XB_XGEN(j)  (2304 + 64 * (j))
#define XB_TOP      3328
#define XB_TOPGEN   3392
#define XCD_BAR_WORDS 3456
#define XB_SPIN_CAP (1u << 22)
#define LAS __attribute__((address_space(3)))
constexpr int LDS_BAR_OFF = 143360 - 16;
DI unsigned xb_ld(unsigned* p) { return __hip_atomic_load(p, __ATOMIC_RELAXED, __HIP_MEMORY_SCOPE_AGENT); }
DI unsigned xb_add(unsigned* p, unsigned v) { return __hip_atomic_fetch_add(p, v, __ATOMIC_RELAXED, __HIP_MEMORY_SCOPE_AGENT); }
DI unsigned xb_xcc_id() { return (unsigned)__builtin_amdgcn_s_getreg((3 << 11) | 20) & 0xFu; }
#define XB_SPIN(cond, bar) do { unsigned _sp = 0; while (cond) { __builtin_amdgcn_s_sleep(1); \
    if ((++_sp & 255u) == 0u) { if (xb_ld(&(bar)[XB_TMO])) break; if (_sp > XB_SPIN_CAP) { atomicAdd(&(bar)[XB_TMO], 1u); break; } } } } while (0)
struct XcdBarrier { unsigned* bar; unsigned x; volatile LAS unsigned* st; };
DI XcdBarrier xcd_barrier_post(unsigned* bar, volatile LAS unsigned* st) {
  XcdBarrier b; b.bar = bar; b.x = xb_xcc_id(); b.st = st;
  if (threadIdx.x == 0) (void)xb_add(&bar[XB_XCNT(b.x)], 1u);
  return b;
}
DI void xcd_barrier_complete(unsigned* bar, unsigned x, unsigned& nloc, unsigned& nx) {
  const unsigned G = gridDim.x * gridDim.y * gridDim.z;
  unsigned sum, cnt, mine, sp = 0u;
  for (;;) {
    sum = 0u; cnt = 0u; mine = 0u;
#pragma unroll
    for (unsigned j = 0; j < 16; ++j) { const unsigned c = xb_ld(&bar[XB_XCNT(j)]); sum += c; cnt += (c > 0u) ? 1u : 0u; mine = (j == x) ? c : mine; }
    if (sum == G) break;
    __builtin_amdgcn_s_sleep(1);
    if ((++sp & 255u) == 0u) { if (xb_ld(&bar[XB_TMO])) break; if (sp > XB_SPIN_CAP) { atomicAdd(&bar[XB_TMO], 1u); break; } }
  }
  nloc = mine > 0u ? mine : 1u; nx = cnt > 0u ? cnt : 1u;
}
DI void xcd_barrier(const XcdBarrier& b) {
  asm volatile("s_waitcnt vmcnt(0)" ::: "memory");
  __syncthreads();
  if (threadIdx.x == 0) {
    unsigned* bar = b.bar;
    __builtin_amdgcn_s_waitcnt(0);
    unsigned nloc = b.st[0], nx = b.st[1];
    if (nloc == 0u) { xcd_barrier_complete(bar, b.x, nloc, nx); b.st[0] = nloc; b.st[1] = nx; }
    const unsigned old = xb_add(&bar[XB_XSUB(b.x)], 1u);
    const unsigned gen = old / nloc;
    if (old + 1u == (gen + 1u) * nloc) {
      __builtin_amdgcn_fence(__ATOMIC_RELEASE, "agent");
      asm volatile("s_waitcnt vmcnt(0)" ::: "memory");
      const unsigned og = xb_add(&bar[XB_TOP], 1u);
      const unsigned tg = og / nx;
      if (og + 1u == (tg + 1u) * nx) xb_add(&bar[XB_TOPGEN], 1u);
      else XB_SPIN(xb_ld(&bar[XB_TOPGEN]) == tg, bar);
      __builtin_amdgcn_fence(__ATOMIC_ACQUIRE, "agent");
      xb_add(&bar[XB_XGEN(b.x)], 1u);
      asm volatile("s_waitcnt vmcnt(0)" ::: "memory");
    } else {
      XB_SPIN(xb_ld(&bar[XB_XGEN(b.x)]) == gen, bar);
      __builtin_amdgcn_fence(__ATOMIC_ACQUIRE, "agent");
      asm volatile("s_waitcnt vmcnt(0)" ::: "memory");
    }
  }
  __syncthreads();
}

#ifdef ONLY_PHASE
#define PH_ON(k) ((k) == ONLY_PHASE)
#else
#define PH_ON(k) 1
#endif
#ifndef REP_MASK
#define REP_MASK 0
#endif
#define RUN_PHASE(k, call) do { if (PH_ON(k) && ph0 <= (k) && (k) < ph1) { \
    _Pragma("unroll 1") for (int _r = 0; _r <= ((REP_MASK >> (k)) & 1); ++_r) { const bool _dry = ((REP_MASK >> (k)) & 1) && _r == 0; (void)_dry; if ((k) > ph0 || _r) GRID_SYNC(); call; } } } while (0)
#ifndef NSYNC_EXTRA
#define NSYNC_EXTRA 0
#endif
#define GRID_SYNC() xcd_barrier(xb)
__global__ void __launch_bounds__(512) hymba_mega(Params p, int ph0, int ph1) {
  volatile LAS unsigned* xst = (volatile LAS unsigned*)(g_smem + LDS_BAR_OFF);
  if (threadIdx.x == 0) { xst[0] = 0u; xst[1] = 0u; }
  __syncthreads();
  const XcdBarrier xb = xcd_barrier_post((unsigned*)(p.ws + OFF_BAR), xst);
  if (ph1 > 1000) cg::this_grid().sync();
  RUN_PHASE(0, phase0(p));
  RUN_PHASE(1, rmsmod_phase(p.x, p.norm_attn, (const float*)(p.ws + OFF_MOD), 0, 2048, (bf16_t*)(p.ws + OFF_U_HI), (bf16_t*)(p.ws + OFF_U_LO)));
  RUN_PHASE(2, inproj_phase(p, _dry));
  RUN_PHASE(3, phase3(p));
  RUN_PHASE(4, phase4(p, _dry));
  RUN_PHASE(5, phase5(p, _dry));
  RUN_PHASE(6, phase6(p, _dry));
  RUN_PHASE(7, ymix_phase(p));
  RUN_PHASE(8, outproj_phase(p));
  RUN_PHASE(9, rmsmod_phase((const float*)(p.ws + OFF_H1), p.norm_ffn, (const float*)(p.ws + OFF_MOD), 6144, 8192, (bf16_t*)(p.ws + OFF_U_HI), nullptr));
  RUN_PHASE(10, gateup_phase(p));
  RUN_PHASE(11, down_phase(p));
  RUN_PHASE(12, final_phase(p));
  _Pragma("unroll 1") for (int i = 0; i < NSYNC_EXTRA; ++i) GRID_SYNC();
}

extern "C" void kernel_launch(void* const* d_in, const int* in_sizes, int n_in, void* d_out, int out_size, void* d_ws, size_t ws_size,
                              hipStream_t stream) {
  Params p{};
  p.x = (const float*)d_in[0]; p.c = (const float*)d_in[1]; p.pos = (const int*)d_in[2];
  p.w_ada = (const float*)d_in[3]; p.b_ada = (const float*)d_in[4]; p.norm_attn = (const float*)d_in[5]; p.norm_ffn = (const float*)d_in[6];
  p.w_in = (const float*)d_in[7]; p.b_fgate = (const float*)d_in[8]; p.cmp_pos = (const float*)d_in[9];
  p.w_kc1 = (const float*)d_in[10]; p.w_kc2 = (const float*)d_in[11]; p.w_vc1 = (const float*)d_in[12]; p.w_vc2 = (const float*)d_in[13];
  p.beta_fox = (const float*)d_in[14]; p.beta_nsa = (const float*)d_in[15]; p.w_out = (const float*)d_in[16];
  p.w_gate = (const float*)d_in[17]; p.w_up = (const float*)d_in[18]; p.w_down = (const float*)d_in[19]; p.final_norm = (const float*)d_in[20];
  p.out = (float*)d_out; p.ws = (char*)d_ws;
  static int grid_blocks = 0;
  if (!grid_blocks) {
    hipFuncSetAttribute((const void*)hymba_mega, hipFuncAttributeMaxDynamicSharedMemorySize, LDS_BYTES);
    int dev = 0, cus = 0, per_cu = 0;
    hipGetDevice(&dev);
    hipDeviceGetAttribute(&cus, hipDeviceAttributeMultiprocessorCount, dev);
    hipOccupancyMaxActiveBlocksPerMultiprocessor(&per_cu, hymba_mega, 512, LDS_BYTES);
    if (per_cu < 1) per_cu = 1;
    grid_blocks = cus * per_cu;
    if (ws_size < WS_END) fprintf(stderr, "workspace too small: %zu < %zu\n", ws_size, (size_t)WS_END);
  }
  hipMemsetAsync((char*)d_ws + OFF_BAR, 0, 16384, stream);
#if N_LAUNCH_MODE == 1
  int ph0 = 0, ph1 = NPH;
  void* args[] = {&p, &ph0, &ph1};
  hipError_t e = hipLaunchCooperativeKernel((const void*)hymba_mega, dim3(grid_blocks), dim3(512), args, LDS_BYTES, stream);
  if (e != hipSuccess) fprintf(stderr, "cooperative launch failed: %s (grid %d)\n", hipGetErrorString(e), grid_blocks);
#else
  for (int ph = 0; ph < NPH; ++ph) hipLaunchKernelGGL(hymba_mega, dim3(grid_blocks), dim3(512), LDS_BYTES, stream, p, ph, ph + 1);
#endif
}
```

```cpp
#include <hip/hip_runtime.h>
#include <hip/hip_cooperative_groups.h>
#include <stdint.h>
#include <cstdio>
namespace cg = cooperative_groups;

#define DI __device__ __forceinline__
typedef unsigned short bf16_t;
typedef short bf16x8 __attribute__((ext_vector_type(8)));
typedef short s16x4 __attribute__((ext_vector_type(4)));
typedef float f32x4 __attribute__((ext_vector_type(4)));
typedef float f32x16 __attribute__((ext_vector_type(16)));
typedef unsigned u32x2 __attribute__((ext_vector_type(2)));
typedef unsigned u32x4 __attribute__((ext_vector_type(4)));

#ifndef DRY_MODE
#define DRY_MODE 0
#endif
#ifndef ATTN_PREFETCH
#define ATTN_PREFETCH 0
#endif
#ifndef N_LAUNCH_MODE
#define N_LAUNCH_MODE 1
#endif

constexpr int T_TOK = 8192, SEQ = 4096, DM = 2048, DFF = 5632, DIN = 5664;
constexpr int NPH = 13;
constexpr float LOG2E = 1.4426950408889634f;
constexpr float QK_C1 = 0.08838834764831845f * 1.4426950408889634f;

constexpr size_t al256(size_t x) { return (x + 255) & ~(size_t)255; }
constexpr size_t OFF_WIN_HI = 0;
constexpr size_t OFF_WIN_LO = OFF_WIN_HI + al256((size_t)5888 * 2048 * 2);
constexpr size_t OFF_WOUT = OFF_WIN_LO + al256((size_t)1280 * 2048 * 2);
constexpr size_t OFF_WGU = OFF_WOUT + al256((size_t)2048 * 2048 * 2);
constexpr size_t OFF_WDN = OFF_WGU + al256((size_t)11264 * 2048 * 2);
constexpr size_t OFF_W1K_HI = OFF_WDN + al256((size_t)2048 * 5632 * 2);
constexpr size_t OFF_W1K_LO = OFF_W1K_HI + al256((size_t)256 * 4096 * 2);
constexpr size_t OFF_W1V = OFF_W1K_LO + al256((size_t)256 * 4096 * 2);
constexpr size_t OFF_MOD = OFF_W1V + al256((size_t)256 * 4096 * 2);
constexpr size_t OFF_COS = OFF_MOD + al256((size_t)2 * 12288 * 4);
constexpr size_t OFF_SIN = OFF_COS + al256((size_t)8192 * 64 * 4);
constexpr size_t OFF_BIAS1 = OFF_SIN + al256((size_t)8192 * 64 * 4);
constexpr size_t OFF_U_HI = OFF_BIAS1 + al256((size_t)2 * 16 * 256 * 4);
constexpr size_t OFF_LOGF = OFF_U_HI + al256((size_t)8192 * 2048 * 2);
constexpr size_t OFF_CUM = OFF_LOGF + al256((size_t)8192 * 8 * 4);
constexpr size_t OFF_GATES = OFF_CUM + al256((size_t)16 * 4096 * 4);
constexpr size_t KCIN_BYTES = al256((size_t)(4 * 4096 + 64) * 128 * 2);
constexpr size_t OFF_KCIN_HI = OFF_GATES + al256((size_t)8192 * 24 * 4);
constexpr size_t OFF_KCIN_LO = OFF_KCIN_HI + KCIN_BYTES;
constexpr size_t OFF_VCIN = OFF_KCIN_LO + KCIN_BYTES;
constexpr size_t KV4_BYTES = (size_t)4 * 4096 * 128 * 2;
constexpr size_t OFF_KS = OFF_VCIN + KCIN_BYTES;
constexpr size_t OFF_VST = OFF_KS + KV4_BYTES;
constexpr size_t OFF_KW = OFF_VST + KV4_BYTES;
constexpr size_t OFF_VWT = OFF_KW + KV4_BYTES;
constexpr size_t OFF_H1P_K = OFF_VWT + KV4_BYTES;
constexpr size_t OFF_H1P_V = OFF_H1P_K + (size_t)16 * 1024 * 256 * 4;
constexpr size_t OFF_KC_HI = OFF_H1P_V + (size_t)8 * 1024 * 256 * 4;
constexpr size_t OFF_KC_LO = OFF_KC_HI + (size_t)4 * 256 * 128 * 2;
constexpr size_t OFF_VCT = OFF_KC_LO + (size_t)4 * 256 * 128 * 2;
constexpr size_t OFF_SEL = OFF_VCT + (size_t)4 * 256 * 128 * 2;
constexpr size_t OFF_OF32 = OFF_SEL + (size_t)4 * 4096 * 8;
constexpr size_t OFF_ON32 = OFF_OF32 + (size_t)8192 * 1024 * 4;
constexpr size_t OFF_H1 = OFF_OF32;
constexpr size_t OFF_RA = OFF_ON32 + (size_t)8192 * 1024 * 4;
constexpr size_t OFF_U_LO = OFF_RA;
constexpr size_t OFF_QF = OFF_U_LO + (size_t)8192 * 2048 * 2;
constexpr size_t OFF_KF = OFF_QF + (size_t)8192 * 1024 * 2;
constexpr size_t OFF_VFT = OFF_KF + (size_t)8192 * 1024 * 2;
constexpr size_t OFF_QN_HI = OFF_VFT + (size_t)8192 * 1024 * 2;
constexpr size_t OFF_QN_LO = OFF_QN_HI + (size_t)8192 * 1024 * 2;
constexpr size_t OFF_ACT = OFF_RA;
constexpr size_t OFF_KNORM = OFF_QN_LO + (size_t)8192 * 1024 * 2;
constexpr size_t OFF_BAR = OFF_KNORM + 8192;
constexpr size_t WS_END = OFF_BAR + 16384;

struct Params {
  const float *x, *c; const int* pos;
  const float *w_ada, *b_ada, *norm_attn, *norm_ffn, *w_in, *b_fgate, *cmp_pos, *w_kc1, *w_kc2, *w_vc1, *w_vc2,
      *beta_fox, *beta_nsa, *w_out, *w_gate, *w_up, *w_down, *final_norm;
  float* out; char* ws;
};

extern __shared__ __attribute__((aligned(16))) char g_smem[];
constexpr int LDS_BYTES = 143360;

__device__ const float c_inv_freq[64] = {
1.000000000e+00f,8.659643531e-01f,7.498942614e-01f,6.493816376e-01f,5.623413324e-01f,4.869675338e-01f,4.216965139e-01f,3.651741147e-01f,3.162277639e-01f,2.738419771e-01f,2.371373773e-01f,2.053525001e-01f,1.778279394e-01f,1.539926529e-01f,1.333521307e-01f,1.154782027e-01f,1.000000015e-01f,8.659642935e-02f,7.498941571e-02f,6.493816525e-02f,5.623413250e-02f,4.869675264e-02f,4.216965288e-02f,3.651741147e-02f,3.162277490e-02f,2.738419734e-02f,2.371373773e-02f,2.053525113e-02f,1.778279431e-02f,1.539926510e-02f,1.333521493e-02f,1.154782064e-02f,9.999999776e-03f,8.659643121e-03f,7.498941850e-03f,6.493816152e-03f,5.623413250e-03f,4.869675264e-03f,4.216964822e-03f,3.651741194e-03f,3.162277630e-03f,2.738419687e-03f,2.371373586e-03f,2.053524833e-03f,1.778279431e-03f,1.539926510e-03f,1.333521446e-03f,1.154781901e-03f,1.000000047e-03f,8.659643354e-04f,7.498942432e-04f,6.493816618e-04f,5.623413017e-04f,4.869675322e-04f,4.216965172e-04f,3.651741426e-04f,3.162277571e-04f,2.738419571e-04f,2.371373703e-04f,2.053525095e-04f,1.778279402e-04f,1.539926452e-04f,1.333521504e-04f,1.154782003e-04f};

DI unsigned short f2bf(float x) { unsigned u = __float_as_uint(x); u += 0x7fffu + ((u >> 16) & 1u); return (unsigned short)(u >> 16); }
DI float bf2f(unsigned short h) { return __uint_as_float(((unsigned)h) << 16); }
typedef float f32x2 __attribute__((ext_vector_type(2)));
typedef __bf16 bf16v2 __attribute__((ext_vector_type(2)));
DI unsigned pack2(float a, float b) { const f32x2 v = {a, b}; return __builtin_bit_cast(unsigned, __builtin_convertvector(v, bf16v2)); }
DI void split2(float a, float b, unsigned& hi, unsigned& lo) {
  hi = pack2(a, b);
  lo = pack2(a - __uint_as_float(hi << 16), b - __uint_as_float(hi & 0xffff0000u));
}
DI float lo_of(float x) { return x - bf2f(f2bf(x)); }
DI float wave_sum(float v) {
#pragma unroll
  for (int o = 32; o > 0; o >>= 1) v += __shfl_xor(v, o);
  return v;
}
DI float xmax32(float v) { auto r = __builtin_amdgcn_permlane32_swap(__float_as_uint(v), __float_as_uint(v), false, false); return fmaxf(__uint_as_float(r[0]), __uint_as_float(r[1])); }
DI float xsum32(float v) { auto r = __builtin_amdgcn_permlane32_swap(__float_as_uint(v), __float_as_uint(v), false, false); return __uint_as_float(r[0]) + __uint_as_float(r[1]); }
DI float fexp2(float x) { return __builtin_amdgcn_exp2f(x); }
DI float sigmoidf_(float x) { return 1.f / (1.f + __expf(-x)); }
DI float siluf_(float x) { return x / (1.f + __expf(-x)); }
DI float silu_fast(float x) { return x * __builtin_amdgcn_rcpf(1.f + __builtin_amdgcn_exp2f(-LOG2E * x)); }
DI float gelu_tanh(float x) { float u = 0.7978845608028654f * (x + 0.044715f * x * x * x); float e = __expf(2.f * u); float t = 1.f - 2.f / (e + 1.f); return 0.5f * x * (1.f + t); }
DI float log_sigmoid(float x) { return fminf(x, 0.f) - log1pf(__expf(-fabsf(x))); }
DI f32x16 mfma32(bf16x8 a, bf16x8 b, f32x16 c) { return __builtin_amdgcn_mfma_f32_32x32x16_bf16(a, b, c, 0, 0, 0); }
DI f32x16 zero16() { f32x16 z;
#pragma unroll
  for (int i = 0; i < 16; ++i) z[i] = 0.f; return z; }
DI int perm_gu(int w) { const int r = w & 31; return (w & 96) + ((r >> 2) & 1) * 16 + (r >> 3) * 4 + (r & 3); }
DI int perm256(int w) { const int hl = (w >> 7) & 1, d = w & 127, bj = d >> 6, q = (d & 63) >> 3, n = (d >> 2) & 1, j = d & 3; return bj * 128 + (hl * 2 + (q >> 2)) * 32 + n * 16 + (q & 3) * 4 + j; }
DI int perm128(int d) { return ((d >> 4) & 3) * 32 + (d >> 6) * 16 + (d & 15); }

#define FOR_JOBS(job, njobs) \
  for (int _r = 0, job; _r * (int)gridDim.x < (njobs); ++_r) \
    if ((job = _r * (int)gridDim.x + ((_r & 1) ? ((int)gridDim.x - 1 - (int)blockIdx.x) : (int)blockIdx.x)) < (njobs))

constexpr int BM = 256, BK = 64, HALF = 128, HTB = HALF * BK * 2;
DI int lds_byte(int r, int c) { int st = (r >> 4) * 2 + (c >> 5), rr = r & 15, cc = c & 31, ob = rr * 64 + cc * 2; return st * 1024 + (ob ^ (((ob >> 9) & 1) << 5)); }
DI void stage_rc(int b, int& R, int& C) { int st = b / 1024, sb = b % 1024, swz = sb ^ (((sb >> 9) & 1) << 5); R = (st >> 1) * 16 + swz / 64; C = (st & 1) * 32 + (swz % 64) / 2; }

DI const char* uptr(const char* p) {
  const unsigned long long v = (unsigned long long)p;
  const unsigned lo = __builtin_amdgcn_readfirstlane((unsigned)v), hi = __builtin_amdgcn_readfirstlane((unsigned)(v >> 32));
  return (const char*)(((unsigned long long)hi << 32) | lo);
}
struct GemmOp { const bf16_t *A0, *A1, *A2, *B0, *B1, *B2; int lda, ldb, nt, shift; };

template <class Epi>
DI void gemm_tile(const GemmOp& g, int brow, int bcol, const Epi& epi) {
#define SA(b, h) (g_smem + ((b) * 2 + (h)) * HTB)
#define SB(b, h) (g_smem + (4 + (b) * 2 + (h)) * HTB)
  int tid = threadIdx.x; asm volatile("" : "+v"(tid));
  const int wid = tid >> 6, lane = tid & 63, wr = wid >> 2, wc = wid & 3, fr = lane & 15, fq = lane >> 4;
  int r0, c0, r1, c1; stage_rc(tid * 16, r0, c0); stage_rc(tid * 16 + 8192, r1, c1);
  const unsigned oa0 = (unsigned)(r0 * g.lda + c0) * 2u, oa1 = (unsigned)(r1 * g.lda + c1) * 2u, ob0 = (unsigned)(r0 * g.ldb + c0) * 2u, ob1 = (unsigned)(r1 * g.ldb + c1) * 2u;
  const int mask = (1 << g.shift) - 1;
#define STAGE_A(P, half, kt) do { const int _s = (kt) >> g.shift; const char* _b = uptr((const char*)((_s == 0 ? g.A0 : (_s == 1 ? g.A1 : g.A2)) + (size_t)(brow + (half) * HALF) * g.lda + (size_t)((kt) & mask) * BK)); \
    __builtin_amdgcn_global_load_lds((const unsigned*)(_b + oa0), (unsigned*)((P) + tid * 16), 16, 0, 0); \
    __builtin_amdgcn_global_load_lds((const unsigned*)(_b + oa1), (unsigned*)((P) + tid * 16 + 8192), 16, 0, 0); } while (0)
#define STAGE_B(P, half, kt) do { const int _s = (kt) >> g.shift; const char* _b = uptr((const char*)((_s == 0 ? g.B0 : (_s == 1 ? g.B1 : g.B2)) + (size_t)(bcol + (half) * HALF) * g.ldb + (size_t)((kt) & mask) * BK)); \
    __builtin_amdgcn_global_load_lds((const unsigned*)(_b + ob0), (unsigned*)((P) + tid * 16), 16, 0, 0); \
    __builtin_amdgcn_global_load_lds((const unsigned*)(_b + ob1), (unsigned*)((P) + tid * 16 + 8192), 16, 0, 0); } while (0)
#define LDA(dst, b, h) for (int m = 0; m < 4; ++m) for (int k = 0; k < 2; ++k) \
    dst[m][k] = *reinterpret_cast<const bf16x8*>(SA(b, h) + lds_byte(wr * 64 + m * 16 + fr, k * 32 + fq * 8))
#define LDB(dst, b, h) for (int n = 0; n < 2; ++n) for (int k = 0; k < 2; ++k) \
    dst[n][k] = *reinterpret_cast<const bf16x8*>(SB(b, h) + lds_byte(wc * 32 + n * 16 + fr, k * 32 + fq * 8))
#define MMA(ai, bj, At_, Bt_) do { __builtin_amdgcn_s_setprio(1); \
    for (int m = 0; m < 4; ++m) for (int n = 0; n < 2; ++n) for (int k = 0; k < 2; ++k) \
      acc[ai][bj][m][n] = __builtin_amdgcn_mfma_f32_16x16x32_bf16(Bt_[n][k], At_[m][k], acc[ai][bj][m][n], 0, 0, 0); \
    __builtin_amdgcn_s_setprio(0); } while (0)
#define WAIT_V(n) asm volatile("s_waitcnt vmcnt(" #n ")" ::: "memory")
#define WAIT_L(n) asm volatile("s_waitcnt lgkmcnt(" #n ")" ::: "memory")
#define BAR __builtin_amdgcn_s_barrier()
#define SCHED __builtin_amdgcn_sched_barrier(0)
  f32x4 acc[2][2][4][2] = {};
  bf16x8 At[4][2], B0[2][2], B1[2][2];
  const int nt = g.nt;
  STAGE_B(SB(0, 0), 0, 0); STAGE_A(SA(0, 0), 0, 0);
  STAGE_B(SB(0, 1), 1, 0); STAGE_A(SA(0, 1), 1, 0);
  if (wr == 1) BAR;
  WAIT_V(4); BAR;
  STAGE_B(SB(1, 0), 0, 1); STAGE_A(SA(1, 0), 0, 1); STAGE_B(SB(1, 1), 1, 1);
  WAIT_V(6); BAR;
  for (int t = 0; t < nt - 2; t += 2) {
    LDB(B0, 0, 0); SCHED; LDA(At, 0, 0); STAGE_A(SA(1, 1), 1, t + 1);
    WAIT_L(8); BAR; WAIT_L(0); MMA(0, 0, At, B0); BAR; SCHED;
    LDB(B1, 0, 1); STAGE_B(SB(0, 0), 0, t + 2);
    BAR; WAIT_L(0); MMA(0, 1, At, B1); BAR;
    LDA(At, 0, 1); STAGE_A(SA(0, 0), 0, t + 2);
    BAR; WAIT_L(0); MMA(1, 0, At, B0); BAR; SCHED;
    STAGE_B(SB(0, 1), 1, t + 2);
    WAIT_V(6); BAR; MMA(1, 1, At, B1); BAR;
    LDB(B0, 1, 0); SCHED; LDA(At, 1, 0); STAGE_A(SA(0, 1), 1, t + 2);
    WAIT_L(8); BAR; WAIT_L(0); MMA(0, 0, At, B0); BAR; SCHED;
    LDB(B1, 1, 1); STAGE_B(SB(1, 0), 0, t + 3);
    BAR; WAIT_L(0); MMA(0, 1, At, B1); BAR;
    LDA(At, 1, 1); STAGE_A(SA(1, 0), 0, t + 3);
    BAR; WAIT_L(0); MMA(1, 0, At, B0); BAR; SCHED;
    STAGE_B(SB(1, 1), 1, t + 3);
    WAIT_V(6); BAR; MMA(1, 1, At, B1); BAR;
  }
  { LDB(B0, 0, 0); LDA(At, 0, 0); STAGE_A(SA(1, 1), 1, nt - 1);
    BAR; WAIT_L(0); MMA(0, 0, At, B0); BAR;
    LDB(B1, 0, 1); BAR; WAIT_L(0); MMA(0, 1, At, B1); BAR;
    LDA(At, 0, 1); WAIT_V(4); BAR; WAIT_L(0); MMA(1, 0, At, B0); MMA(1, 1, At, B1); BAR; }
  { LDB(B0, 1, 0); LDA(At, 1, 0); WAIT_V(2); BAR; WAIT_L(0); MMA(0, 0, At, B0); BAR;
    LDB(B1, 1, 1); WAIT_V(0); BAR; WAIT_L(0); MMA(0, 1, At, B1); BAR;
    LDA(At, 1, 1); BAR; WAIT_L(0); MMA(1, 0, At, B0); MMA(1, 1, At, B1); BAR; }
  if (wr == 0) BAR;
  { int t2 = tid; asm volatile("" : "+v"(t2)); const int w2 = t2 >> 6, l2 = t2 & 63; epi(acc, brow, bcol, w2 >> 2, w2 & 3, l2 & 15, l2 >> 4); }
  __syncthreads();
#undef SA
#undef SB
}

typedef f32x4 AccT[2][2][4][2];

struct EpiInproj {
  const Params* p; int pn;
  DI void operator()(const AccT& acc, int brow, int bcol, int wr, int wc, int fr, int fq) const {
    char* ws = p->ws;
    const float* cs = (const float*)(ws + OFF_COS); const float* sn = (const float*)(ws + OFF_SIN);
    const int hl = wc >> 1, dlo = ((wc & 1) * 4 + fq) * 8;
    const bool rope = (pn >= 12 && pn < 16) || pn == 18 || pn == 20;
#pragma unroll
    for (int ai = 0; ai < 2; ++ai)
#pragma unroll
      for (int m = 0; m < 4; ++m) {
        const int token = brow + ai * 128 + wr * 64 + m * 16 + fr;
        const int b = token >> 12, s = token & 4095;
        f32x4 a0 = acc[ai][0][m][0], a1 = acc[ai][0][m][1], b0 = acc[ai][1][m][0], b1 = acc[ai][1][m][1];
        if (rope) {
          const f32x4 c0 = *(const f32x4*)(cs + (size_t)token * 64 + dlo), c1 = *(const f32x4*)(cs + (size_t)token * 64 + dlo + 4);
          const f32x4 s0 = *(const f32x4*)(sn + (size_t)token * 64 + dlo), s1 = *(const f32x4*)(sn + (size_t)token * 64 + dlo + 4);
          const f32x4 y0 = a0 * c0 - b0 * s0, y1 = a1 * c1 - b1 * s1, z0 = b0 * c0 + a0 * s0, z1 = b1 * c1 + a1 * s1;
          a0 = y0; a1 = y1; b0 = z0; b1 = z1;
        }
        unsigned h[8], l[8];
        split2(a0[0], a0[1], h[0], l[0]); split2(a0[2], a0[3], h[1], l[1]); split2(a1[0], a1[1], h[2], l[2]); split2(a1[2], a1[3], h[3], l[3]);
        split2(b0[0], b0[1], h[4], l[4]); split2(b0[2], b0[3], h[5], l[5]); split2(b1[0], b1[1], h[6], l[6]); split2(b1[2], b1[3], h[7], l[7]);
        size_t o; size_t off_hi; size_t off_lo = 0; bool has_lo = false;
        if (pn < 8) { o = (size_t)token * 1024 + ((pn & 3) * 2 + hl) * 128 + dlo; off_hi = pn < 4 ? OFF_QF : OFF_KF; }
        else if (pn < 16) { o = (size_t)token * 1024 + ((pn - 12) * 2 + hl) * 128 + dlo; off_hi = OFF_QN_HI; off_lo = OFF_QN_LO; has_lo = true; }
        else {
          o = ((size_t)(b * 2 + hl) * 4096 + s) * 128 + dlo;
          off_hi = pn == 16 ? OFF_KCIN_HI : (pn == 17 ? OFF_VCIN : (pn == 18 ? OFF_KS : OFF_KW));
          if (pn == 16) { off_lo = OFF_KCIN_LO; has_lo = true; }
        }
        bf16_t* dh = (bf16_t*)(ws + off_hi) + o;
        *(u32x4*)dh = (u32x4){h[0], h[1], h[2], h[3]};
        *(u32x4*)(dh + 64) = (u32x4){h[4], h[5], h[6], h[7]};
        if (has_lo) {
          bf16_t* dl = (bf16_t*)(ws + off_lo) + o;
          *(u32x4*)dl = (u32x4){l[0], l[1], l[2], l[3]};
          *(u32x4*)(dl + 64) = (u32x4){l[4], l[5], l[6], l[7]};
        }
      }
  }
};

struct EpiVT {
  bf16_t* dst; int nheads; int sec_row0;
  DI void operator()(const AccT& acc, int brow, int bcol, int wr, int wc, int fr, int fq) const {
#pragma unroll
    for (int ai = 0; ai < 2; ++ai)
#pragma unroll
      for (int m = 0; m < 4; ++m) {
        const int vr = brow - sec_row0 + ai * 128 + wr * 64 + m * 16 + fr;
        const int head = vr >> 7, d = vr & 127;
#pragma unroll
        for (int bj = 0; bj < 2; ++bj)
#pragma unroll
          for (int n = 0; n < 2; ++n) {
            const int tk = bcol + bj * 128 + wc * 32 + n * 16 + fq * 4;
            const int b = tk >> 12, s = tk & 4095;
            const f32x4 v = acc[ai][bj][m][n];
            *(u32x2*)(dst + ((size_t)(b * nheads + head) * 128 + d) * 4096 + s) = (u32x2){pack2(v[0], v[1]), pack2(v[2], v[3])};
          }
      }
  }
};

struct EpiF32 {
  float* dst; int ld;
  DI void operator()(const AccT& acc, int brow, int bcol, int wr, int wc, int fr, int fq) const {
#pragma unroll
    for (int ai = 0; ai < 2; ++ai)
#pragma unroll
      for (int m = 0; m < 4; ++m) {
        const int row = brow + ai * 128 + wr * 64 + m * 16 + fr;
#pragma unroll
        for (int bj = 0; bj < 2; ++bj)
#pragma unroll
          for (int n = 0; n < 2; ++n)
            *(f32x4*)(dst + (size_t)row * ld + bcol + bj * 128 + wc * 32 + n * 16 + fq * 4) = acc[ai][bj][m][n];
      }
  }
};

struct EpiResid {
  float* dst; const float* base; const float* gate;
  DI void operator()(const AccT& acc, int brow, int bcol, int wr, int wc, int fr, int fq) const {
#pragma unroll
    for (int ai = 0; ai < 2; ++ai)
#pragma unroll
      for (int m = 0; m < 4; ++m) {
        const int row = brow + ai * 128 + wr * 64 + m * 16 + fr;
        const int b = row >> 12;
#pragma unroll
        for (int bj = 0; bj < 2; ++bj)
#pragma unroll
          for (int n = 0; n < 2; ++n) {
            const int col = bcol + bj * 128 + wc * 32 + n * 16 + fq * 4;
            const f32x4 xv = *(const f32x4*)(base + (size_t)row * 2048 + col);
            const f32x4 gv = *(const f32x4*)(gate + b * 12288 + col);
            *(f32x4*)(dst + (size_t)row * 2048 + col) = xv + gv * acc[ai][bj][m][n];
          }
      }
  }
};

struct EpiSwiglu {
  bf16_t* act;
  DI void operator()(const AccT& acc, int brow, int bcol, int wr, int wc, int fr, int fq) const {
    const int pn = bcol >> 8;
#pragma unroll
    for (int ai = 0; ai < 2; ++ai)
#pragma unroll
      for (int m = 0; m < 4; ++m) {
        const int row = brow + ai * 128 + wr * 64 + m * 16 + fr;
        float r[8];
#pragma unroll
        for (int n = 0; n < 2; ++n) {
          const f32x4 gt = acc[ai][0][m][n], up = acc[ai][1][m][n];
#pragma unroll
          for (int j = 0; j < 4; ++j) r[n * 4 + j] = silu_fast(gt[j]) * up[j];
        }
        *(u32x4*)(act + (size_t)row * DFF + pn * 128 + wc * 32 + fq * 8) = (u32x4){pack2(r[0], r[1]), pack2(r[2], r[3]), pack2(r[4], r[5]), pack2(r[6], r[7])};
      }
  }
};

DI int map_win(int c, int& lo_row) {
  lo_row = -1;
  if (c < 2048) return (c & ~255) + perm256(c & 255);
  if (c < 3072) return c;
  if (c < 3080) return 5632 + (c - 3072);
  if (c < 4104) { int cc = c - 3080; int d = 3072 + (cc & ~255) + perm256(cc & 255); lo_row = d - 3072; return d; }
  if (c < 4360) { int cc = c - 4104; int d = 4096 + perm256(cc); lo_row = d - 3072; return d; }
  if (c < 4616) { int cc = c - 4360; return 4352 + perm256(cc); }
  if (c < 4872) { int cc = c - 4616; return 4608 + perm256(cc); }
  if (c < 5128) return 4864 + (c - 4872);
  if (c < 5384) { int cc = c - 5128; return 5120 + perm256(cc); }
  if (c < 5640) return 5376 + (c - 5384);
  return c;
}

struct TInfo { const float* src; bf16_t* dh; bf16_t* dl; int N, Kd, mat, k0, n0; };
constexpr int TJ_WIN = 16 * 89, TJ_WOUT = 16 * 32, TJ_WG = 16 * 88, TJ_WD = 44 * 32, TJ_W1 = 32 * 4;
constexpr int TE0 = TJ_WIN, TE1 = TE0 + TJ_WOUT, TE2 = TE1 + TJ_WG, TE3 = TE2 + TJ_WG, TE4 = TE3 + TJ_WD, TE5 = TE4 + TJ_W1, TE6 = TE5 + TJ_W1;
DI void tile_info(const Params& p, int t, TInfo& ti) {
  char* ws = p.ws; ti.dl = nullptr; int nn;
  if (t < TE0) { ti.mat = 0; ti.src = p.w_in; ti.N = DIN; ti.Kd = 2048; ti.dh = (bf16_t*)(ws + OFF_WIN_HI); ti.dl = (bf16_t*)(ws + OFF_WIN_LO); nn = 89; }
  else if (t < TE1) { t -= TE0; ti.mat = 1; ti.src = p.w_out; ti.N = 2048; ti.Kd = 2048; ti.dh = (bf16_t*)(ws + OFF_WOUT); nn = 32; }
  else if (t < TE2) { t -= TE1; ti.mat = 2; ti.src = p.w_gate; ti.N = DFF; ti.Kd = 2048; ti.dh = (bf16_t*)(ws + OFF_WGU); nn = 88; }
  else if (t < TE3) { t -= TE2; ti.mat = 3; ti.src = p.w_up; ti.N = DFF; ti.Kd = 2048; ti.dh = (bf16_t*)(ws + OFF_WGU); nn = 88; }
  else if (t < TE4) { t -= TE3; ti.mat = 4; ti.src = p.w_down; ti.N = 2048; ti.Kd = DFF; ti.dh = (bf16_t*)(ws + OFF_WDN); nn = 32; }
  else if (t < TE5) { t -= TE4; ti.mat = 5; ti.src = p.w_kc1; ti.N = 256; ti.Kd = 4096; ti.dh = (bf16_t*)(ws + OFF_W1K_HI); ti.dl = (bf16_t*)(ws + OFF_W1K_LO); nn = 4; }
  else { t -= TE5; ti.mat = 6; ti.src = p.w_vc1; ti.N = 256; ti.Kd = 4096; ti.dh = (bf16_t*)(ws + OFF_W1V); nn = 4; }
  ti.k0 = (t / nn) * 128; ti.n0 = (t % nn) * 64;
}
DI void tr_load(const TInfo& ti, int tid, f32x4 (&r)[4]) {
#pragma unroll
  for (int i = 0; i < 4; ++i) {
    const int idx = tid + i * 512, k = idx >> 4, col = ti.n0 + (idx & 15) * 4;
    r[i] = col < ti.N ? *(const f32x4*)(ti.src + (size_t)(ti.k0 + k) * ti.N + col) : (f32x4){0.f, 0.f, 0.f, 0.f};
  }
}
DI void tr_lds_write(float* tile, int tid, const f32x4 (&r)[4]) {
#pragma unroll
  for (int i = 0; i < 4; ++i) {
    const int idx = tid + i * 512, k = idx >> 4, c = (idx & 15) * 4;
#pragma unroll
    for (int j = 0; j < 4; ++j) tile[k * 65 + c + j] = r[i][j];
  }
}
DI void tr_store(const TInfo& ti, const float* tile, int tid) {
#pragma unroll
  for (int i = 0; i < 2; ++i) {
    const int idx = tid + i * 512, nr = idx >> 4, kc = idx & 15, col = ti.n0 + nr;
    if (col < ti.N) {
      int row, lrow = -1;
      if (ti.mat == 0) row = map_win(col, lrow);
      else if (ti.mat == 2) row = (col >> 7) * 256 + perm_gu(col & 127);
      else if (ti.mat == 3) row = (col >> 7) * 256 + 128 + perm_gu(col & 127);
      else { row = col; if (ti.mat == 5) lrow = col; }
      float v[8];
#pragma unroll
      for (int e = 0; e < 8; ++e) v[e] = tile[(kc * 8 + e) * 65 + nr];
      *(u32x4*)(ti.dh + (size_t)row * ti.Kd + ti.k0 + kc * 8) = (u32x4){pack2(v[0], v[1]), pack2(v[2], v[3]), pack2(v[4], v[5]), pack2(v[6], v[7])};
      if (lrow >= 0)
        *(u32x4*)(ti.dl + (size_t)lrow * ti.Kd + ti.k0 + kc * 8) = (u32x4){pack2(lo_of(v[0]), lo_of(v[1])), pack2(lo_of(v[2]), lo_of(v[3])), pack2(lo_of(v[4]), lo_of(v[5])), pack2(lo_of(v[6]), lo_of(v[7]))};
    }
  }
}
DI void transpose_all(const Params& p) {
  float* lds = (float*)g_smem;
  int tid = threadIdx.x; asm volatile("" : "+v"(tid));
  const int G = gridDim.x;
  int t0 = blockIdx.x, t1 = t0 + G;
  TInfo ia, ib; f32x4 ra[4], rb[4];
  if (t0 < TE6) { tile_info(p, t0, ia); tr_load(ia, tid, ra); }
  if (t1 < TE6) { tile_info(p, t1, ib); tr_load(ib, tid, rb); }
  while (t0 < TE6) {
    tr_lds_write(lds, tid, ra);
    __syncthreads();
    const TInfo cura = ia;
    const int t2 = t0 + 2 * G;
    if (t2 < TE6) { tile_info(p, t2, ia); tr_load(ia, tid, ra); }
    tr_store(cura, lds, tid);
    if (t1 >= TE6) break;
    tr_lds_write(lds + 128 * 65, tid, rb);
    __syncthreads();
    const TInfo curb = ib;
    const int t3 = t1 + 2 * G;
    if (t3 < TE6) { tile_info(p, t3, ib); tr_load(ib, tid, rb); }
    tr_store(curb, lds + 128 * 65, tid);
    t0 = t2; t1 = t3;
  }
  __syncthreads();
}

DI void mod_job(const Params& p, int job) {
  float* sc = (float*)g_smem;
  float* red = sc + 4096;
  const int tid = threadIdx.x, wave = tid >> 6, lane = tid & 63;
  for (int i = tid; i < 4096; i += 512) sc[i] = siluf_(p.c[i]);
  __syncthreads();
  const int n0 = job * 64, cgp = lane & 15, kr = lane >> 4;
  f32x4 a0 = {0.f, 0.f, 0.f, 0.f}, a1 = {0.f, 0.f, 0.f, 0.f};
#pragma unroll 8
  for (int k = wave * 4 + kr; k < 2048; k += 32) {
    const f32x4 wv = *(const f32x4*)(p.w_ada + (size_t)k * 12288 + n0 + cgp * 4);
    a0 += wv * sc[k]; a1 += wv * sc[2048 + k];
  }
#pragma unroll
  for (int j = 0; j < 4; ++j) {
    a0[j] += __shfl_xor(a0[j], 16); a0[j] += __shfl_xor(a0[j], 32);
    a1[j] += __shfl_xor(a1[j], 16); a1[j] += __shfl_xor(a1[j], 32);
  }
  if (kr == 0) {
#pragma unroll
    for (int j = 0; j < 4; ++j) { red[(wave * 2 + 0) * 64 + cgp * 4 + j] = a0[j]; red[(wave * 2 + 1) * 64 + cgp * 4 + j] = a1[j]; }
  }
  __syncthreads();
  if (tid < 128) {
    const int b = tid >> 6, col = tid & 63;
    float s = p.b_ada[n0 + col];
#pragma unroll
    for (int w = 0; w < 8; ++w) s += red[(w * 2 + b) * 64 + col];
    ((float*)(p.ws + OFF_MOD))[b * 12288 + n0 + col] = s;
  }
  __syncthreads();
}

DI void bias1_job(const Params& p, int j) {
  const int which = j >> 4, chunk = j & 15;
  const float* w1 = which ? p.w_vc1 : p.w_kc1;
  float* red = (float*)g_smem;
  const int tid = threadIdx.x, col = tid & 255, half = tid >> 8;
  float s = 0.f;
  const int kb = chunk * 256 + half * 128;
#pragma unroll 16
  for (int k = kb; k < kb + 128; ++k) s += p.cmp_pos[k] * w1[(size_t)k * 256 + col];
  red[tid] = s;
  __syncthreads();
  if (tid < 256) ((float*)(p.ws + OFF_BIAS1))[(which * 16 + chunk) * 256 + tid] = red[tid] + red[tid + 256];
  __syncthreads();
}

DI void rope_job(const Params& p, int job) {
  const int idx = job * 512 + threadIdx.x, token = idx >> 6, i = idx & 63;
  const float ang = (float)p.pos[token] * c_inv_freq[i];
  double t = (double)ang * 0.15915494309189535;
  t -= floor(t + 0.5);
  const float tf = (float)t;
  ((float*)(p.ws + OFF_COS))[idx] = __builtin_amdgcn_cosf(tf);
  ((float*)(p.ws + OFF_SIN))[idx] = __builtin_amdgcn_sinf(tf);
}

DI void phase0(const Params& p) {
  transpose_all(p);
  constexpr int J_MOD = 192, J_B1 = 32, J_ROPE = 1024;
  for (int job = blockIdx.x; job < J_MOD + J_B1 + J_ROPE; job += gridDim.x) {
    if (job < J_MOD) mod_job(p, job);
    else if (job < J_MOD + J_B1) bias1_job(p, job - J_MOD);
    else rope_job(p, job - J_MOD - J_B1);
  }
}

DI void rmsmod_phase(const float* src, const float* g, const float* mod, int sh_off, int sc_off, bf16_t* dhi, bf16_t* dlo) {
  const int wave = threadIdx.x >> 6, lane = threadIdx.x & 63;
  for (int row = blockIdx.x * 8 + wave; row < T_TOK; row += gridDim.x * 8) {
    const int b = row >> 12;
    const f32x4* xr = (const f32x4*)(src + (size_t)row * 2048);
    f32x4 v[8]; float ss = 0.f;
#pragma unroll
    for (int i = 0; i < 8; ++i) { v[i] = xr[lane + i * 64]; ss += v[i][0] * v[i][0] + v[i][1] * v[i][1] + v[i][2] * v[i][2] + v[i][3] * v[i][3]; }
    ss = wave_sum(ss);
    const float rstd = rsqrtf(ss * (1.f / 2048.f) + 1e-6f);
#pragma unroll
    for (int i = 0; i < 8; ++i) {
      const int col = (lane + i * 64) * 4;
      const f32x4 gv = *(const f32x4*)(g + col);
      const f32x4 sc = *(const f32x4*)(mod + b * 12288 + sc_off + col), sh = *(const f32x4*)(mod + b * 12288 + sh_off + col);
      f32x4 u = (v[i] * rstd) * gv; u = u * (1.f + sc) + sh;
      unsigned h0, h1, l0, l1; split2(u[0], u[1], h0, l0); split2(u[2], u[3], h1, l1);
      *(u32x2*)(dhi + (size_t)row * 2048 + col) = (u32x2){h0, h1};
      if (dlo) *(u32x2*)(dlo + (size_t)row * 2048 + col) = (u32x2){l0, l1};
    }
  }
}

DI void ymix_phase(const Params& p) {
  const int wave = threadIdx.x >> 6, lane = threadIdx.x & 63;
  bf16_t* ym = (bf16_t*)(p.ws + OFF_U_HI);
  for (int row = blockIdx.x * 8 + wave; row < T_TOK; row += gridDim.x * 8) {
#pragma unroll
    for (int part = 0; part < 2; ++part) {
      const f32x4* xr = (const f32x4*)((const float*)(p.ws + (part ? OFF_ON32 : OFF_OF32)) + (size_t)row * 1024);
      const float* beta = part ? p.beta_nsa : p.beta_fox;
      f32x4 v[4]; float ss = 0.f;
#pragma unroll
      for (int i = 0; i < 4; ++i) { v[i] = xr[lane + i * 64]; ss += v[i][0] * v[i][0] + v[i][1] * v[i][1] + v[i][2] * v[i][2] + v[i][3] * v[i][3]; }
      ss = wave_sum(ss);
      const float rstd = rsqrtf(ss * (1.f / 1024.f) + 1e-6f);
#pragma unroll
      for (int i = 0; i < 4; ++i) {
        const int col = (lane + i * 64) * 4;
        const f32x4 u = (v[i] * rstd) * *(const f32x4*)(beta + col);
        *(u32x2*)(ym + (size_t)row * 2048 + part * 1024 + col) = (u32x2){pack2(u[0], u[1]), pack2(u[2], u[3])};
      }
    }
  }
}

DI void final_phase(const Params& p) {
  const int wave = threadIdx.x >> 6, lane = threadIdx.x & 63;
  for (int row = blockIdx.x * 8 + wave; row < T_TOK; row += gridDim.x * 8) {
    f32x4* xr = (f32x4*)(p.out + (size_t)row * 2048);
    f32x4 v[8]; float ss = 0.f;
#pragma unroll
    for (int i = 0; i < 8; ++i) { v[i] = xr[lane + i * 64]; ss += v[i][0] * v[i][0] + v[i][1] * v[i][1] + v[i][2] * v[i][2] + v[i][3] * v[i][3]; }
    ss = wave_sum(ss);
    const float rstd = rsqrtf(ss * (1.f / 2048.f) + 1e-6f);
#pragma unroll
    for (int i = 0; i < 8; ++i) xr[lane + i * 64] = (v[i] * rstd) * *(const f32x4*)(p.final_norm + (lane + i * 64) * 4);
  }
}

typedef float f32x4_ __attribute__((ext_vector_type(4)));
DI void misc_job(const Params& p, int piece) {
  char* ws = p.ws;
  int tid = threadIdx.x; asm volatile("" : "+v"(tid));
  const int wave = tid >> 6, lane = tid & 63, fr = lane & 15, fq = lane >> 4;
  const bf16_t* A = (const bf16_t*)(ws + OFF_U_HI) + (size_t)(piece * 32 + fr) * 2048 + fq * 8 + wave * 256;
  const bf16_t* B = (const bf16_t*)(ws + OFF_WIN_HI) + (size_t)(5632 + fr) * 2048 + fq * 8 + wave * 256;
  f32x4 acc[2][2] = {};
#pragma unroll
  for (int k = 0; k < 8; ++k) {
    const bf16x8 a0 = *(const bf16x8*)(A + k * 32), a1 = *(const bf16x8*)(A + 16 * 2048 + k * 32);
    const bf16x8 b0 = *(const bf16x8*)(B + k * 32), b1 = *(const bf16x8*)(B + 16 * 2048 + k * 32);
    acc[0][0] = __builtin_amdgcn_mfma_f32_16x16x32_bf16(a0, b0, acc[0][0], 0, 0, 0);
    acc[0][1] = __builtin_amdgcn_mfma_f32_16x16x32_bf16(a0, b1, acc[0][1], 0, 0, 0);
    acc[1][0] = __builtin_amdgcn_mfma_f32_16x16x32_bf16(a1, b0, acc[1][0], 0, 0, 0);
    acc[1][1] = __builtin_amdgcn_mfma_f32_16x16x32_bf16(a1, b1, acc[1][1], 0, 0, 0);
  }
  f32x4* red = (f32x4*)g_smem;
#pragma unroll
  for (int q = 0; q < 4; ++q) red[(wave * 4 + q) * 64 + lane] = acc[q >> 1][q & 1];
  __syncthreads();
  if (tid < 256) {
    const int q = tid >> 6, l = tid & 63, mb = q >> 1, nb = q & 1, fr2 = l & 15, fq2 = l >> 4;
    f32x4 sum = red[q * 64 + l];
#pragma unroll
    for (int w = 1; w < 8; ++w) sum += red[(w * 4 + q) * 64 + l];
    const int col = nb * 16 + fr2;
#pragma unroll
    for (int j = 0; j < 4; ++j) {
      const int token = piece * 32 + mb * 16 + fq2 * 4 + j;
      if (col < 8) ((float*)(ws + OFF_LOGF))[token * 8 + col] = log_sigmoid(sum[j] + p.b_fgate[col]);
      else ((float*)(ws + OFF_GATES))[token * 24 + col - 8] = sigmoidf_(sum[j]);
    }
  }
  __syncthreads();
}
DI void inproj_heavy(const Params& p, int job) {
  char* ws = p.ws;
  const bf16_t* uhi = (const bf16_t*)(ws + OFF_U_HI); const bf16_t* ulo = (const bf16_t*)(ws + OFF_U_LO);
  const bf16_t* whi = (const bf16_t*)(ws + OFF_WIN_HI); const bf16_t* wlo = (const bf16_t*)(ws + OFF_WIN_LO);
  const int pn = 12 + job / 32, pm = job % 32;
  GemmOp g; g.lda = 2048; g.ldb = 2048;
  g.A0 = uhi; g.A1 = uhi; g.A2 = ulo; g.B0 = whi; g.B1 = wlo - (size_t)3072 * 2048; g.B2 = whi; g.nt = 96; g.shift = 5;
  EpiInproj e{&p, pn};
  gemm_tile(g, pm * 256, pn * 256, e);
}
DI void inproj_light(const Params& p, int L) {
  char* ws = p.ws;
  const bf16_t* uhi = (const bf16_t*)(ws + OFF_U_HI); const bf16_t* whi = (const bf16_t*)(ws + OFF_WIN_HI);
  GemmOp g; g.lda = 2048; g.ldb = 2048; g.nt = 32; g.shift = 5;
  if (L < 352) {
    const int t = L / 32, pm = L % 32;
    const int pn = t < 8 ? t : (t == 8 ? 17 : (t == 9 ? 18 : 20));
    g.A0 = g.A1 = g.A2 = uhi; g.B0 = g.B1 = g.B2 = whi;
    EpiInproj e{&p, pn};
    gemm_tile(g, pm * 256, pn * 256, e);
  } else {
    const int j = L - 352, rt = j / 32, tt = j % 32;
    int wrow; bf16_t* dst; int nh, sec0;
    if (rt < 4) { wrow = 2048 + rt * 256; dst = (bf16_t*)(ws + OFF_VFT); nh = 8; sec0 = 2048; }
    else if (rt == 4) { wrow = 4864; dst = (bf16_t*)(ws + OFF_VST); nh = 2; sec0 = 4864; }
    else { wrow = 5376; dst = (bf16_t*)(ws + OFF_VWT); nh = 2; sec0 = 5376; }
    g.A0 = g.A1 = g.A2 = whi; g.B0 = g.B1 = g.B2 = uhi;
    EpiVT e{dst, nh, sec0};
    gemm_tile(g, wrow, tt * 256, e);
  }
}
DI void inproj_phase(const Params& p, bool dry) {
  if (gridDim.x == 256) {
    const int c = blockIdx.x;
    if (c < 160) { inproj_heavy(p, c); inproj_light(p, c); }
    else { for (int i = 0; i < 4; ++i) inproj_light(p, 160 + (c - 160) * 4 + i); }
    if (!dry) misc_job(p, c);
  } else {
    FOR_JOBS(job, 160) inproj_heavy(p, job);
    FOR_JOBS(job, 544) inproj_light(p, job);
    FOR_JOBS(job, 256) misc_job(p, job);
  }
}

constexpr int KSTR = 272, VSTR = 264;
constexpr int ST_K = 0, ST_V = 128 * KSTR, ST_C = ST_V + 128 * VSTR, ST_SIZE = ST_C + 512;
constexpr int LDS_LIST = 2 * ST_SIZE;

DI bf16x8 pack8(const f32x16& x, int s) {
  u32x4 r;
  r[0] = pack2(x[8 * s + 0], x[8 * s + 1]); r[1] = pack2(x[8 * s + 2], x[8 * s + 3]);
  r[2] = pack2(x[8 * s + 4], x[8 * s + 5]); r[3] = pack2(x[8 * s + 6], x[8 * s + 7]);
  return __builtin_bit_cast(bf16x8, r);
}
DI bf16x8 ldv8(const char* p) {
  const u32x2 a = *(const u32x2*)p, b = *(const u32x2*)(p + 16);
  u32x4 r = {a[0], a[1], b[0], b[1]};
  return __builtin_bit_cast(bf16x8, r);
}

constexpr int AS_K = 0, AS_V = 32768, AS_C = 65536, AS_SIZE = 66048;
constexpr int LDS_LIST2 = 2 * AS_SIZE;
DI int pi23(int r) { return (r & ~12) | ((r & 4) << 1) | ((r & 8) >> 1); }
template <int MODE>
DI void attn_unit(const Params& p, int b, int hg, int qt, bool dry = false) {
  char* ws = p.ws;
  int tid = threadIdx.x; asm volatile("" : "+v"(tid));
  const int wave = tid >> 6, lane = tid & 63, l32 = lane & 31, hh = lane >> 5, rg = wave & 3, kh = wave >> 2;
  int token, head; const bf16_t *qrow, *kbase, *vbase; int kstride;
  if (MODE == 0) {
    token = qt * 128 + rg * 32 + l32; head = hg;
    qrow = (const bf16_t*)(ws + OFF_QF) + (size_t)(b * 4096 + token) * 1024 + head * 128;
    kbase = (const bf16_t*)(ws + OFF_KF) + (size_t)b * 4096 * 1024 + head * 128; kstride = 1024;
    vbase = (const bf16_t*)(ws + OFF_VFT) + (size_t)(b * 8 + head) * 128 * 4096;
  } else {
    if (MODE == 1) { token = qt * 32 + l32; head = hg * 4 + rg; }
    else { token = qt * 32 + rg * 8 + (l32 >> 2); head = hg * 4 + (l32 & 3); }
    qrow = (const bf16_t*)(ws + OFF_QN_HI) + (size_t)(b * 4096 + token) * 1024 + head * 128;
    kbase = (const bf16_t*)(ws + (MODE == 1 ? OFF_KW : OFF_KS)) + (size_t)(b * 2 + hg) * 4096 * 128; kstride = 128;
    vbase = (const bf16_t*)(ws + (MODE == 1 ? OFF_VWT : OFF_VST)) + (size_t)(b * 2 + hg) * 128 * 4096;
  }
  const int wtmin = MODE == 0 ? qt * 128 + rg * 32 : (MODE == 1 ? qt * 32 : qt * 32 + rg * 8), wtmax = wtmin + (MODE == 2 ? 7 : 31);
  int nst, kv_start = 0;
  int* list = (int*)(g_smem + LDS_LIST2);
  unsigned long long selmask = 0;
  if (MODE == 0) nst = qt + 1;
  else if (MODE == 1) { int lo = qt * 32 - 511; if (lo < 0) lo = 0; kv_start = lo & ~63; nst = (qt * 32 + 32 - kv_start + 127) >> 7; }
  else {
    const unsigned long long* sel = (const unsigned long long*)(ws + OFF_SEL) + (size_t)(b * 2 + hg) * 4096;
    selmask = sel[token];
    if (wave == 0) {
      const unsigned long long sm0 = sel[qt * 32 + l32];
      unsigned lo = (unsigned)sm0, hi = (unsigned)(sm0 >> 32);
#pragma unroll
      for (int o = 16; o > 0; o >>= 1) { lo |= __shfl_xor(lo, o); hi |= __shfl_xor(hi, o); }
      const unsigned long long um = ((unsigned long long)hi << 32) | lo;
      if ((um >> lane) & 1ull) list[1 + __popcll(um & ((1ull << lane) - 1ull))] = lane;
      if (lane == 0) list[0] = __popcll(um);
    }
    __syncthreads();
    nst = (list[0] + 1) >> 1;
  }
  bf16x8 qf[8];
#pragma unroll
  for (int ks = 0; ks < 8; ++ks) qf[ks] = *(const bf16x8*)(qrow + ks * 16 + hh * 8);
  float cumq = 0.f;
  const float* cumrow = nullptr;
  if (MODE == 0) { cumrow = (const float*)(ws + OFF_CUM) + (size_t)(b * 8 + head) * 4096; cumq = cumrow[token]; }

  f32x16 o[4];
#pragma unroll
  for (int i = 0; i < 4; ++i) o[i] = zero16();
  float mrun = -1e30f, lrun = 0.f;

  auto tile_base = [&](int it, int half) -> int {
    if (MODE == 2) { const int i = 2 * it + half; return i < list[0] ? list[1 + i] * 64 : -1; }
    return kv_start + it * 128 + half * 64;
  };
  const int rsub = lane >> 4, slot = lane & 15;
  unsigned koff[4], voff[4]; bool vhalf[4];
#pragma unroll
  for (int j = 0; j < 4; ++j) {
    const int row = (j * 8 + wave) * 4 + rsub;
    const int c = slot ^ (row & 15);
    koff[j] = (unsigned)(pi23(row & 63) * kstride + c * 8) * 2u;
    vhalf[j] = (c >> 3) != 0;
    voff[j] = MODE == 2 ? (unsigned)(row * 4096 + (c & 7) * 8) * 2u : (unsigned)(row * 4096 + c * 8) * 2u;
  }
  auto issue_stage = [&](int it, int buf) {
    if (DRY_MODE == 2 && dry) return;
    int kb0 = tile_base(it, 0), kb1 = tile_base(it, 1);
    if (kb1 < 0) kb1 = 0;
    char* sb = g_smem + buf * AS_SIZE;
    const char* kp0 = uptr((const char*)(kbase + (size_t)kb0 * kstride));
    const char* kp1 = uptr((const char*)(kbase + (size_t)kb1 * kstride));
    const char* vp0 = uptr((const char*)(vbase + kb0));
    const char* vp1 = uptr((const char*)(vbase + kb1));
#pragma unroll
    for (int j = 0; j < 4; ++j) {
      __builtin_amdgcn_global_load_lds((const unsigned*)((j >> 1 ? kp1 : kp0) + koff[j]), (unsigned*)(sb + AS_K + (j * 8 + wave) * 1024 + lane * 16), 16, 0, 0);
      const char* vsrc = MODE == 2 ? ((vhalf[j] ? vp1 : vp0) + voff[j]) : (vp0 + voff[j]);
      __builtin_amdgcn_global_load_lds((const unsigned*)vsrc, (unsigned*)(sb + AS_V + (j * 8 + wave) * 1024 + lane * 16), 16, 0, 0);
    }
    if (MODE == 0 && wave < 2) {
      const int key = (wave ? kb1 : kb0) + lane;
      __builtin_amdgcn_global_load_lds((const unsigned*)(cumrow + key), (unsigned*)(sb + AS_C + wave * 256 + lane * 4), 4, 0, 0);
    }
  };

  int it0 = 0;
  if (MODE == 0) {
    float q2 = 0.f;
#pragma unroll
    for (int ks = 0; ks < 8; ++ks)
#pragma unroll
      for (int e = 0; e < 8; ++e) { const float f = bf2f((unsigned short)qf[ks][e]); q2 += f * f; }
    q2 = xsum32(q2);
#pragma unroll
    for (int o2 = 16; o2 > 0; o2 >>= 1) q2 = fmaxf(q2, __shfl_xor(q2, o2));
    const float* kn = (const float*)(ws + OFF_KNORM) + (size_t)(b * 8 + head) * 128;
    float k2 = fmaxf(kn[lane], kn[lane + 64]);
#pragma unroll
    for (int o2 = 32; o2 > 0; o2 >>= 1) k2 = fmaxf(k2, __shfl_xor(k2, o2));
    float* qx = (float*)(g_smem + LDS_LIST2);
    if (lane == 0) qx[wave] = q2;
    __syncthreads();
    const float q2m = fmaxf(fmaxf(qx[0], qx[1]), fmaxf(qx[2], qx[3]));
    const float xub = sqrtf(q2m * k2) * (QK_C1 * 1.001f) + 0.01f;
    const float cend = lane < qt ? cumrow[lane * 128 + 127] : cumrow[qt * 128];
    const float bub = (cumrow[qt * 128] - cend) * LOG2E;
    const bool skip = lane < qt && (2.f * xub + bub < -160.f);
    const unsigned long long sk = __ballot(skip);
    it0 = (int)__builtin_ctzll(~sk);
    if (it0 > qt) it0 = qt;
    it0 = __builtin_amdgcn_readfirstlane(it0);
  }
#pragma unroll
  for (int ks = 0; ks < 8; ++ks) asm volatile("" :: "v"(qf[ks]));
  asm volatile("" :: "v"(cumq));
  issue_stage(it0, it0 & 1);
  for (int it = it0; it < nst; ++it) {
    asm volatile("s_waitcnt vmcnt(0)" ::: "memory");
    __builtin_amdgcn_s_barrier();
    if (it + 1 < nst) issue_stage(it + 1, (it + 1) & 1);
    const char* sb = g_smem + (it & 1) * AS_SIZE;
    const int kbh = tile_base(it, kh);
    bool active;
    if (MODE == 0) active = kbh <= wtmax;
    else if (MODE == 1) active = kbh <= wtmax && kbh + 63 >= wtmin - 511;
    else active = kbh >= 0;
    if (DRY_MODE == 1 && dry) active = false;
    const bool selbit = (MODE == 2 && kbh >= 0) ? ((selmask >> (kbh >> 6)) & 1ull) != 0 : true;
    if (MODE == 2) active = active && __any(selbit);
    if (active) {
      f32x16 stA = zero16(), stB = zero16();
      {
        const int row = kh * 64 + l32;
        const char* kp = sb + AS_K + row * 256;
        const int sw = row & 15;
#pragma unroll
        for (int ks = 0; ks < 8; ++ks) stA = mfma32(*(const bf16x8*)(kp + (((ks * 2 + hh) ^ sw) << 4)), qf[ks], stA);
#pragma unroll
        for (int ks = 0; ks < 8; ++ks) stB = mfma32(*(const bf16x8*)(kp + 32 * 256 + (((ks * 2 + hh) ^ sw) << 4)), qf[ks], stB);
      }
      const int tq0 = token - kbh - hh * 8;
      bf16x8 pk0, pk1;
#define ATTN_SOFTMAX(ST, KB2) do { \
        const int kmin = kbh + (KB2) * 32, kmax = kmin + 31; \
        if (MODE == 0) { \
          f32x16 cs16; \
          _Pragma("unroll") for (int gq = 0; gq < 4; ++gq) { \
            const f32x4 cs = *(const f32x4*)(sb + AS_C + (kh * 64 + (KB2) * 32 + (gq >> 1) * 16 + hh * 8 + (gq & 1) * 4) * 4); \
            cs16[gq * 4] = cs[0]; cs16[gq * 4 + 1] = cs[1]; cs16[gq * 4 + 2] = cs[2]; cs16[gq * 4 + 3] = cs[3]; } \
          ST = ST * QK_C1 + (cs16 * (-LOG2E) + cumq * LOG2E); \
        } else ST = ST * QK_C1; \
        bool need_mask; \
        if (MODE == 0) need_mask = kmax > wtmin; \
        else if (MODE == 1) need_mask = kmax > wtmin || wtmax - kmin >= 512; \
        else need_mask = (kbh >> 6) == (wtmin >> 6); \
        if (need_mask) { \
          _Pragma("unroll") for (int gq = 0; gq < 4; ++gq) _Pragma("unroll") for (int j = 0; j < 4; ++j) { \
            const int kofs = (KB2) * 32 + (gq >> 1) * 16 + (gq & 1) * 4 + j; \
            bool valid = kofs <= tq0; \
            if (MODE == 1) valid = valid && (tq0 - kofs < 512); \
            ST[gq * 4 + j] = valid ? ST[gq * 4 + j] : -1e30f; } } \
        float mx = ST[0]; \
        _Pragma("unroll") for (int r = 1; r < 16; ++r) mx = fmaxf(mx, ST[r]); \
        mx = xmax32(mx); \
        if (MODE == 2) mx = selbit ? mx : -1e30f; \
        const float mnew = (mx > mrun + 8.f) ? mx : mrun;        \
        if (__any(mnew != mrun)) { \
          const float alpha = fexp2(mrun - mnew); \
          lrun *= alpha; \
          _Pragma("unroll") for (int i = 0; i < 4; ++i) o[i] = o[i] * alpha; } \
        mrun = mnew; \
        const float msub = (mnew > -1e29f && selbit) ? mnew : 1e30f; \
        ST = ST - msub; \
        float rs = 0.f; \
        _Pragma("unroll") for (int r = 0; r < 16; ++r) { ST[r] = fexp2(ST[r]); rs += ST[r]; } \
        rs = xsum32(rs); \
        lrun += rs; \
        pk0 = pack8(ST, 0); pk1 = pack8(ST, 1); } while (0)
#define ATTN_PV(KB2) do { \
        _Pragma("unroll") for (int dblk = 0; dblk < 4; ++dblk) { \
          const int d = dblk * 32 + l32; \
          const char* vp = sb + AS_V + d * 256; \
          const int sw = d & 15; \
          o[dblk] = mfma32(*(const bf16x8*)(vp + (((kh * 8 + (KB2) * 4 + hh) ^ sw) << 4)), pk0, o[dblk]); \
          o[dblk] = mfma32(*(const bf16x8*)(vp + (((kh * 8 + (KB2) * 4 + 2 + hh) ^ sw) << 4)), pk1, o[dblk]); } } while (0)
      ATTN_SOFTMAX(stA, 0);
      ATTN_PV(0);
      ATTN_SOFTMAX(stB, 1);
      ATTN_PV(1);
#undef ATTN_SOFTMAX
#undef ATTN_PV
    }
  }
  __syncthreads();
  float* X = (float*)g_smem;
  if (kh == 1) {
#pragma unroll
    for (int i = 0; i < 4; ++i)
#pragma unroll
      for (int r = 0; r < 16; ++r) X[(rg * 66 + i * 16 + r) * 64 + lane] = o[i][r];
    X[(rg * 66 + 64) * 64 + lane] = mrun; X[(rg * 66 + 65) * 64 + lane] = lrun;
  }
  __syncthreads();
  float* Tt = (float*)(g_smem + 67584);
  if (kh == 0) {
    const float m1 = X[(rg * 66 + 64) * 64 + lane], l1 = X[(rg * 66 + 65) * 64 + lane];
    const float mf = fmaxf(mrun, m1);
    const float a0 = fexp2(mrun - mf), a1 = fexp2(m1 - mf);
    const float lt = lrun * a0 + l1 * a1;
    float inv = lt > 0.f ? 1.f / lt : 0.f;
    if (MODE != 0) inv *= ((const float*)(ws + OFF_GATES))[(size_t)(b * 4096 + token) * 24 + head * 3 + (MODE == 1 ? 2 : 1)];
    const float s0 = a0 * inv, s1 = a1 * inv;
    float* trow = Tt + (rg * 32 + l32) * 132;
#pragma unroll
    for (int i = 0; i < 4; ++i)
#pragma unroll
      for (int gq = 0; gq < 4; ++gq) {
        f32x4 v;
#pragma unroll
        for (int j = 0; j < 4; ++j) v[j] = o[i][gq * 4 + j] * s0 + X[(rg * 66 + i * 16 + gq * 4 + j) * 64 + lane] * s1;
        *(f32x4*)(trow + i * 32 + 8 * gq + 4 * hh) = v;
      }
  }
  __syncthreads();
  if (!dry) {
    float* obase = (float*)(ws + (MODE == 0 ? OFF_OF32 : OFF_ON32)) + (size_t)b * 4096 * 1024;
#pragma unroll
    for (int k = 0; k < 8; ++k) {
      const int R = wave * 16 + k * 2 + (lane >> 5), rgr = R >> 5, rr = R & 31, c4 = (lane & 31) * 4;
      int tk, hd;
      if (MODE == 0) { tk = qt * 128 + rgr * 32 + rr; hd = hg; }
      else if (MODE == 1) { tk = qt * 32 + rr; hd = hg * 4 + rgr; }
      else { tk = qt * 32 + rgr * 8 + (rr >> 2); hd = hg * 4 + (rr & 3); }
      float* dp = obase + (size_t)tk * 1024 + hd * 128 + c4;
      f32x4 v = *(const f32x4*)(Tt + R * 132 + c4);
      if (MODE == 2) v += *(const f32x4*)dp;
      *(f32x4*)dp = v;
    }
  }
  __syncthreads();
}

constexpr int CV_STR = 520;
constexpr int C_V = 0, C_K = 128 * CV_STR  , C_KLO = C_K + 128 * KSTR, C_EX = C_KLO + 128 * KSTR  ;
DI void cmp_unit(const Params& p, int b, int g, int qt, bool dry = false) {
  char* ws = p.ws;
  int tid = threadIdx.x; asm volatile("" : "+v"(tid));
  const int wave = tid >> 6, lane = tid & 63, l32 = lane & 31, hh = lane >> 5, rg = wave & 3, kh = wave >> 2;
  const int token = qt * 32 + l32, head = g * 4 + rg, bg = b * 2 + g;
  const bf16_t* qh = (const bf16_t*)(ws + OFF_QN_HI) + (size_t)(b * 4096 + token) * 1024 + head * 128;
  const bf16_t* ql = (const bf16_t*)(ws + OFF_QN_LO) + (size_t)(b * 4096 + token) * 1024 + head * 128;
  const bf16_t* kch = (const bf16_t*)(ws + OFF_KC_HI) + (size_t)bg * 256 * 128;
  const bf16_t* kcl = (const bf16_t*)(ws + OFF_KC_LO) + (size_t)bg * 256 * 128;
  const bf16_t* vct = (const bf16_t*)(ws + OFF_VCT) + (size_t)bg * 128 * 256;
  bf16x8 qfh[8], qfl[8];
#pragma unroll
  for (int ks = 0; ks < 8; ++ks) { qfh[ks] = *(const bf16x8*)(qh + ks * 16 + hh * 8); qfl[ks] = *(const bf16x8*)(ql + ks * 16 + hh * 8); }
#pragma unroll
  for (int i = 0; i < 8; ++i) {
    const int c = tid + i * 512, d = c >> 5, cc = c & 31;
    const u32x4 v = *(const u32x4*)(vct + (size_t)d * 256 + cc * 8);
    char* vd = g_smem + C_V + d * CV_STR + cc * 16;
    *(u32x2*)vd = (u32x2){v[0], v[1]}; *(u32x2*)(vd + 8) = (u32x2){v[2], v[3]};
  }
  f32x16 t4[4];
#pragma unroll
  for (int s = 0; s < 2; ++s) {
#pragma unroll
    for (int i = 0; i < 4; ++i) {
      const int c = tid + i * 512, rr = c >> 4, cc = c & 15;
      const int key = (rr >> 6) * 128 + s * 64 + (rr & 63);
      *(u32x4*)(g_smem + C_K + rr * KSTR + cc * 16) = *(const u32x4*)(kch + (size_t)key * 128 + cc * 8);
      *(u32x4*)(g_smem + C_KLO + rr * KSTR + cc * 16) = *(const u32x4*)(kcl + (size_t)key * 128 + cc * 8);
    }
    __syncthreads();
    {
      f32x16 st0 = zero16(), st1 = zero16();
      const int off = (kh * 64 + l32) * KSTR + hh * 16;
      const int tmaxu = qt * 32 + 31;
      const bool act0 = 16 * (kh * 128 + s * 64) + 31 <= tmaxu, act1 = 16 * (kh * 128 + s * 64 + 32) + 31 <= tmaxu;
      if (act0) {
#pragma unroll
        for (int ks = 0; ks < 8; ++ks) {
          const bf16x8 ah0 = *(const bf16x8*)(g_smem + C_K + off + ks * 32), al0 = *(const bf16x8*)(g_smem + C_KLO + off + ks * 32);
          st0 = mfma32(al0, qfh[ks], st0); st0 = mfma32(ah0, qfl[ks], st0); st0 = mfma32(ah0, qfh[ks], st0);
        }
      }
      if (act1) {
#pragma unroll
        for (int ks = 0; ks < 8; ++ks) {
          const bf16x8 ah1 = *(const bf16x8*)(g_smem + C_K + off + 32 * KSTR + ks * 32), al1 = *(const bf16x8*)(g_smem + C_KLO + off + 32 * KSTR + ks * 32);
          st1 = mfma32(al1, qfh[ks], st1); st1 = mfma32(ah1, qfl[ks], st1); st1 = mfma32(ah1, qfh[ks], st1);
        }
      }
#pragma unroll
      for (int r = 0; r < 16; ++r) {
        const int c = kh * 128 + s * 64 + (r & 3) + 8 * (r >> 2) + 4 * hh;
        st0[r] = ((16 * c + 31 <= token) && c < 255) ? st0[r] * QK_C1 : -1e30f;
        st1[r] = ((16 * (c + 32) + 31 <= token) && (c + 32) < 255) ? st1[r] * QK_C1 : -1e30f;
      }
      t4[s * 2 + 0] = st0; t4[s * 2 + 1] = st1;
    }
    __syncthreads();
  }
  float* ex = (float*)(g_smem + C_EX);
  float mx = -1e30f;
#pragma unroll
  for (int i = 0; i < 4; ++i)
#pragma unroll
    for (int r = 0; r < 16; ++r) mx = fmaxf(mx, t4[i][r]);
  mx = xmax32(mx);
  if (hh == 0) ex[(rg * 2 + kh) * 32 + l32] = mx;
  __syncthreads();
  const float mf = fmaxf(ex[(rg * 2 + 0) * 32 + l32], ex[(rg * 2 + 1) * 32 + l32]);
  float rs = 0.f;
#pragma unroll
  for (int i = 0; i < 4; ++i)
#pragma unroll
    for (int r = 0; r < 16; ++r) { const float t = t4[i][r]; const float pv = t > -1e29f ? fexp2(t - mf) : 0.f; t4[i][r] = pv; rs += pv; }
  rs = xsum32(rs);
  if (hh == 0) ex[256 + (rg * 2 + kh) * 32 + l32] = rs;
  __syncthreads();
  const float lt = ex[256 + (rg * 2 + 0) * 32 + l32] + ex[256 + (rg * 2 + 1) * 32 + l32];
  const float inv = lt > 0.f ? 1.f / lt : 0.f;
  float* Ap = (float*)(g_smem + C_K); float* Bp = Ap + 4 * 32 * 64;
#pragma unroll
  for (int i = 0; i < 4; ++i) {
#pragma unroll
    for (int r = 0; r < 16; ++r) t4[i][r] *= inv;
#pragma unroll
    for (int gq = 0; gq < 4; ++gq) {
      const int n = kh * 32 + (i >> 1) * 16 + (i & 1) * 8 + 2 * gq + hh;
      const float p0 = t4[i][gq * 4], p1 = t4[i][gq * 4 + 1], p2 = t4[i][gq * 4 + 2], p3 = t4[i][gq * 4 + 3];
      Ap[(rg * 32 + l32) * 64 + n] = 2.f * (p0 + p1 + p2) + p3;
      Bp[(rg * 32 + l32) * 64 + n] = p3;
    }
  }
  f32x16 o[4];
#pragma unroll
  for (int i = 0; i < 4; ++i) o[i] = zero16();
#pragma unroll
  for (int i = 0; i < 4; ++i) {
    const int keyb = kh * 128 + (i >> 1) * 64 + (i & 1) * 32;
    if (16 * keyb + 31 > qt * 32 + 31) continue;
    const bf16x8 pk0 = pack8(t4[i], 0), pk1 = pack8(t4[i], 1);
#pragma unroll
    for (int dblk = 0; dblk < 4; ++dblk) {
      const char* vp = g_smem + C_V + (dblk * 32 + l32) * CV_STR + (keyb + 4 * hh) * 2;
      o[dblk] = mfma32(ldv8(vp), pk0, o[dblk]);
      o[dblk] = mfma32(ldv8(vp + 32), pk1, o[dblk]);
    }
  }
  __syncthreads();
  float* X = (float*)(g_smem + C_V);
  if (kh == 1) {
#pragma unroll
    for (int i = 0; i < 4; ++i)
#pragma unroll
      for (int r = 0; r < 16; ++r) X[(rg * 64 + i * 16 + r) * 64 + lane] = o[i][r];
  }
  {
    const int n = lane;
#pragma unroll
    for (int i = 0; i < 4; ++i) {
      const int tok = wave * 4 + i, tk = qt * 32 + tok, cur = tk >> 6;
      float imp = 0.f;
#pragma unroll
      for (int r4 = 0; r4 < 4; ++r4) { imp += Ap[(r4 * 32 + tok) * 64 + n]; if (n > 0) imp += Bp[(r4 * 32 + tok) * 64 + n - 1]; }
      const bool causal = n <= cur, forced = n == 0 || n == cur || n == cur - 1;
      const float score = causal ? (forced ? 1e6f : imp) : -1e6f;
      int rank = 0;
#pragma unroll 4
      for (int j = 0; j < 64; ++j) { const float sj = __int_as_float(__builtin_amdgcn_readlane(__float_as_int(score), j)); rank += (sj > score || (sj == score && j < n)) ? 1 : 0; }
      const unsigned long long msk = __ballot(causal && rank < 16);
      if (lane == 0) ((unsigned long long*)(ws + OFF_SEL))[(size_t)bg * 4096 + tk] = msk;
    }
  }
  __syncthreads();
  float* Tt = (float*)(g_smem + C_K);
  if (kh == 0) {
    const float gt = ((const float*)(ws + OFF_GATES))[(size_t)(b * 4096 + token) * 24 + head * 3 + 0];
    float* trow = Tt + (rg * 32 + l32) * 132;
#pragma unroll
    for (int i = 0; i < 4; ++i)
#pragma unroll
      for (int gq = 0; gq < 4; ++gq) {
        f32x4 v;
#pragma unroll
        for (int j = 0; j < 4; ++j) v[j] = (o[i][gq * 4 + j] + X[(rg * 64 + i * 16 + gq * 4 + j) * 64 + lane]) * gt;
        *(f32x4*)(trow + i * 32 + 8 * gq + 4 * hh) = v;
      }
  }
  __syncthreads();
  if (!dry) {
    float* obase = (float*)(ws + OFF_ON32) + (size_t)b * 4096 * 1024;
#pragma unroll
    for (int k = 0; k < 8; ++k) {
      const int R = wave * 16 + k * 2 + (lane >> 5), rgr = R >> 5, rr = R & 31, c4 = (lane & 31) * 4;
      float* dp = obase + (size_t)(qt * 32 + rr) * 1024 + (g * 4 + rgr) * 128 + c4;
      *(f32x4*)dp = *(const f32x4*)dp + *(const f32x4*)(Tt + R * 132 + c4);
    }
  }
  __syncthreads();
}

DI void cumsum_job(const Params& p, int bh) {
  int tid = threadIdx.x; asm volatile("" : "+v"(tid));
  const int b = bh >> 3, h = bh & 7, wave = tid >> 6, lane = tid & 63;
  const float* lf = (const float*)(p.ws + OFF_LOGF) + (size_t)b * 4096 * 8 + h;
  float* cum = (float*)(p.ws + OFF_CUM) + (size_t)bh * 4096;
  float* wt = (float*)g_smem;
  float v[8]; float s = 0.f;
#pragma unroll
  for (int i = 0; i < 8; ++i) { s += lf[(size_t)(tid * 8 + i) * 8]; v[i] = s; }
  float inc = s;
#pragma unroll
  for (int o = 1; o < 64; o <<= 1) { const float t = __shfl_up(inc, o); if (lane >= o) inc += t; }
  if (lane == 63) wt[wave] = inc;
  __syncthreads();
  float base = inc - s;
  for (int w = 0; w < wave; ++w) base += wt[w];
#pragma unroll
  for (int i = 0; i < 8; ++i) cum[tid * 8 + i] = base + v[i];
  __syncthreads();
}

DI void knorm_job(const Params& p, int j) {
  int tid = threadIdx.x; asm volatile("" : "+v"(tid));
  const int pair = tid >> 1, half = tid & 1, tl = pair >> 3, h = pair & 7;
  const bf16_t* kp = (const bf16_t*)(p.ws + OFF_KF) + (size_t)(j * 32 + tl) * 1024 + h * 128 + half * 64;
  float ss = 0.f;
#pragma unroll
  for (int i = 0; i < 8; ++i) {
    const bf16x8 v = *(const bf16x8*)(kp + i * 8);
#pragma unroll
    for (int e = 0; e < 8; ++e) { const float f = bf2f((unsigned short)v[e]); ss += f * f; }
  }
  ss += __shfl_xor(ss, 1);
  float* nr = (float*)g_smem;
  if (half == 0) nr[pair] = ss;
  __syncthreads();
  if (tid < 8) {
    float m = 0.f;
    for (int t = 0; t < 32; ++t) m = fmaxf(m, nr[t * 8 + tid]);
    ((float*)(p.ws + OFF_KNORM))[((j >> 7) * 8 + tid) * 128 + (j & 127)] = m;
  }
  __syncthreads();
}
DI void gemm1_job(const Params& p, int j) {
  char* ws = p.ws;
  GemmOp g; g.lda = 2048; g.ldb = 4096;
  if (j < 64) {
    const int pm = j >> 4, split = j & 15;
    const bf16_t* ah = (const bf16_t*)(ws + OFF_KCIN_HI) + split * 256; const bf16_t* al = (const bf16_t*)(ws + OFF_KCIN_LO) + split * 256;
    const bf16_t* bh = (const bf16_t*)(ws + OFF_W1K_HI) + split * 256; const bf16_t* bl = (const bf16_t*)(ws + OFF_W1K_LO) + split * 256;
    g.A0 = ah; g.A1 = ah; g.A2 = al; g.B0 = bh; g.B1 = bl; g.B2 = bh; g.nt = 12; g.shift = 2;
    EpiF32 e{(float*)(ws + OFF_H1P_K) + (size_t)split * 1024 * 256, 256};
    gemm_tile(g, pm * 256, 0, e);
  } else {
    const int jj = j - 64, pm = jj >> 3, split = jj & 7;
    const bf16_t* ah = (const bf16_t*)(ws + OFF_VCIN) + split * 512; const bf16_t* bh = (const bf16_t*)(ws + OFF_W1V) + split * 512;
    g.A0 = g.A1 = g.A2 = ah; g.B0 = g.B1 = g.B2 = bh; g.nt = 8; g.shift = 3;
    EpiF32 e{(float*)(ws + OFF_H1P_V) + (size_t)split * 1024 * 256, 256};
    gemm_tile(g, pm * 256, 0, e);
  }
}

DI void gemm2_job(const Params& p, int j) {
  char* ws = p.ws;
  int tid = threadIdx.x; asm volatile("" : "+v"(tid));
  const bool isv = j >= 128; const int r0 = (j & 127) * 8;
  const float* part = (const float*)(ws + (isv ? OFF_H1P_V : OFF_H1P_K));
  const float* bias = (const float*)(ws + OFF_BIAS1) + (isv ? 16 * 256 : 0);
  const float* w2 = isv ? p.w_vc2 : p.w_kc2;
  float* hs = (float*)g_smem;
  float* w2s = hs + 2048;
  float* os = w2s;
  {
    const f32x4* w2v = (const f32x4*)w2;
#pragma unroll 16
    for (int i = 0; i < 16; ++i) ((f32x4*)w2s)[tid + i * 512] = w2v[tid + i * 512];
  }
  for (int idx = tid; idx < 2048; idx += 512) {
    const int row = idx >> 8, col = idx & 255;
    float s = 0.f;
#pragma unroll
    for (int c16 = 0; c16 < 16; ++c16) s += bias[c16 * 256 + col];
    const int nsp = isv ? 8 : 16;
    for (int sp = 0; sp < nsp; ++sp) s += part[((size_t)sp * 1024 + r0 + row) * 256 + col];
    hs[idx] = gelu_tanh(s);
  }
  __syncthreads();
  float a0 = 0.f, a1 = 0.f;
  {
    const int col = tid & 127, rp = tid >> 7;
#pragma unroll 8
    for (int k = 0; k < 256; ++k) { const float w = w2s[k * 128 + col]; a0 += hs[(rp * 2) * 256 + k] * w; a1 += hs[(rp * 2 + 1) * 256 + k] * w; }
  }
  __syncthreads();
  { const int col = tid & 127, rp = tid >> 7; os[(rp * 2) * 128 + col] = a0; os[(rp * 2 + 1) * 128 + col] = a1; }
  __syncthreads();
  if (!isv) {
    const int row = tid >> 6, i = tid & 63;
    const int rr = r0 + row, bg = rr >> 8, n = rr & 255;
    float y1 = 0.f, y2 = 0.f;
    if (n < 255) {
      const int tk = (bg >> 1) * 4096 + 16 * n + 31;
      const float cv = ((const float*)(ws + OFF_COS))[(size_t)tk * 64 + i], sv = ((const float*)(ws + OFF_SIN))[(size_t)tk * 64 + i];
      const float x1 = os[row * 128 + i], x2 = os[row * 128 + 64 + i];
      y1 = x1 * cv - x2 * sv; y2 = x2 * cv + x1 * sv;
    }
    bf16_t* kh_ = (bf16_t*)(ws + OFF_KC_HI) + (size_t)rr * 128; bf16_t* kl_ = (bf16_t*)(ws + OFF_KC_LO) + (size_t)rr * 128;
    kh_[i] = f2bf(y1); kh_[i + 64] = f2bf(y2); kl_[i] = f2bf(lo_of(y1)); kl_[i + 64] = f2bf(lo_of(y2));
  } else {
    for (int idx = tid; idx < 1024; idx += 512) {
      const int row = idx & 7, d = idx >> 3;
      const int rr = r0 + row, bg = rr >> 8, n = rr & 255;
      ((bf16_t*)(ws + OFF_VCT))[((size_t)bg * 128 + d) * 256 + n] = n < 255 ? f2bf(os[row * 128 + d]) : (bf16_t)0;
    }
  }
  __syncthreads();
}

DI void phase3(const Params& p) {
  FOR_JOBS(job, 96) gemm1_job(p, job);
  for (int job = (int)gridDim.x - 1 - (int)blockIdx.x; job < 16; job += gridDim.x) cumsum_job(p, job);
  for (int job = (int)gridDim.x - 1 - (int)blockIdx.x; job < 256; job += gridDim.x) knorm_job(p, job);
}
DI void phase4(const Params& p, bool dry) {
  if (!dry) { FOR_JOBS(job, 256) gemm2_job(p, job); }
  unsigned* qctr = (unsigned*)(p.ws + OFF_BAR) + (dry ? 3616 : 3600);
  volatile int* qslot = (volatile int*)(g_smem + 143360 - 32);
  for (;;) {
    if (threadIdx.x == 0) *qslot = (int)__hip_atomic_fetch_add(qctr, 1u, __ATOMIC_RELAXED, __HIP_MEMORY_SCOPE_AGENT);
    __syncthreads();
    const int u = *qslot;
    __syncthreads();
    if (u >= 1024) break;
    if (u < 512) { const int qt = 31 - (u >> 4), bh = u & 15; attn_unit<0>(p, bh >> 3, bh & 7, qt, dry); }
    else { const int v = u - 512; const int qt = 127 - (v >> 2), bg = v & 3; attn_unit<1>(p, bg >> 1, bg & 1, qt, dry); }
  }
}
DI void phase5(const Params& p, bool dry) {
  FOR_JOBS(job, 512) { const int qt = job >> 2, bg = job & 3; cmp_unit(p, bg >> 1, bg & 1, qt, dry); }
}
DI void phase6(const Params& p, bool dry) {
  unsigned* qctr = (unsigned*)(p.ws + OFF_BAR) + (dry ? 3648 : 3632);
  volatile int* qslot = (volatile int*)(g_smem + 143360 - 32);
  for (;;) {
    if (threadIdx.x == 0) *qslot = (int)__hip_atomic_fetch_add(qctr, 1u, __ATOMIC_RELAXED, __HIP_MEMORY_SCOPE_AGENT);
    __syncthreads();
    const int job = *qslot;
    __syncthreads();
    if (job >= 512) break;
    const int qt = 127 - (job >> 2), bg = job & 3; attn_unit<2>(p, bg >> 1, bg & 1, qt, dry);
  }
}

DI void outproj_phase(const Params& p) {
  char* ws = p.ws;
  FOR_JOBS(job, 256) {
    const int pn = job >> 5, pm = job & 31;
    GemmOp g; g.lda = 2048; g.ldb = 2048; g.nt = 32; g.shift = 5;
    g.A0 = g.A1 = g.A2 = (const bf16_t*)(ws + OFF_U_HI); g.B0 = g.B1 = g.B2 = (const bf16_t*)(ws + OFF_WOUT);
    EpiResid e{(float*)(ws + OFF_H1), p.x, (const float*)(ws + OFF_MOD) + 4096};
    gemm_tile(g, pm * 256, pn * 256, e);
  }
}
DI void gateup_phase(const Params& p) {
  char* ws = p.ws;
  FOR_JOBS(job, 44 * 32) {
    const int pn = job >> 5, pm = job & 31;
    GemmOp g; g.lda = 2048; g.ldb = 2048; g.nt = 32; g.shift = 5;
    g.A0 = g.A1 = g.A2 = (const bf16_t*)(ws + OFF_U_HI); g.B0 = g.B1 = g.B2 = (const bf16_t*)(ws + OFF_WGU);
    EpiSwiglu e{(bf16_t*)(ws + OFF_ACT)};
    gemm_tile(g, pm * 256, pn * 256, e);
  }
}
DI void down_phase(const Params& p) {
  char* ws = p.ws;
  FOR_JOBS(job, 256) {
    const int pn = job >> 5, pm = job & 31;
    GemmOp g; g.lda = DFF; g.ldb = DFF; g.nt = 88; g.shift = 20;
    g.A0 = g.A1 = g.A2 = (const bf16_t*)(ws + OFF_ACT); g.B0 = g.B1 = g.B2 = (const bf16_t*)(ws + OFF_WDN);
    EpiResid e{p.out, (const float*)(ws + OFF_H1), (const float*)(ws + OFF_MOD) + 10240};
    gemm_tile(g, pm * 256, pn * 256, e);
  }
}


#define XB_TMO      128
#define XB_XCNT(j)  (256  + 64 * (j))
#define XB_XSUB(j)  (1280 + 64 * (j))
#define XB_XGEN(j)  (2304 + 64 * (j))
#define XB_TOP      3328
#define XB_TOPGEN   3392
#define XCD_BAR_WORDS 3456
#define XB_SPIN_CAP (1u << 22)
#define LAS __attribute__((address_space(3)))
constexpr int LDS_BAR_OFF = 143360 - 16;
DI unsigned xb_ld(unsigned* p) { return __hip_atomic_load(p, __ATOMIC_RELAXED, __HIP_MEMORY_SCOPE_AGENT); }
DI unsigned xb_add(unsigned* p, unsigned v) { return __hip_atomic_fetch_add(p, v, __ATOMIC_RELAXED, __HIP_MEMORY_SCOPE_AGENT); }
DI unsigned xb_xcc_id() { return (unsigned)__builtin_amdgcn_s_getreg((3 << 11) | 20) & 0xFu; }
#define XB_SPIN(cond, bar) do { unsigned _sp = 0; while (cond) { __builtin_amdgcn_s_sleep(1); \
    if ((++_sp & 255u) == 0u) { if (xb_ld(&(bar)[XB_TMO])) break; if (_sp > XB_SPIN_CAP) { atomicAdd(&(bar)[XB_TMO], 1u); break; } } } } while (0)
struct XcdBarrier { unsigned* bar; unsigned x; volatile LAS unsigned* st; };
DI XcdBarrier xcd_barrier_post(unsigned* bar, volatile LAS unsigned* st) {
  XcdBarrier b; b.bar = bar; b.x = xb_xcc_id(); b.st = st;
  if (threadIdx.x == 0) (void)xb_add(&bar[XB_XCNT(b.x)], 1u);
  return b;
}
DI void xcd_barrier_complete(unsigned* bar, unsigned x, unsigned& nloc, unsigned& nx) {
  const unsigned G = gridDim.x * gridDim.y * gridDim.z;
  unsigned sum, cnt, mine, sp = 0u;
  for (;;) {
    sum = 0u; cnt = 0u; mine = 0u;
#pragma unroll
    for (unsigned j = 0; j < 16; ++j) { const unsigned c = xb_ld(&bar[XB_XCNT(j)]); sum += c; cnt += (c > 0u) ? 1u : 0u; mine = (j == x) ? c : mine; }
    if (sum == G) break;
    __builtin_amdgcn_s_sleep(1);
    if ((++sp & 255u) == 0u) { if (xb_ld(&bar[XB_TMO])) break; if (sp > XB_SPIN_CAP) { atomicAdd(&bar[XB_TMO], 1u); break; } }
  }
  nloc = mine > 0u ? mine : 1u; nx = cnt > 0u ? cnt : 1u;
}
DI void xcd_barrier(const XcdBarrier& b) {
  asm volatile("s_waitcnt vmcnt(0)" ::: "memory");
  __syncthreads();
  if (threadIdx.x == 0) {
    unsigned* bar = b.bar;
    __builtin_amdgcn_s_waitcnt(0);
    unsigned nloc = b.st[0], nx = b.st[1];
    if (nloc == 0u) { xcd_barrier_complete(bar, b.x, nloc, nx); b.st[0] = nloc; b.st[1] = nx; }
    const unsigned old = xb_add(&bar[XB_XSUB(b.x)], 1u);
    const unsigned gen = old / nloc;
    if (old + 1u == (gen + 1u) * nloc) {
      __builtin_amdgcn_fence(__ATOMIC_RELEASE, "agent");
      asm volatile("s_waitcnt vmcnt(0)" ::: "memory");
      const unsigned og = xb_add(&bar[XB_TOP], 1u);
      const unsigned tg = og / nx;
      if (og + 1u == (tg + 1u) * nx) xb_add(&bar[XB_TOPGEN], 1u);
      else XB_SPIN(xb_ld(&bar[XB_TOPGEN]) == tg, bar);
      __builtin_amdgcn_fence(__ATOMIC_ACQUIRE, "agent");
      xb_add(&bar[XB_XGEN(b.x)], 1u);
      asm volatile("s_waitcnt vmcnt(0)" ::: "memory");
    } else {
      XB_SPIN(xb_ld(&bar[XB_XGEN(b.x)]) == gen, bar);
      __builtin_amdgcn_fence(__ATOMIC_ACQUIRE, "agent");
      asm volatile("s_waitcnt vmcnt(0)" ::: "memory");
    }
  }
  __syncthreads();
}

#ifdef ONLY_PHASE
#define PH_ON(k) ((k) == ONLY_PHASE)
#else
#define PH_ON(k) 1
#endif
#ifndef REP_MASK
#define REP_MASK 0
#endif
#define RUN_PHASE(k, call) do { if (PH_ON(k) && ph0 <= (k) && (k) < ph1) { \
    _Pragma("unroll 1") for (int _r = 0; _r <= ((REP_MASK >> (k)) & 1); ++_r) { const bool _dry = ((REP_MASK >> (k)) & 1) && _r == 0; (void)_dry; if ((k) > ph0 || _r) GRID_SYNC(); call; } } } while (0)
#ifndef NSYNC_EXTRA
#define NSYNC_EXTRA 0
#endif
#define GRID_SYNC() xcd_barrier(xb)
__global__ void __launch_bounds__(512) hymba_mega(Params p, int ph0, int ph1) {
  volatile LAS unsigned* xst = (volatile LAS unsigned*)(g_smem + LDS_BAR_OFF);
  if (threadIdx.x == 0) { xst[0] = 0u; xst[1] = 0u; }
  __syncthreads();
  const XcdBarrier xb = xcd_barrier_post((unsigned*)(p.ws + OFF_BAR), xst);
  if (ph1 > 1000) cg::this_grid().sync();
  RUN_PHASE(0, phase0(p));
  RUN_PHASE(1, rmsmod_phase(p.x, p.norm_attn, (const float*)(p.ws + OFF_MOD), 0, 2048, (bf16_t*)(p.ws + OFF_U_HI), (bf16_t*)(p.ws + OFF_U_LO)));
  RUN_PHASE(2, inproj_phase(p, _dry));
  RUN_PHASE(3, phase3(p));
  RUN_PHASE(4, phase4(p, _dry));
  RUN_PHASE(5, phase5(p, _dry));
  RUN_PHASE(6, phase6(p, _dry));
  RUN_PHASE(7, ymix_phase(p));
  RUN_PHASE(8, outproj_phase(p));
  RUN_PHASE(9, rmsmod_phase((const float*)(p.ws + OFF_H1), p.norm_ffn, (const float*)(p.ws + OFF_MOD), 6144, 8192, (bf16_t*)(p.ws + OFF_U_HI), nullptr));
  RUN_PHASE(10, gateup_phase(p));
  RUN_PHASE(11, down_phase(p));
  RUN_PHASE(12, final_phase(p));
  _Pragma("unroll 1") for (int i = 0; i < NSYNC_EXTRA; ++i) GRID_SYNC();
}

extern "C" void kernel_launch(void* const* d_in, const int* in_sizes, int n_in, void* d_out, int out_size, void* d_ws, size_t ws_size,
                              hipStream_t stream) {
  Params p{};
  p.x = (const float*)d_in[0]; p.c = (const float*)d_in[1]; p.pos = (const int*)d_in[2];
  p.w_ada = (const float*)d_in[3]; p.b_ada = (const float*)d_in[4]; p.norm_attn = (const float*)d_in[5]; p.norm_ffn = (const float*)d_in[6];
  p.w_in = (const float*)d_in[7]; p.b_fgate = (const float*)d_in[8]; p.cmp_pos = (const float*)d_in[9];
  p.w_kc1 = (const float*)d_in[10]; p.w_kc2 = (const float*)d_in[11]; p.w_vc1 = (const float*)d_in[12]; p.w_vc2 = (const float*)d_in[13];
  p.beta_fox = (const float*)d_in[14]; p.beta_nsa = (const float*)d_in[15]; p.w_out = (const float*)d_in[16];
  p.w_gate = (const float*)d_in[17]; p.w_up = (const float*)d_in[18]; p.w_down = (const float*)d_in[19]; p.final_norm = (const float*)d_in[20];
  p.out = (float*)d_out; p.ws = (char*)d_ws;
  static int grid_blocks = 0;
  if (!grid_blocks) {
    hipFuncSetAttribute((const void*)hymba_mega, hipFuncAttributeMaxDynamicSharedMemorySize, LDS_BYTES);
    int dev = 0, cus = 0, per_cu = 0;
    hipGetDevice(&dev);
    hipDeviceGetAttribute(&cus, hipDeviceAttributeMultiprocessorCount, dev);
    hipOccupancyMaxActiveBlocksPerMultiprocessor(&per_cu, hymba_mega, 512, LDS_BYTES);
    if (per_cu < 1) per_cu = 1;
    grid_blocks = cus * per_cu;
    if (ws_size < WS_END) fprintf(stderr, "workspace too small: %zu < %zu\n", ws_size, (size_t)WS_END);
  }
  hipMemsetAsync((char*)d_ws + OFF_BAR, 0, 16384, stream);
#if N_LAUNCH_MODE == 1
  int ph0 = 0, ph1 = NPH;
  void* args[] = {&p, &ph0, &ph1};
  hipError_t e = hipLaunchCooperativeKernel((const void*)hymba_mega, dim3(grid_blocks), dim3(512), args, LDS_BYTES, stream);
  if (e != hipSuccess) fprintf(stderr, "cooperative launch failed: %s (grid %d)\n", hipGetErrorString(e), grid_blocks);
#else
  for (int ph = 0; ph < NPH; ++ph) hipLaunchKernelGGL(hymba_mega, dim3(grid_blocks), dim3(512), LDS_BYTES, stream, p, ph, ph + 1);
#endif
}
```

```cpp
#include <hip/hip_runtime.h>
#include <hip/hip_cooperative_groups.h>
#include <stdint.h>
#include <cstdio>
namespace cg = cooperative_groups;

#define DI __device__ __forceinline__
typedef unsigned short bf16_t;
typedef short bf16x8 __attribute__((ext_vector_type(8)));
typedef short s16x4 __attribute__((ext_vector_type(4)));
typedef float f32x4 __attribute__((ext_vector_type(4)));
typedef float f32x16 __attribute__((ext_vector_type(16)));
typedef unsigned u32x2 __attribute__((ext_vector_type(2)));
typedef unsigned u32x4 __attribute__((ext_vector_type(4)));

#ifndef DRY_MODE
#define DRY_MODE 0
#endif
#ifndef ATTN_PREFETCH
#define ATTN_PREFETCH 0
#endif
#ifndef N_LAUNCH_MODE
#define N_LAUNCH_MODE 1
#endif

constexpr int T_TOK = 8192, SEQ = 4096, DM = 2048, DFF = 5632, DIN = 5664;
constexpr int NPH = 13;
constexpr float LOG2E = 1.4426950408889634f;
constexpr float QK_C1 = 0.08838834764831845f * 1.4426950408889634f;

constexpr size_t al256(size_t x) { return (x + 255) & ~(size_t)255; }
constexpr size_t OFF_WIN_HI = 0;
constexpr size_t OFF_WIN_LO = OFF_WIN_HI + al256((size_t)5888 * 2048 * 2);
constexpr size_t OFF_WOUT = OFF_WIN_LO + al256((size_t)1280 * 2048 * 2);
constexpr size_t OFF_WGU = OFF_WOUT + al256((size_t)2048 * 2048 * 2);
constexpr size_t OFF_WDN = OFF_WGU + al256((size_t)11264 * 2048 * 2);
constexpr size_t OFF_W1K_HI = OFF_WDN + al256((size_t)2048 * 5632 * 2);
constexpr size_t OFF_W1K_LO = OFF_W1K_HI + al256((size_t)256 * 4096 * 2);
constexpr size_t OFF_W1V = OFF_W1K_LO + al256((size_t)256 * 4096 * 2);
constexpr size_t OFF_MOD = OFF_W1V + al256((size_t)256 * 4096 * 2);
constexpr size_t OFF_COS = OFF_MOD + al256((size_t)2 * 12288 * 4);
constexpr size_t OFF_SIN = OFF_COS + al256((size_t)8192 * 64 * 4);
constexpr size_t OFF_BIAS1 = OFF_SIN + al256((size_t)8192 * 64 * 4);
constexpr size_t OFF_U_HI = OFF_BIAS1 + al256((size_t)2 * 16 * 256 * 4);
constexpr size_t OFF_LOGF = OFF_U_HI + al256((size_t)8192 * 2048 * 2);
constexpr size_t OFF_CUM = OFF_LOGF + al256((size_t)8192 * 8 * 4);
constexpr size_t OFF_GATES = OFF_CUM + al256((size_t)16 * 4096 * 4);
constexpr size_t KCIN_BYTES = al256((size_t)(4 * 4096 + 64) * 128 * 2);
constexpr size_t OFF_KCIN_HI = OFF_GATES + al256((size_t)8192 * 24 * 4);
constexpr size_t OFF_KCIN_LO = OFF_KCIN_HI + KCIN_BYTES;
constexpr size_t OFF_VCIN = OFF_KCIN_LO + KCIN_BYTES;
constexpr size_t KV4_BYTES = (size_t)4 * 4096 * 128 * 2;
constexpr size_t OFF_KS = OFF_VCIN + KCIN_BYTES;
constexpr size_t OFF_VST = OFF_KS + KV4_BYTES;
constexpr size_t OFF_KW = OFF_VST + KV4_BYTES;
constexpr size_t OFF_VWT = OFF_KW + KV4_BYTES;
constexpr size_t OFF_H1P_K = OFF_VWT + KV4_BYTES;
constexpr size_t OFF_H1P_V = OFF_H1P_K + (size_t)16 * 1024 * 256 * 4;
constexpr size_t OFF_KC_HI = OFF_H1P_V + (size_t)8 * 1024 * 256 * 4;
constexpr size_t OFF_KC_LO = OFF_KC_HI + (size_t)4 * 256 * 128 * 2;
constexpr size_t OFF_VCT = OFF_KC_LO + (size_t)4 * 256 * 128 * 2;
constexpr size_t OFF_SEL = OFF_VCT + (size_t)4 * 256 * 128 * 2;
constexpr size_t OFF_OF32 = OFF_SEL + (size_t)4 * 4096 * 8;
constexpr size_t OFF_ON32 = OFF_OF32 + (size_t)8192 * 1024 * 4;
constexpr size_t OFF_H1 = OFF_OF32;
constexpr size_t OFF_RA = OFF_ON32 + (size_t)8192 * 1024 * 4;
constexpr size_t OFF_U_LO = OFF_RA;
constexpr size_t OFF_QF = OFF_U_LO + (size_t)8192 * 2048 * 2;
constexpr size_t OFF_KF = OFF_QF + (size_t)8192 * 1024 * 2;
constexpr size_t OFF_VFT = OFF_KF + (size_t)8192 * 1024 * 2;
constexpr size_t OFF_QN_HI = OFF_VFT + (size_t)8192 * 1024 * 2;
constexpr size_t OFF_QN_LO = OFF_QN_HI + (size_t)8192 * 1024 * 2;
constexpr size_t OFF_ACT = OFF_RA;
constexpr size_t OFF_KNORM = OFF_QN_LO + (size_t)8192 * 1024 * 2;
constexpr size_t OFF_BAR = OFF_KNORM + 8192;
constexpr size_t WS_END = OFF_BAR + 16384;

struct Params {
  const float *x, *c; const int* pos;
  const float *w_ada, *b_ada, *norm_attn, *norm_ffn, *w_in, *b_fgate, *cmp_pos, *w_kc1, *w_kc2, *w_vc1, *w_vc2,
      *beta_fox, *beta_nsa, *w_out, *w_gate, *w_up, *w_down, *final_norm;
  float* out; char* ws;
};

extern __shared__ __attribute__((aligned(16))) char g_smem[];
constexpr int LDS_BYTES = 143360;

__device__ const float c_inv_freq[64] = {
1.000000000e+00f,8.659643531e-01f,7.498942614e-01f,6.493816376e-01f,5.623413324e-01f,4.869675338e-01f,4.216965139e-01f,3.651741147e-01f,3.162277639e-01f,2.738419771e-01f,2.371373773e-01f,2.053525001e-01f,1.778279394e-01f,1.539926529e-01f,1.333521307e-01f,1.154782027e-01f,1.000000015e-01f,8.659642935e-02f,7.498941571e-02f,6.493816525e-02f,5.623413250e-02f,4.869675264e-02f,4.216965288e-02f,3.651741147e-02f,3.162277490e-02f,2.738419734e-02f,2.371373773e-02f,2.053525113e-02f,1.778279431e-02f,1.539926510e-02f,1.333521493e-02f,1.154782064e-02f,9.999999776e-03f,8.659643121e-03f,7.498941850e-03f,6.493816152e-03f,5.623413250e-03f,4.869675264e-03f,4.216964822e-03f,3.651741194e-03f,3.162277630e-03f,2.738419687e-03f,2.371373586e-03f,2.053524833e-03f,1.778279431e-03f,1.539926510e-03f,1.333521446e-03f,1.154781901e-03f,1.000000047e-03f,8.659643354e-04f,7.498942432e-04f,6.493816618e-04f,5.623413017e-04f,4.869675322e-04f,4.216965172e-04f,3.651741426e-04f,3.162277571e-04f,2.738419571e-04f,2.371373703e-04f,2.053525095e-04f,1.778279402e-04f,1.539926452e-04f,1.333521504e-04f,1.154782003e-04f};

DI unsigned short f2bf(float x) { unsigned u = __float_as_uint(x); u += 0x7fffu + ((u >> 16) & 1u); return (unsigned short)(u >> 16); }
DI float bf2f(unsigned short h) { return __uint_as_float(((unsigned)h) << 16); }
typedef float f32x2 __attribute__((ext_vector_type(2)));
typedef __bf16 bf16v2 __attribute__((ext_vector_type(2)));
DI unsigned pack2(float a, float b) { const f32x2 v = {a, b}; return __builtin_bit_cast(unsigned, __builtin_convertvector(v, bf16v2)); }
DI void split2(float a, float b, unsigned& hi, unsigned& lo) {
  hi = pack2(a, b);
  lo = pack2(a - __uint_as_float(hi << 16), b - __uint_as_float(hi & 0xffff0000u));
}
DI float lo_of(float x) { return x - bf2f(f2bf(x)); }
DI float wave_sum(float v) {
#pragma unroll
  for (int o = 32; o > 0; o >>= 1) v += __shfl_xor(v, o);
  return v;
}
DI float xmax32(float v) { auto r = __builtin_amdgcn_permlane32_swap(__float_as_uint(v), __float_as_uint(v), false, false); return fmaxf(__uint_as_float(r[0]), __uint_as_float(r[1])); }
DI float xsum32(float v) { auto r = __builtin_amdgcn_permlane32_swap(__float_as_uint(v), __float_as_uint(v), false, false); return __uint_as_float(r[0]) + __uint_as_float(r[1]); }
DI float fexp2(float x) { return __builtin_amdgcn_exp2f(x); }
DI float sigmoidf_(float x) { return 1.f / (1.f + __expf(-x)); }
DI float siluf_(float x) { return x / (1.f + __expf(-x)); }
DI float silu_fast(float x) { return x * __builtin_amdgcn_rcpf(1.f + __builtin_amdgcn_exp2f(-LOG2E * x)); }
DI float gelu_tanh(float x) { float u = 0.7978845608028654f * (x + 0.044715f * x * x * x); float e = __expf(2.f * u); float t = 1.f - 2.f / (e + 1.f); return 0.5f * x * (1.f + t); }
DI float log_sigmoid(float x) { return fminf(x, 0.f) - log1pf(__expf(-fabsf(x))); }
DI f32x16 mfma32(bf16x8 a, bf16x8 b, f32x16 c) { return __builtin_amdgcn_mfma_f32_32x32x16_bf16(a, b, c, 0, 0, 0); }
DI f32x16 zero16() { f32x16 z;
#pragma unroll
  for (int i = 0; i < 16; ++i) z[i] = 0.f; return z; }
DI int perm_gu(int w) { const int r = w & 31; return (w & 96) + ((r >> 2) & 1) * 16 + (r >> 3) * 4 + (r & 3); }
DI int perm256(int w) { const int hl = (w >> 7) & 1, d = w & 127, bj = d >> 6, q = (d & 63) >> 3, n = (d >> 2) & 1, j = d & 3; return bj * 128 + (hl * 2 + (q >> 2)) * 32 + n * 16 + (q & 3) * 4 + j; }
DI int perm128(int d) { return ((d >> 4) & 3) * 32 + (d >> 6) * 16 + (d & 15); }

#define FOR_JOBS(job, njobs) \
  for (int _r = 0, job; _r * (int)gridDim.x < (njobs); ++_r) \
    if ((job = _r * (int)gridDim.x + ((_r & 1) ? ((int)gridDim.x - 1 - (int)blockIdx.x) : (int)blockIdx.x)) < (njobs))

constexpr int BM = 256, BK = 64, HALF = 128, HTB = HALF * BK * 2;
DI int lds_byte(int r, int c) { int st = (r >> 4) * 2 + (c >> 5), rr = r & 15, cc = c & 31, ob = rr * 64 + cc * 2; return st * 1024 + (ob ^ (((ob >> 9) & 1) << 5)); }
DI void stage_rc(int b, int& R, int& C) { int st = b / 1024, sb = b % 1024, swz = sb ^ (((sb >> 9) & 1) << 5); R = (st >> 1) * 16 + swz / 64; C = (st & 1) * 32 + (swz % 64) / 2; }

DI const char* uptr(const char* p) {
  const unsigned long long v = (unsigned long long)p;
  const unsigned lo = __builtin_amdgcn_readfirstlane((unsigned)v), hi = __builtin_amdgcn_readfirstlane((unsigned)(v >> 32));
  return (const char*)(((unsigned long long)hi << 32) | lo);
}
struct GemmOp { const bf16_t *A0, *A1, *A2, *B0, *B1, *B2; int lda, ldb, nt, shift; };

template <class Epi>
DI void gemm_tile(const GemmOp& g, int brow, int bcol, const Epi& epi) {
#define SA(b, h) (g_smem + ((b) * 2 + (h)) * HTB)
#define SB(b, h) (g_smem + (4 + (b) * 2 + (h)) * HTB)
  int tid = threadIdx.x; asm volatile("" : "+v"(tid));
  const int wid = tid >> 6, lane = tid & 63, wr = wid >> 2, wc = wid & 3, fr = lane & 15, fq = lane >> 4;
  int r0, c0, r1, c1; stage_rc(tid * 16, r0, c0); stage_rc(tid * 16 + 8192, r1, c1);
  const unsigned oa0 = (unsigned)(r0 * g.lda + c0) * 2u, oa1 = (unsigned)(r1 * g.lda + c1) * 2u, ob0 = (unsigned)(r0 * g.ldb + c0) * 2u, ob1 = (unsigned)(r1 * g.ldb + c1) * 2u;
  const int mask = (1 << g.shift) - 1;
#define STAGE_A(P, half, kt) do { const int _s = (kt) >> g.shift; const char* _b = uptr((const char*)((_s == 0 ? g.A0 : (_s == 1 ? g.A1 : g.A2)) + (size_t)(brow + (half) * HALF) * g.lda + (size_t)((kt) & mask) * BK)); \
    __builtin_amdgcn_global_load_lds((const unsigned*)(_b + oa0), (unsigned*)((P) + tid * 16), 16, 0, 0); \
    __builtin_amdgcn_global_load_lds((const unsigned*)(_b + oa1), (unsigned*)((P) + tid * 16 + 8192), 16, 0, 0); } while (0)
#define STAGE_B(P, half, kt) do { const int _s = (kt) >> g.shift; const char* _b = uptr((const char*)((_s == 0 ? g.B0 : (_s == 1 ? g.B1 : g.B2)) + (size_t)(bcol + (half) * HALF) * g.ldb + (size_t)((kt) & mask) * BK)); \
    __builtin_amdgcn_global_load_lds((const unsigned*)(_b + ob0), (unsigned*)((P) + tid * 16), 16, 0, 0); \
    __builtin_amdgcn_global_load_lds((const unsigned*)(_b + ob1), (unsigned*)((P) + tid * 16 + 8192), 16, 0, 0); } while (0)
#define LDA(dst, b, h) for (int m = 0; m < 4; ++m) for (int k = 0; k < 2; ++k) \
    dst[m][k] = *reinterpret_cast<const bf16x8*>(SA(b, h) + lds_byte(wr * 64 + m * 16 + fr, k * 32 + fq * 8))
#define LDB(dst, b, h) for (int n = 0; n < 2; ++n) for (int k = 0; k < 2; ++k) \
    dst[n][k] = *reinterpret_cast<const bf16x8*>(SB(b, h) + lds_byte(wc * 32 + n * 16 + fr, k * 32 + fq * 8))
#define MMA(ai, bj, At_, Bt_) do { __builtin_amdgcn_s_setprio(1); \
    for (int m = 0; m < 4; ++m) for (int n = 0; n < 2; ++n) for (int k = 0; k < 2; ++k) \
      acc[ai][bj][m][n] = __builtin_amdgcn_mfma_f32_16x16x32_bf16(Bt_[n][k], At_[m][k], acc[ai][bj][m][n], 0, 0, 0); \
    __builtin_amdgcn_s_setprio(0); } while (0)
#define WAIT_V(n) asm volatile("s_waitcnt vmcnt(" #n ")" ::: "memory")
#define WAIT_L(n) asm volatile("s_waitcnt lgkmcnt(" #n ")" ::: "memory")
#define BAR __builtin_amdgcn_s_barrier()
#define SCHED __builtin_amdgcn_sched_barrier(0)
  f32x4 acc[2][2][4][2] = {};
  bf16x8 At[4][2], B0[2][2], B1[2][2];
  const int nt = g.nt;
  STAGE_B(SB(0, 0), 0, 0); STAGE_A(SA(0, 0), 0, 0);
  STAGE_B(SB(0, 1), 1, 0); STAGE_A(SA(0, 1), 1, 0);
  if (wr == 1) BAR;
  WAIT_V(4); BAR;
  STAGE_B(SB(1, 0), 0, 1); STAGE_A(SA(1, 0), 0, 1); STAGE_B(SB(1, 1), 1, 1);
  WAIT_V(6); BAR;
  for (int t = 0; t < nt - 2; t += 2) {
    LDB(B0, 0, 0); SCHED; LDA(At, 0, 0); STAGE_A(SA(1, 1), 1, t + 1);
    WAIT_L(8); BAR; WAIT_L(0); MMA(0, 0, At, B0); BAR; SCHED;
    LDB(B1, 0, 1); STAGE_B(SB(0, 0), 0, t + 2);
    BAR; WAIT_L(0); MMA(0, 1, At, B1); BAR;
    LDA(At, 0, 1); STAGE_A(SA(0, 0), 0, t + 2);
    BAR; WAIT_L(0); MMA(1, 0, At, B0); BAR; SCHED;
    STAGE_B(SB(0, 1), 1, t + 2);
    WAIT_V(6); BAR; MMA(1, 1, At, B1); BAR;
    LDB(B0, 1, 0); SCHED; LDA(At, 1, 0); STAGE_A(SA(0, 1), 1, t + 2);
    WAIT_L(8); BAR; WAIT_L(0); MMA(0, 0, At, B0); BAR; SCHED;
    LDB(B1, 1, 1); STAGE_B(SB(1, 0), 0, t + 3);
    BAR; WAIT_L(0); MMA(0, 1, At, B1); BAR;
    LDA(At, 1, 1); STAGE_A(SA(1, 0), 0, t + 3);
    BAR; WAIT_L(0); MMA(1, 0, At, B0); BAR; SCHED;
    STAGE_B(SB(1, 1), 1, t + 3);
    WAIT_V(6); BAR; MMA(1, 1, At, B1); BAR;
  }
  { LDB(B0, 0, 0); LDA(At, 0, 0); STAGE_A(SA(1, 1), 1, nt - 1);
    BAR; WAIT_L(0); MMA(0, 0, At, B0); BAR;
    LDB(B1, 0, 1); BAR; WAIT_L(0); MMA(0, 1, At, B1); BAR;
    LDA(At, 0, 1); WAIT_V(4); BAR; WAIT_L(0); MMA(1, 0, At, B0); MMA(1, 1, At, B1); BAR; }
  { LDB(B0, 1, 0); LDA(At, 1, 0); WAIT_V(2); BAR; WAIT_L(0); MMA(0, 0, At, B0); BAR;
    LDB(B1, 1, 1); WAIT_V(0); BAR; WAIT_L(0); MMA(0, 1, At, B1); BAR;
    LDA(At, 1, 1); BAR; WAIT_L(0); MMA(1, 0, At, B0); MMA(1, 1, At, B1); BAR; }
  if (wr == 0) BAR;
  { int t2 = tid; asm volatile("" : "+v"(t2)); const int w2 = t2 >> 6, l2 = t2 & 63; epi(acc, brow, bcol, w2 >> 2, w2 & 3, l2 & 15, l2 >> 4); }
  __syncthreads();
#undef SA
#undef SB
}

typedef f32x4 AccT[2][2][4][2];

struct EpiInproj {
  const Params* p; int pn;
  DI void operator()(const AccT& acc, int brow, int bcol, int wr, int wc, int fr, int fq) const {
    char* ws = p->ws;
    const float* cs = (const float*)(ws + OFF_COS); const float* sn = (const float*)(ws + OFF_SIN);
    const int hl = wc >> 1, dlo = ((wc & 1) * 4 + fq) * 8;
    const bool rope = (pn >= 12 && pn < 16) || pn == 18 || pn == 20;
#pragma unroll
    for (int ai = 0; ai < 2; ++ai)
#pragma unroll
      for (int m = 0; m < 4; ++m) {
        const int token = brow + ai * 128 + wr * 64 + m * 16 + fr;
        const int b = token >> 12, s = token & 4095;
        f32x4 a0 = acc[ai][0][m][0], a1 = acc[ai][0][m][1], b0 = acc[ai][1][m][0], b1 = acc[ai][1][m][1];
        if (rope) {
          const f32x4 c0 = *(const f32x4*)(cs + (size_t)token * 64 + dlo), c1 = *(const f32x4*)(cs + (size_t)token * 64 + dlo + 4);
          const f32x4 s0 = *(const f32x4*)(sn + (size_t)token * 64 + dlo), s1 = *(const f32x4*)(sn + (size_t)token * 64 + dlo + 4);
          const f32x4 y0 = a0 * c0 - b0 * s0, y1 = a1 * c1 - b1 * s1, z0 = b0 * c0 + a0 * s0, z1 = b1 * c1 + a1 * s1;
          a0 = y0; a1 = y1; b0 = z0; b1 = z1;
        }
        unsigned h[8], l[8];
        split2(a0[0], a0[1], h[0], l[0]); split2(a0[2], a0[3], h[1], l[1]); split2(a1[0], a1[1], h[2], l[2]); split2(a1[2], a1[3], h[3], l[3]);
        split2(b0[0], b0[1], h[4], l[4]); split2(b0[2], b0[3], h[5], l[5]); split2(b1[0], b1[1], h[6], l[6]); split2(b1[2], b1[3], h[7], l[7]);
        size_t o; size_t off_hi; size_t off_lo = 0; bool has_lo = false;
        if (pn < 8) { o = (size_t)token * 1024 + ((pn & 3) * 2 + hl) * 128 + dlo; off_hi = pn < 4 ? OFF_QF : OFF_KF; }
        else if (pn < 16) { o = (size_t)token * 1024 + ((pn - 12) * 2 + hl) * 128 + dlo; off_hi = OFF_QN_HI; off_lo = OFF_QN_LO; has_lo = true; }
        else {
          o = ((size_t)(b * 2 + hl) * 4096 + s) * 128 + dlo;
          off_hi = pn == 16 ? OFF_KCIN_HI : (pn == 17 ? OFF_VCIN : (pn == 18 ? OFF_KS : OFF_KW));
          if (pn == 16) { off_lo = OFF_KCIN_LO; has_lo = true; }
        }
        bf16_t* dh = (bf16_t*)(ws + off_hi) + o;
        *(u32x4*)dh = (u32x4){h[0], h[1], h[2], h[3]};
        *(u32x4*)(dh + 64) = (u32x4){h[4], h[5], h[6], h[7]};
        if (has_lo) {
          bf16_t* dl = (bf16_t*)(ws + off_lo) + o;
          *(u32x4*)dl = (u32x4){l[0], l[1], l[2], l[3]};
          *(u32x4*)(dl + 64) = (u32x4){l[4], l[5], l[6], l[7]};
        }
      }
  }
};

struct EpiVT {
  bf16_t* dst; int nheads; int sec_row0;
  DI void operator()(const AccT& acc, int brow, int bcol, int wr, int wc, int fr, int fq) const {
#pragma unroll
    for (int ai = 0; ai < 2; ++ai)
#pragma unroll
      for (int m = 0; m < 4; ++m) {
        const int vr = brow - sec_row0 + ai * 128 + wr * 64 + m * 16 + fr;
        const int head = vr >> 7, d = vr & 127;
#pragma unroll
        for (int bj = 0; bj < 2; ++bj)
#pragma unroll
          for (int n = 0; n < 2; ++n) {
            const int tk = bcol + bj * 128 + wc * 32 + n * 16 + fq * 4;
            const int b = tk >> 12, s = tk & 4095;
            const f32x4 v = acc[ai][bj][m][n];
            *(u32x2*)(dst + ((size_t)(b * nheads + head) * 128 + d) * 4096 + s) = (u32x2){pack2(v[0], v[1]), pack2(v[2], v[3])};
          }
      }
  }
};

struct EpiF32 {
  float* dst; int ld;
  DI void operator()(const AccT& acc, int brow, int bcol, int wr, int wc, int fr, int fq) const {
#pragma unroll
    for (int ai = 0; ai < 2; ++ai)
#pragma unroll
      for (int m = 0; m < 4; ++m) {
        const int row = brow + ai * 128 + wr * 64 + m * 16 + fr;
#pragma unroll
        for (int bj = 0; bj < 2; ++bj)
#pragma unroll
          for (int n = 0; n < 2; ++n)
            *(f32x4*)(dst + (size_t)row * ld + bcol + bj * 128 + wc * 32 + n * 16 + fq * 4) = acc[ai][bj][m][n];
      }
  }
};

struct EpiResid {
  float* dst; const float* base; const float* gate;
  DI void operator()(const AccT& acc, int brow, int bcol, int wr, int wc, int fr, int fq) const {
#pragma unroll
    for (int ai = 0; ai < 2; ++ai)
#pragma unroll
      for (int m = 0; m < 4; ++m) {
        const int row = brow + ai * 128 + wr * 64 + m * 16 + fr;
        const int b = row >> 12;
#pragma unroll
        for (int bj = 0; bj < 2; ++bj)
#pragma unroll
          for (int n = 0; n < 2; ++n) {
            const int col = bcol + bj * 128 + wc * 32 + n * 16 + fq * 4;
            const f32x4 xv = *(const f32x4*)(base + (size_t)row * 2048 + col);
            const f32x4 gv = *(const f32x4*)(gate + b * 12288 + col);
            *(f32x4*)(dst + (size_t)row * 2048 + col) = xv + gv * acc[ai][bj][m][n];
          }
      }
  }
};

struct EpiSwiglu {
  bf16_t* act;
  DI void operator()(const AccT& acc, int brow, int bcol, int wr, int wc, int fr, int fq) const {
    const int pn = bcol >> 8;
#pragma unroll
    for (int ai = 0; ai < 2; ++ai)
#pragma unroll
      for (int m = 0; m < 4; ++m) {
        const int row = brow + ai * 128 + wr * 64 + m * 16 + fr;
        float r[8];
#pragma unroll
        for (int n = 0; n < 2; ++n) {
          const f32x4 gt = acc[ai][0][m][n], up = acc[ai][1][m][n];
#pragma unroll
          for (int j = 0; j < 4; ++j) r[n * 4 + j] = silu_fast(gt[j]) * up[j];
        }
        *(u32x4*)(act + (size_t)row * DFF + pn * 128 + wc * 32 + fq * 8) = (u32x4){pack2(r[0], r[1]), pack2(r[2], r[3]), pack2(r[4], r[5]), pack2(r[6], r[7])};
      }
  }
};

DI int map_win(int c, int& lo_row) {
  lo_row = -1;
  if (c < 2048) return (c & ~255) + perm256(c & 255);
  if (c < 3072) return c;
  if (c < 3080) return 5632 + (c - 3072);
  if (c < 4104) { int cc = c - 3080; int d = 3072 + (cc & ~255) + perm256(cc & 255); lo_row = d - 3072; return d; }
  if (c < 4360) { int cc = c - 4104; int d = 4096 + perm256(cc); lo_row = d - 3072; return d; }
  if (c < 4616) { int cc = c - 4360; return 4352 + perm256(cc); }
  if (c < 4872) { int cc = c - 4616; return 4608 + perm256(cc); }
  if (c < 5128) return 4864 + (c - 4872);
  if (c < 5384) { int cc = c - 5128; return 5120 + perm256(cc); }
  if (c < 5640) return 5376 + (c - 5384);
  return c;
}

struct TInfo { const float* src; bf16_t* dh; bf16_t* dl; int N, Kd, mat, k0, n0; };
constexpr int TJ_WIN = 16 * 89, TJ_WOUT = 16 * 32, TJ_WG = 16 * 88, TJ_WD = 44 * 32, TJ_W1 = 32 * 4;
constexpr int TE0 = TJ_WIN, TE1 = TE0 + TJ_WOUT, TE2 = TE1 + TJ_WG, TE3 = TE2 + TJ_WG, TE4 = TE3 + TJ_WD, TE5 = TE4 + TJ_W1, TE6 = TE5 + TJ_W1;
DI void tile_info(const Params& p, int t, TInfo& ti) {
  char* ws = p.ws; ti.dl = nullptr; int nn;
  if (t < TE0) { ti.mat = 0; ti.src = p.w_in; ti.N = DIN; ti.Kd = 2048; ti.dh = (bf16_t*)(ws + OFF_WIN_HI); ti.dl = (bf16_t*)(ws + OFF_WIN_LO); nn = 89; }
  else if (t < TE1) { t -= TE0; ti.mat = 1; ti.src = p.w_out; ti.N = 2048; ti.Kd = 2048; ti.dh = (bf16_t*)(ws + OFF_WOUT); nn = 32; }
  else if (t < TE2) { t -= TE1; ti.mat = 2; ti.src = p.w_gate; ti.N = DFF; ti.Kd = 2048; ti.dh = (bf16_t*)(ws + OFF_WGU); nn = 88; }
  else if (t < TE3) { t -= TE2; ti.mat = 3; ti.src = p.w_up; ti.N = DFF; ti.Kd = 2048; ti.dh = (bf16_t*)(ws + OFF_WGU); nn = 88; }
  else if (t < TE4) { t -= TE3; ti.mat = 4; ti.src = p.w_down; ti.N = 2048; ti.Kd = DFF; ti.dh = (bf16_t*)(ws + OFF_WDN); nn = 32; }
  else if (t < TE5) { t -= TE4; ti.mat = 5; ti.src = p.w_kc1; ti.N = 256; ti.Kd = 4096; ti.dh = (bf16_t*)(ws + OFF_W1K_HI); ti.dl = (bf16_t*)(ws + OFF_W1K_LO); nn = 4; }
  else { t -= TE5; ti.mat = 6; ti.src = p.w_vc1; ti.N = 256; ti.Kd = 4096; ti.dh = (bf16_t*)(ws + OFF_W1V); nn = 4; }
  ti.k0 = (t / nn) * 128; ti.n0 = (t % nn) * 64;
}
DI void tr_load(const TInfo& ti, int tid, f32x4 (&r)[4]) {
#pragma unroll
  for (int i = 0; i < 4; ++i) {
    const int idx = tid + i * 512, k = idx >> 4, col = ti.n0 + (idx & 15) * 4;
    r[i] = col < ti.N ? __builtin_nontemporal_load((const f32x4*)(ti.src + (size_t)(ti.k0 + k) * ti.N + col)) : (f32x4){0.f, 0.f, 0.f, 0.f};
  }
}
DI void tr_lds_write(float* tile, int tid, const f32x4 (&r)[4]) {
#pragma unroll
  for (int i = 0; i < 4; ++i) {
    const int idx = tid + i * 512, k = idx >> 4, c = (idx & 15) * 4;
#pragma unroll
    for (int j = 0; j < 4; ++j) tile[k * 65 + c + j] = r[i][j];
  }
}
DI void tr_store(const TInfo& ti, const float* tile, int tid) {
#pragma unroll
  for (int i = 0; i < 2; ++i) {
    const int idx = tid + i * 512, nr = idx >> 4, kc = idx & 15, col = ti.n0 + nr;
    if (col < ti.N) {
      int row, lrow = -1;
      if (ti.mat == 0) row = map_win(col, lrow);
      else if (ti.mat == 2) row = (col >> 7) * 256 + perm_gu(col & 127);
      else if (ti.mat == 3) row = (col >> 7) * 256 + 128 + perm_gu(col & 127);
      else { row = col; if (ti.mat == 5) lrow = col; }
      float v[8];
#pragma unroll
      for (int e = 0; e < 8; ++e) v[e] = tile[(kc * 8 + e) * 65 + nr];
      *(u32x4*)(ti.dh + (size_t)row * ti.Kd + ti.k0 + kc * 8) = (u32x4){pack2(v[0], v[1]), pack2(v[2], v[3]), pack2(v[4], v[5]), pack2(v[6], v[7])};
      if (lrow >= 0)
        *(u32x4*)(ti.dl + (size_t)lrow * ti.Kd + ti.k0 + kc * 8) = (u32x4){pack2(lo_of(v[0]), lo_of(v[1])), pack2(lo_of(v[2]), lo_of(v[3])), pack2(lo_of(v[4]), lo_of(v[5])), pack2(lo_of(v[6]), lo_of(v[7]))};
    }
  }
}
DI void transpose_all(const Params& p) {
  float* lds = (float*)g_smem;
  int tid = threadIdx.x; asm volatile("" : "+v"(tid));
  const int G = gridDim.x;
  int t0 = blockIdx.x, t1 = t0 + G;
  TInfo ia, ib; f32x4 ra[4], rb[4];
  if (t0 < TE6) { tile_info(p, t0, ia); tr_load(ia, tid, ra); }
  if (t1 < TE6) { tile_info(p, t1, ib); tr_load(ib, tid, rb); }
  while (t0 < TE6) {
    tr_lds_write(lds, tid, ra);
    __syncthreads();
    const TInfo cura = ia;
    const int t2 = t0 + 2 * G;
    if (t2 < TE6) { tile_info(p, t2, ia); tr_load(ia, tid, ra); }
    tr_store(cura, lds, tid);
    if (t1 >= TE6) break;
    tr_lds_write(lds + 128 * 65, tid, rb);
    __syncthreads();
    const TInfo curb = ib;
    const int t3 = t1 + 2 * G;
    if (t3 < TE6) { tile_info(p, t3, ib); tr_load(ib, tid, rb); }
    tr_store(curb, lds + 128 * 65, tid);
    t0 = t2; t1 = t3;
  }
  __syncthreads();
}

DI void mod_job(const Params& p, int job) {
  float* sc = (float*)g_smem;
  float* red = sc + 4096;
  const int tid = threadIdx.x, wave = tid >> 6, lane = tid & 63;
  for (int i = tid; i < 4096; i += 512) sc[i] = siluf_(p.c[i]);
  __syncthreads();
  const int n0 = job * 64, cgp = lane & 15, kr = lane >> 4;
  f32x4 a0 = {0.f, 0.f, 0.f, 0.f}, a1 = {0.f, 0.f, 0.f, 0.f};
#pragma unroll 8
  for (int k = wave * 4 + kr; k < 2048; k += 32) {
    const f32x4 wv = __builtin_nontemporal_load((const f32x4*)(p.w_ada + (size_t)k * 12288 + n0 + cgp * 4));
    a0 += wv * sc[k]; a1 += wv * sc[2048 + k];
  }
#pragma unroll
  for (int j = 0; j < 4; ++j) {
    a0[j] += __shfl_xor(a0[j], 16); a0[j] += __shfl_xor(a0[j], 32);
    a1[j] += __shfl_xor(a1[j], 16); a1[j] += __shfl_xor(a1[j], 32);
  }
  if (kr == 0) {
#pragma unroll
    for (int j = 0; j < 4; ++j) { red[(wave * 2 + 0) * 64 + cgp * 4 + j] = a0[j]; red[(wave * 2 + 1) * 64 + cgp * 4 + j] = a1[j]; }
  }
  __syncthreads();
  if (tid < 128) {
    const int b = tid >> 6, col = tid & 63;
    float s = p.b_ada[n0 + col];
#pragma unroll
    for (int w = 0; w < 8; ++w) s += red[(w * 2 + b) * 64 + col];
    ((float*)(p.ws + OFF_MOD))[b * 12288 + n0 + col] = s;
  }
  __syncthreads();
}

DI void bias1_job(const Params& p, int j) {
  const int which = j >> 4, chunk = j & 15;
  const float* w1 = which ? p.w_vc1 : p.w_kc1;
  float* red = (float*)g_smem;
  const int tid = threadIdx.x, col = tid & 255, half = tid >> 8;
  float s = 0.f;
  const int kb = chunk * 256 + half * 128;
#pragma unroll 16
  for (int k = kb; k < kb + 128; ++k) s += p.cmp_pos[k] * w1[(size_t)k * 256 + col];
  red[tid] = s;
  __syncthreads();
  if (tid < 256) ((float*)(p.ws + OFF_BIAS1))[(which * 16 + chunk) * 256 + tid] = red[tid] + red[tid + 256];
  __syncthreads();
}

DI void rope_job(const Params& p, int job) {
  const int idx = job * 512 + threadIdx.x, token = idx >> 6, i = idx & 63;
  const float ang = (float)p.pos[token] * c_inv_freq[i];
  double t = (double)ang * 0.15915494309189535;
  t -= floor(t + 0.5);
  const float tf = (float)t;
  ((float*)(p.ws + OFF_COS))[idx] = __builtin_amdgcn_cosf(tf);
  ((float*)(p.ws + OFF_SIN))[idx] = __builtin_amdgcn_sinf(tf);
}

DI void phase0(const Params& p) {
  transpose_all(p);
  constexpr int J_MOD = 192, J_B1 = 32, J_ROPE = 1024;
  for (int job = blockIdx.x; job < J_MOD + J_B1 + J_ROPE; job += gridDim.x) {
    if (job < J_MOD) mod_job(p, job);
    else if (job < J_MOD + J_B1) bias1_job(p, job - J_MOD);
    else rope_job(p, job - J_MOD - J_B1);
  }
}

DI void rmsmod_phase(const float* src, const float* g, const float* mod, int sh_off, int sc_off, bf16_t* dhi, bf16_t* dlo) {
  const int wave = threadIdx.x >> 6, lane = threadIdx.x & 63;
  for (int row = blockIdx.x * 8 + wave; row < T_TOK; row += gridDim.x * 8) {
    const int b = row >> 12;
    const f32x4* xr = (const f32x4*)(src + (size_t)row * 2048);
    f32x4 v[8]; float ss = 0.f;
#pragma unroll
    for (int i = 0; i < 8; ++i) { v[i] = xr[lane + i * 64]; ss += v[i][0] * v[i][0] + v[i][1] * v[i][1] + v[i][2] * v[i][2] + v[i][3] * v[i][3]; }
    ss = wave_sum(ss);
    const float rstd = rsqrtf(ss * (1.f / 2048.f) + 1e-6f);
#pragma unroll
    for (int i = 0; i < 8; ++i) {
      const int col = (lane + i * 64) * 4;
      const f32x4 gv = *(const f32x4*)(g + col);
      const f32x4 sc = *(const f32x4*)(mod + b * 12288 + sc_off + col), sh = *(const f32x4*)(mod + b * 12288 + sh_off + col);
      f32x4 u = (v[i] * rstd) * gv; u = u * (1.f + sc) + sh;
      unsigned h0, h1, l0, l1; split2(u[0], u[1], h0, l0); split2(u[2], u[3], h1, l1);
      *(u32x2*)(dhi + (size_t)row * 2048 + col) = (u32x2){h0, h1};
      if (dlo) *(u32x2*)(dlo + (size_t)row * 2048 + col) = (u32x2){l0, l1};
    }
  }
}

DI void ymix_phase(const Params& p) {
  const int wave = threadIdx.x >> 6, lane = threadIdx.x & 63;
  bf16_t* ym = (bf16_t*)(p.ws + OFF_U_HI);
  for (int row = blockIdx.x * 8 + wave; row < T_TOK; row += gridDim.x * 8) {
#pragma unroll
    for (int part = 0; part < 2; ++part) {
      const f32x4* xr = (const f32x4*)((const float*)(p.ws + (part ? OFF_ON32 : OFF_OF32)) + (size_t)row * 1024);
      const float* beta = part ? p.beta_nsa : p.beta_fox;
      f32x4 v[4]; float ss = 0.f;
#pragma unroll
      for (int i = 0; i < 4; ++i) { v[i] = xr[lane + i * 64]; ss += v[i][0] * v[i][0] + v[i][1] * v[i][1] + v[i][2] * v[i][2] + v[i][3] * v[i][3]; }
      ss = wave_sum(ss);
      const float rstd = rsqrtf(ss * (1.f / 1024.f) + 1e-6f);
#pragma unroll
      for (int i = 0; i < 4; ++i) {
        const int col = (lane + i * 64) * 4;
        const f32x4 u = (v[i] * rstd) * *(const f32x4*)(beta + col);
        *(u32x2*)(ym + (size_t)row * 2048 + part * 1024 + col) = (u32x2){pack2(u[0], u[1]), pack2(u[2], u[3])};
      }
    }
  }
}

DI void final_phase(const Params& p) {
  const int wave = threadIdx.x >> 6, lane = threadIdx.x & 63;
  for (int row = blockIdx.x * 8 + wave; row < T_TOK; row += gridDim.x * 8) {
    f32x4* xr = (f32x4*)(p.out + (size_t)row * 2048);
    f32x4 v[8]; float ss = 0.f;
#pragma unroll
    for (int i = 0; i < 8; ++i) { v[i] = xr[lane + i * 64]; ss += v[i][0] * v[i][0] + v[i][1] * v[i][1] + v[i][2] * v[i][2] + v[i][3] * v[i][3]; }
    ss = wave_sum(ss);
    const float rstd = rsqrtf(ss * (1.f / 2048.f) + 1e-6f);
#pragma unroll
    for (int i = 0; i < 8; ++i) xr[lane + i * 64] = (v[i] * rstd) * *(const f32x4*)(p.final_norm + (lane + i * 64) * 4);
  }
}

typedef float f32x4_ __attribute__((ext_vector_type(4)));
DI void misc_job(const Params& p, int piece) {
  char* ws = p.ws;
  int tid = threadIdx.x; asm volatile("" : "+v"(tid));
  const int wave = tid >> 6, lane = tid & 63, fr = lane & 15, fq = lane >> 4;
  const bf16_t* A = (const bf16_t*)(ws + OFF_U_HI) + (size_t)(piece * 32 + fr) * 2048 + fq * 8 + wave * 256;
  const bf16_t* B = (const bf16_t*)(ws + OFF_WIN_HI) + (size_t)(5632 + fr) * 2048 + fq * 8 + wave * 256;
  f32x4 acc[2][2] = {};
#pragma unroll
  for (int k = 0; k < 8; ++k) {
    const bf16x8 a0 = *(const bf16x8*)(A + k * 32), a1 = *(const bf16x8*)(A + 16 * 2048 + k * 32);
    const bf16x8 b0 = *(const bf16x8*)(B + k * 32), b1 = *(const bf16x8*)(B + 16 * 2048 + k * 32);
    acc[0][0] = __builtin_amdgcn_mfma_f32_16x16x32_bf16(a0, b0, acc[0][0], 0, 0, 0);
    acc[0][1] = __builtin_amdgcn_mfma_f32_16x16x32_bf16(a0, b1, acc[0][1], 0, 0, 0);
    acc[1][0] = __builtin_amdgcn_mfma_f32_16x16x32_bf16(a1, b0, acc[1][0], 0, 0, 0);
    acc[1][1] = __builtin_amdgcn_mfma_f32_16x16x32_bf16(a1, b1, acc[1][1], 0, 0, 0);
  }
  f32x4* red = (f32x4*)g_smem;
#pragma unroll
  for (int q = 0; q < 4; ++q) red[(wave * 4 + q) * 64 + lane] = acc[q >> 1][q & 1];
  __syncthreads();
  if (tid < 256) {
    const int q = tid >> 6, l = tid & 63, mb = q >> 1, nb = q & 1, fr2 = l & 15, fq2 = l >> 4;
    f32x4 sum = red[q * 64 + l];
#pragma unroll
    for (int w = 1; w < 8; ++w) sum += red[(w * 4 + q) * 64 + l];
    const int col = nb * 16 + fr2;
#pragma unroll
    for (int j = 0; j < 4; ++j) {
      const int token = piece * 32 + mb * 16 + fq2 * 4 + j;
      if (col < 8) ((float*)(ws + OFF_LOGF))[token * 8 + col] = log_sigmoid(sum[j] + p.b_fgate[col]);
      else ((float*)(ws + OFF_GATES))[token * 24 + col - 8] = sigmoidf_(sum[j]);
    }
  }
  __syncthreads();
}
DI void inproj_heavy(const Params& p, int job) {
  char* ws = p.ws;
  const bf16_t* uhi = (const bf16_t*)(ws + OFF_U_HI); const bf16_t* ulo = (const bf16_t*)(ws + OFF_U_LO);
  const bf16_t* whi = (const bf16_t*)(ws + OFF_WIN_HI); const bf16_t* wlo = (const bf16_t*)(ws + OFF_WIN_LO);
  const int pn = 12 + job / 32, pm = job % 32;
  GemmOp g; g.lda = 2048; g.ldb = 2048;
  g.A0 = uhi; g.A1 = uhi; g.A2 = ulo; g.B0 = whi; g.B1 = wlo - (size_t)3072 * 2048; g.B2 = whi; g.nt = 96; g.shift = 5;
  EpiInproj e{&p, pn};
  gemm_tile(g, pm * 256, pn * 256, e);
}
DI void inproj_light(const Params& p, int L) {
  char* ws = p.ws;
  const bf16_t* uhi = (const bf16_t*)(ws + OFF_U_HI); const bf16_t* whi = (const bf16_t*)(ws + OFF_WIN_HI);
  GemmOp g; g.lda = 2048; g.ldb = 2048; g.nt = 32; g.shift = 5;
  if (L < 352) {
    const int t = L / 32, pm = L % 32;
    const int pn = t < 8 ? t : (t == 8 ? 17 : (t == 9 ? 18 : 20));
    g.A0 = g.A1 = g.A2 = uhi; g.B0 = g.B1 = g.B2 = whi;
    EpiInproj e{&p, pn};
    gemm_tile(g, pm * 256, pn * 256, e);
  } else {
    const int j = L - 352, rt = j / 32, tt = j % 32;
    int wrow; bf16_t* dst; int nh, sec0;
    if (rt < 4) { wrow = 2048 + rt * 256; dst = (bf16_t*)(ws + OFF_VFT); nh = 8; sec0 = 2048; }
    else if (rt == 4) { wrow = 4864; dst = (bf16_t*)(ws + OFF_VST); nh = 2; sec0 = 4864; }
    else { wrow = 5376; dst = (bf16_t*)(ws + OFF_VWT); nh = 2; sec0 = 5376; }
    g.A0 = g.A1 = g.A2 = whi; g.B0 = g.B1 = g.B2 = uhi;
    EpiVT e{dst, nh, sec0};
    gemm_tile(g, wrow, tt * 256, e);
  }
}
DI void inproj_phase(const Params& p, bool dry) {
  if (gridDim.x == 256) {
    const int c = blockIdx.x;
    if (c < 160) { inproj_heavy(p, c); inproj_light(p, c); }
    else { for (int i = 0; i < 4; ++i) inproj_light(p, 160 + (c - 160) * 4 + i); }
    if (!dry) misc_job(p, c);
  } else {
    FOR_JOBS(job, 160) inproj_heavy(p, job);
    FOR_JOBS(job, 544) inproj_light(p, job);
    FOR_JOBS(job, 256) misc_job(p, job);
  }
}

constexpr int KSTR = 272, VSTR = 264;
constexpr int ST_K = 0, ST_V = 128 * KSTR, ST_C = ST_V + 128 * VSTR, ST_SIZE = ST_C + 512;
constexpr int LDS_LIST = 2 * ST_SIZE;

DI bf16x8 pack8(const f32x16& x, int s) {
  u32x4 r;
  r[0] = pack2(x[8 * s + 0], x[8 * s + 1]); r[1] = pack2(x[8 * s + 2], x[8 * s + 3]);
  r[2] = pack2(x[8 * s + 4], x[8 * s + 5]); r[3] = pack2(x[8 * s + 6], x[8 * s + 7]);
  return __builtin_bit_cast(bf16x8, r);
}
DI bf16x8 ldv8(const char* p) {
  const u32x2 a = *(const u32x2*)p, b = *(const u32x2*)(p + 16);
  u32x4 r = {a[0], a[1], b[0], b[1]};
  return __builtin_bit_cast(bf16x8, r);
}

constexpr int AS_K = 0, AS_V = 32768, AS_C = 65536, AS_SIZE = 66048;
constexpr int LDS_LIST2 = 2 * AS_SIZE;
DI int pi23(int r) { return (r & ~12) | ((r & 4) << 1) | ((r & 8) >> 1); }
template <int MODE>
DI void attn_unit(const Params& p, int b, int hg, int qt, bool dry = false) {
  char* ws = p.ws;
  int tid = threadIdx.x; asm volatile("" : "+v"(tid));
  const int wave = tid >> 6, lane = tid & 63, l32 = lane & 31, hh = lane >> 5, rg = wave & 3, kh = wave >> 2;
  int token, head; const bf16_t *qrow, *kbase, *vbase; int kstride;
  if (MODE == 0) {
    token = qt * 128 + rg * 32 + l32; head = hg;
    qrow = (const bf16_t*)(ws + OFF_QF) + (size_t)(b * 4096 + token) * 1024 + head * 128;
    kbase = (const bf16_t*)(ws + OFF_KF) + (size_t)b * 4096 * 1024 + head * 128; kstride = 1024;
    vbase = (const bf16_t*)(ws + OFF_VFT) + (size_t)(b * 8 + head) * 128 * 4096;
  } else {
    if (MODE == 1) { token = qt * 32 + l32; head = hg * 4 + rg; }
    else { token = qt * 32 + rg * 8 + (l32 >> 2); head = hg * 4 + (l32 & 3); }
    qrow = (const bf16_t*)(ws + OFF_QN_HI) + (size_t)(b * 4096 + token) * 1024 + head * 128;
    kbase = (const bf16_t*)(ws + (MODE == 1 ? OFF_KW : OFF_KS)) + (size_t)(b * 2 + hg) * 4096 * 128; kstride = 128;
    vbase = (const bf16_t*)(ws + (MODE == 1 ? OFF_VWT : OFF_VST)) + (size_t)(b * 2 + hg) * 128 * 4096;
  }
  const int wtmin = MODE == 0 ? qt * 128 + rg * 32 : (MODE == 1 ? qt * 32 : qt * 32 + rg * 8), wtmax = wtmin + (MODE == 2 ? 7 : 31);
  int nst, kv_start = 0;
  int* list = (int*)(g_smem + LDS_LIST2);
  unsigned long long selmask = 0;
  if (MODE == 0) nst = qt + 1;
  else if (MODE == 1) { int lo = qt * 32 - 511; if (lo < 0) lo = 0; kv_start = lo & ~63; nst = (qt * 32 + 32 - kv_start + 127) >> 7; }
  else {
    const unsigned long long* sel = (const unsigned long long*)(ws + OFF_SEL) + (size_t)(b * 2 + hg) * 4096;
    selmask = sel[token];
    if (wave == 0) {
      const unsigned long long sm0 = sel[qt * 32 + l32];
      unsigned lo = (unsigned)sm0, hi = (unsigned)(sm0 >> 32);
#pragma unroll
      for (int o = 16; o > 0; o >>= 1) { lo |= __shfl_xor(lo, o); hi |= __shfl_xor(hi, o); }
      const unsigned long long um = ((unsigned long long)hi << 32) | lo;
      if ((um >> lane) & 1ull) list[1 + __popcll(um & ((1ull << lane) - 1ull))] = lane;
      if (lane == 0) list[0] = __popcll(um);
    }
    __syncthreads();
    nst = (list[0] + 1) >> 1;
  }
  bf16x8 qf[8];
#pragma unroll
  for (int ks = 0; ks < 8; ++ks) qf[ks] = *(const bf16x8*)(qrow + ks * 16 + hh * 8);
  float cumq = 0.f;
  const float* cumrow = nullptr;
  if (MODE == 0) { cumrow = (const float*)(ws + OFF_CUM) + (size_t)(b * 8 + head) * 4096; cumq = cumrow[token]; }

  f32x16 o[4];
#pragma unroll
  for (int i = 0; i < 4; ++i) o[i] = zero16();
  float mrun = -1e30f, lrun = 0.f;

  auto tile_base = [&](int it, int half) -> int {
    if (MODE == 2) { const int i = 2 * it + half; return i < list[0] ? list[1 + i] * 64 : -1; }
    return kv_start + it * 128 + half * 64;
  };
  const int rsub = lane >> 4, slot = lane & 15;
  unsigned koff[4], voff[4]; bool vhalf[4];
#pragma unroll
  for (int j = 0; j < 4; ++j) {
    const int row = (j * 8 + wave) * 4 + rsub;
    const int c = slot ^ (row & 15);
    koff[j] = (unsigned)(pi23(row & 63) * kstride + c * 8) * 2u;
    vhalf[j] = (c >> 3) != 0;
    voff[j] = MODE == 2 ? (unsigned)(row * 4096 + (c & 7) * 8) * 2u : (unsigned)(row * 4096 + c * 8) * 2u;
  }
  auto issue_stage = [&](int it, int buf) {
    if (DRY_MODE == 2 && dry) return;
    int kb0 = tile_base(it, 0), kb1 = tile_base(it, 1);
    if (kb1 < 0) kb1 = 0;
    char* sb = g_smem + buf * AS_SIZE;
    const char* kp0 = uptr((const char*)(kbase + (size_t)kb0 * kstride));
    const char* kp1 = uptr((const char*)(kbase + (size_t)kb1 * kstride));
    const char* vp0 = uptr((const char*)(vbase + kb0));
    const char* vp1 = uptr((const char*)(vbase + kb1));
#pragma unroll
    for (int j = 0; j < 4; ++j) {
      __builtin_amdgcn_global_load_lds((const unsigned*)((j >> 1 ? kp1 : kp0) + koff[j]), (unsigned*)(sb + AS_K + (j * 8 + wave) * 1024 + lane * 16), 16, 0, 0);
      const char* vsrc = MODE == 2 ? ((vhalf[j] ? vp1 : vp0) + voff[j]) : (vp0 + voff[j]);
      __builtin_amdgcn_global_load_lds((const unsigned*)vsrc, (unsigned*)(sb + AS_V + (j * 8 + wave) * 1024 + lane * 16), 16, 0, 0);
    }
    if (MODE == 0 && wave < 2) {
      const int key = (wave ? kb1 : kb0) + lane;
      __builtin_amdgcn_global_load_lds((const unsigned*)(cumrow + key), (unsigned*)(sb + AS_C + wave * 256 + lane * 4), 4, 0, 0);
    }
  };

  int it0 = 0;
  if (MODE == 0) {
    float q2 = 0.f;
#pragma unroll
    for (int ks = 0; ks < 8; ++ks)
#pragma unroll
      for (int e = 0; e < 8; ++e) { const float f = bf2f((unsigned short)qf[ks][e]); q2 += f * f; }
    q2 = xsum32(q2);
#pragma unroll
    for (int o2 = 16; o2 > 0; o2 >>= 1) q2 = fmaxf(q2, __shfl_xor(q2, o2));
    const float* kn = (const float*)(ws + OFF_KNORM) + (size_t)(b * 8 + head) * 128;
    float k2 = fmaxf(kn[lane], kn[lane + 64]);
#pragma unroll
    for (int o2 = 32; o2 > 0; o2 >>= 1) k2 = fmaxf(k2, __shfl_xor(k2, o2));
    float* qx = (float*)(g_smem + LDS_LIST2);
    if (lane == 0) qx[wave] = q2;
    __syncthreads();
    const float q2m = fmaxf(fmaxf(qx[0], qx[1]), fmaxf(qx[2], qx[3]));
    const float xub = sqrtf(q2m * k2) * (QK_C1 * 1.001f) + 0.01f;
    const float cend = lane < qt ? cumrow[lane * 128 + 127] : cumrow[qt * 128];
    const float bub = (cumrow[qt * 128] - cend) * LOG2E;
    const bool skip = lane < qt && (2.f * xub + bub < -160.f);
    const unsigned long long sk = __ballot(skip);
    it0 = (int)__builtin_ctzll(~sk);
    if (it0 > qt) it0 = qt;
    it0 = __builtin_amdgcn_readfirstlane(it0);
  }
#pragma unroll
  for (int ks = 0; ks < 8; ++ks) asm volatile("" :: "v"(qf[ks]));
  asm volatile("" :: "v"(cumq));
  issue_stage(it0, it0 & 1);
  for (int it = it0; it < nst; ++it) {
    asm volatile("s_waitcnt vmcnt(0)" ::: "memory");
    __builtin_amdgcn_s_barrier();
    if (it + 1 < nst) issue_stage(it + 1, (it + 1) & 1);
    const char* sb = g_smem + (it & 1) * AS_SIZE;
    const int kbh = tile_base(it, kh);
    bool active;
    if (MODE == 0) active = kbh <= wtmax;
    else if (MODE == 1) active = kbh <= wtmax && kbh + 63 >= wtmin - 511;
    else active = kbh >= 0;
    if (DRY_MODE == 1 && dry) active = false;
    const bool selbit = (MODE == 2 && kbh >= 0) ? ((selmask >> (kbh >> 6)) & 1ull) != 0 : true;
    if (MODE == 2) active = active && __any(selbit);
    if (active) {
      f32x16 stA = zero16(), stB = zero16();
      {
        const int row = kh * 64 + l32;
        const char* kp = sb + AS_K + row * 256;
        const int sw = row & 15;
#pragma unroll
        for (int ks = 0; ks < 8; ++ks) stA = mfma32(*(const bf16x8*)(kp + (((ks * 2 + hh) ^ sw) << 4)), qf[ks], stA);
#pragma unroll
        for (int ks = 0; ks < 8; ++ks) stB = mfma32(*(const bf16x8*)(kp + 32 * 256 + (((ks * 2 + hh) ^ sw) << 4)), qf[ks], stB);
      }
      const int tq0 = token - kbh - hh * 8;
      bf16x8 pk0, pk1;
#define ATTN_SOFTMAX(ST, KB2) do { \
        const int kmin = kbh + (KB2) * 32, kmax = kmin + 31; \
        if (MODE == 0) { \
          f32x16 cs16; \
          _Pragma("unroll") for (int gq = 0; gq < 4; ++gq) { \
            const f32x4 cs = *(const f32x4*)(sb + AS_C + (kh * 64 + (KB2) * 32 + (gq >> 1) * 16 + hh * 8 + (gq & 1) * 4) * 4); \
            cs16[gq * 4] = cs[0]; cs16[gq * 4 + 1] = cs[1]; cs16[gq * 4 + 2] = cs[2]; cs16[gq * 4 + 3] = cs[3]; } \
          ST = ST * QK_C1 + (cs16 * (-LOG2E) + cumq * LOG2E); \
        } else ST = ST * QK_C1; \
        bool need_mask; \
        if (MODE == 0) need_mask = kmax > wtmin; \
        else if (MODE == 1) need_mask = kmax > wtmin || wtmax - kmin >= 512; \
        else need_mask = (kbh >> 6) == (wtmin >> 6); \
        if (need_mask) { \
          _Pragma("unroll") for (int gq = 0; gq < 4; ++gq) _Pragma("unroll") for (int j = 0; j < 4; ++j) { \
            const int kofs = (KB2) * 32 + (gq >> 1) * 16 + (gq & 1) * 4 + j; \
            bool valid = kofs <= tq0; \
            if (MODE == 1) valid = valid && (tq0 - kofs < 512); \
            ST[gq * 4 + j] = valid ? ST[gq * 4 + j] : -1e30f; } } \
        float mx = ST[0]; \
        _Pragma("unroll") for (int r = 1; r < 16; ++r) mx = fmaxf(mx, ST[r]); \
        mx = xmax32(mx); \
        if (MODE == 2) mx = selbit ? mx : -1e30f; \
        const float mnew = (mx > mrun + 8.f) ? mx : mrun;        \
        if (__any(mnew != mrun)) { \
          const float alpha = fexp2(mrun - mnew); \
          lrun *= alpha; \
          _Pragma("unroll") for (int i = 0; i < 4; ++i) o[i] = o[i] * alpha; } \
        mrun = mnew; \
        const float msub = (mnew > -1e29f && selbit) ? mnew : 1e30f; \
        ST = ST - msub; \
        float rs = 0.f; \
        _Pragma("unroll") for (int r = 0; r < 16; ++r) { ST[r] = fexp2(ST[r]); rs += ST[r]; } \
        rs = xsum32(rs); \
        lrun += rs; \
        pk0 = pack8(ST, 0); pk1 = pack8(ST, 1); } while (0)
#define ATTN_PV(KB2) do { \
        _Pragma("unroll") for (int dblk = 0; dblk < 4; ++dblk) { \
          const int d = dblk * 32 + l32; \
          const char* vp = sb + AS_V + d * 256; \
          const int sw = d & 15; \
          o[dblk] = mfma32(*(const bf16x8*)(vp + (((kh * 8 + (KB2) * 4 + hh) ^ sw) << 4)), pk0, o[dblk]); \
          o[dblk] = mfma32(*(const bf16x8*)(vp + (((kh * 8 + (KB2) * 4 + 2 + hh) ^ sw) << 4)), pk1, o[dblk]); } } while (0)
      ATTN_SOFTMAX(stA, 0);
      ATTN_PV(0);
      ATTN_SOFTMAX(stB, 1);
      ATTN_PV(1);
#undef ATTN_SOFTMAX
#undef ATTN_PV
    }
  }
  __syncthreads();
  float* X = (float*)g_smem;
  if (kh == 1) {
#pragma unroll
    for (int i = 0; i < 4; ++i)
#pragma unroll
      for (int r = 0; r < 16; ++r) X[(rg * 66 + i * 16 + r) * 64 + lane] = o[i][r];
    X[(rg * 66 + 64) * 64 + lane] = mrun; X[(rg * 66 + 65) * 64 + lane] = lrun;
  }
  __syncthreads();
  float* Tt = (float*)(g_smem + 67584);
  if (kh == 0) {
    const float m1 = X[(rg * 66 + 64) * 64 + lane], l1 = X[(rg * 66 + 65) * 64 + lane];
    const float mf = fmaxf(mrun, m1);
    const float a0 = fexp2(mrun - mf), a1 = fexp2(m1 - mf);
    const float lt = lrun * a0 + l1 * a1;
    float inv = lt > 0.f ? 1.f / lt : 0.f;
    if (MODE != 0) inv *= ((const float*)(ws + OFF_GATES))[(size_t)(b * 4096 + token) * 24 + head * 3 + (MODE == 1 ? 2 : 1)];
    const float s0 = a0 * inv, s1 = a1 * inv;
    float* trow = Tt + (rg * 32 + l32) * 132;
#pragma unroll
    for (int i = 0; i < 4; ++i)
#pragma unroll
      for (int gq = 0; gq < 4; ++gq) {
        f32x4 v;
#pragma unroll
        for (int j = 0; j < 4; ++j) v[j] = o[i][gq * 4 + j] * s0 + X[(rg * 66 + i * 16 + gq * 4 + j) * 64 + lane] * s1;
        *(f32x4*)(trow + i * 32 + 8 * gq + 4 * hh) = v;
      }
  }
  __syncthreads();
  if (!dry) {
    float* obase = (float*)(ws + (MODE == 0 ? OFF_OF32 : OFF_ON32)) + (size_t)b * 4096 * 1024;
#pragma unroll
    for (int k = 0; k < 8; ++k) {
      const int R = wave * 16 + k * 2 + (lane >> 5), rgr = R >> 5, rr = R & 31, c4 = (lane & 31) * 4;
      int tk, hd;
      if (MODE == 0) { tk = qt * 128 + rgr * 32 + rr; hd = hg; }
      else if (MODE == 1) { tk = qt * 32 + rr; hd = hg * 4 + rgr; }
      else { tk = qt * 32 + rgr * 8 + (rr >> 2); hd = hg * 4 + (rr & 3); }
      float* dp = obase + (size_t)tk * 1024 + hd * 128 + c4;
      f32x4 v = *(const f32x4*)(Tt + R * 132 + c4);
      if (MODE == 2) v += *(const f32x4*)dp;
      *(f32x4*)dp = v;
    }
  }
  __syncthreads();
}

constexpr int CV_STR = 520;
constexpr int C_V = 0, C_K = 128 * CV_STR  , C_KLO = C_K + 128 * KSTR, C_EX = C_KLO + 128 * KSTR  ;
DI void cmp_unit(const Params& p, int b, int g, int qt, bool dry = false) {
  char* ws = p.ws;
  int tid = threadIdx.x; asm volatile("" : "+v"(tid));
  const int wave = tid >> 6, lane = tid & 63, l32 = lane & 31, hh = lane >> 5, rg = wave & 3, kh = wave >> 2;
  const int token = qt * 32 + l32, head = g * 4 + rg, bg = b * 2 + g;
  const bf16_t* qh = (const bf16_t*)(ws + OFF_QN_HI) + (size_t)(b * 4096 + token) * 1024 + head * 128;
  const bf16_t* ql = (const bf16_t*)(ws + OFF_QN_LO) + (size_t)(b * 4096 + token) * 1024 + head * 128;
  const bf16_t* kch = (const bf16_t*)(ws + OFF_KC_HI) + (size_t)bg * 256 * 128;
  const bf16_t* kcl = (const bf16_t*)(ws + OFF_KC_LO) + (size_t)bg * 256 * 128;
  const bf16_t* vct = (const bf16_t*)(ws + OFF_VCT) + (size_t)bg * 128 * 256;
  bf16x8 qfh[8], qfl[8];
#pragma unroll
  for (int ks = 0; ks < 8; ++ks) { qfh[ks] = *(const bf16x8*)(qh + ks * 16 + hh * 8); qfl[ks] = *(const bf16x8*)(ql + ks * 16 + hh * 8); }
#pragma unroll
  for (int i = 0; i < 8; ++i) {
    const int c = tid + i * 512, d = c >> 5, cc = c & 31;
    const u32x4 v = *(const u32x4*)(vct + (size_t)d * 256 + cc * 8);
    char* vd = g_smem + C_V + d * CV_STR + cc * 16;
    *(u32x2*)vd = (u32x2){v[0], v[1]}; *(u32x2*)(vd + 8) = (u32x2){v[2], v[3]};
  }
  f32x16 t4[4];
#pragma unroll
  for (int s = 0; s < 2; ++s) {
#pragma unroll
    for (int i = 0; i < 4; ++i) {
      const int c = tid + i * 512, rr = c >> 4, cc = c & 15;
      const int key = (rr >> 6) * 128 + s * 64 + (rr & 63);
      *(u32x4*)(g_smem + C_K + rr * KSTR + cc * 16) = *(const u32x4*)(kch + (size_t)key * 128 + cc * 8);
      *(u32x4*)(g_smem + C_KLO + rr * KSTR + cc * 16) = *(const u32x4*)(kcl + (size_t)key * 128 + cc * 8);
    }
    __syncthreads();
    {
      f32x16 st0 = zero16(), st1 = zero16();
      const int off = (kh * 64 + l32) * KSTR + hh * 16;
      const int tmaxu = qt * 32 + 31;
      const bool act0 = 16 * (kh * 128 + s * 64) + 31 <= tmaxu, act1 = 16 * (kh * 128 + s * 64 + 32) + 31 <= tmaxu;
      if (act0) {
#pragma unroll
        for (int ks = 0; ks < 8; ++ks) {
          const bf16x8 ah0 = *(const bf16x8*)(g_smem + C_K + off + ks * 32), al0 = *(const bf16x8*)(g_smem + C_KLO + off + ks * 32);
          st0 = mfma32(al0, qfh[ks], st0); st0 = mfma32(ah0, qfl[ks], st0); st0 = mfma32(ah0, qfh[ks], st0);
        }
      }
      if (act1) {
#pragma unroll
        for (int ks = 0; ks < 8; ++ks) {
          const bf16x8 ah1 = *(const bf16x8*)(g_smem + C_K + off + 32 * KSTR + ks * 32), al1 = *(const bf16x8*)(g_smem + C_KLO + off + 32 * KSTR + ks * 32);
          st1 = mfma32(al1, qfh[ks], st1); st1 = mfma32(ah1, qfl[ks], st1); st1 = mfma32(ah1, qfh[ks], st1);
        }
      }
#pragma unroll
      for (int r = 0; r < 16; ++r) {
        const int c = kh * 128 + s * 64 + (r & 3) + 8 * (r >> 2) + 4 * hh;
        st0[r] = ((16 * c + 31 <= token) && c < 255) ? st0[r] * QK_C1 : -1e30f;
        st1[r] = ((16 * (c + 32) + 31 <= token) && (c + 32) < 255) ? st1[r] * QK_C1 : -1e30f;
      }
      t4[s * 2 + 0] = st0; t4[s * 2 + 1] = st1;
    }
    __syncthreads();
  }
  float* ex = (float*)(g_smem + C_EX);
  float mx = -1e30f;
#pragma unroll
  for (int i = 0; i < 4; ++i)
#pragma unroll
    for (int r = 0; r < 16; ++r) mx = fmaxf(mx, t4[i][r]);
  mx = xmax32(mx);
  if (hh == 0) ex[(rg * 2 + kh) * 32 + l32] = mx;
  __syncthreads();
  const float mf = fmaxf(ex[(rg * 2 + 0) * 32 + l32], ex[(rg * 2 + 1) * 32 + l32]);
  float rs = 0.f;
#pragma unroll
  for (int i = 0; i < 4; ++i)
#pragma unroll
    for (int r = 0; r < 16; ++r) { const float t = t4[i][r]; const float pv = t > -1e29f ? fexp2(t - mf) : 0.f; t4[i][r] = pv; rs += pv; }
  rs = xsum32(rs);
  if (hh == 0) ex[256 + (rg * 2 + kh) * 32 + l32] = rs;
  __syncthreads();
  const float lt = ex[256 + (rg * 2 + 0) * 32 + l32] + ex[256 + (rg * 2 + 1) * 32 + l32];
  const float inv = lt > 0.f ? 1.f / lt : 0.f;
  float* Ap = (float*)(g_smem + C_K); float* Bp = Ap + 4 * 32 * 64;
#pragma unroll
  for (int i = 0; i < 4; ++i) {
#pragma unroll
    for (int r = 0; r < 16; ++r) t4[i][r] *= inv;
#pragma unroll
    for (int gq = 0; gq < 4; ++gq) {
      const int n = kh * 32 + (i >> 1) * 16 + (i & 1) * 8 + 2 * gq + hh;
      const float p0 = t4[i][gq * 4], p1 = t4[i][gq * 4 + 1], p2 = t4[i][gq * 4 + 2], p3 = t4[i][gq * 4 + 3];
      Ap[(rg * 32 + l32) * 64 + n] = 2.f * (p0 + p1 + p2) + p3;
      Bp[(rg * 32 + l32) * 64 + n] = p3;
    }
  }
  f32x16 o[4];
#pragma unroll
  for (int i = 0; i < 4; ++i) o[i] = zero16();
#pragma unroll
  for (int i = 0; i < 4; ++i) {
    const int keyb = kh * 128 + (i >> 1) * 64 + (i & 1) * 32;
    if (16 * keyb + 31 > qt * 32 + 31) continue;
    const bf16x8 pk0 = pack8(t4[i], 0), pk1 = pack8(t4[i], 1);
#pragma unroll
    for (int dblk = 0; dblk < 4; ++dblk) {
      const char* vp = g_smem + C_V + (dblk * 32 + l32) * CV_STR + (keyb + 4 * hh) * 2;
      o[dblk] = mfma32(ldv8(vp), pk0, o[dblk]);
      o[dblk] = mfma32(ldv8(vp + 32), pk1, o[dblk]);
    }
  }
  __syncthreads();
  float* X = (float*)(g_smem + C_V);
  if (kh == 1) {
#pragma unroll
    for (int i = 0; i < 4; ++i)
#pragma unroll
      for (int r = 0; r < 16; ++r) X[(rg * 64 + i * 16 + r) * 64 + lane] = o[i][r];
  }
  {
    const int n = lane;
#pragma unroll
    for (int i = 0; i < 4; ++i) {
      const int tok = wave * 4 + i, tk = qt * 32 + tok, cur = tk >> 6;
      float imp = 0.f;
#pragma unroll
      for (int r4 = 0; r4 < 4; ++r4) { imp += Ap[(r4 * 32 + tok) * 64 + n]; if (n > 0) imp += Bp[(r4 * 32 + tok) * 64 + n - 1]; }
      const bool causal = n <= cur, forced = n == 0 || n == cur || n == cur - 1;
      const float score = causal ? (forced ? 1e6f : imp) : -1e6f;
      int rank = 0;
#pragma unroll 4
      for (int j = 0; j < 64; ++j) { const float sj = __int_as_float(__builtin_amdgcn_readlane(__float_as_int(score), j)); rank += (sj > score || (sj == score && j < n)) ? 1 : 0; }
      const unsigned long long msk = __ballot(causal && rank < 16);
      if (lane == 0) ((unsigned long long*)(ws + OFF_SEL))[(size_t)bg * 4096 + tk] = msk;
    }
  }
  __syncthreads();
  float* Tt = (float*)(g_smem + C_K);
  if (kh == 0) {
    const float gt = ((const float*)(ws + OFF_GATES))[(size_t)(b * 4096 + token) * 24 + head * 3 + 0];
    float* trow = Tt + (rg * 32 + l32) * 132;
#pragma unroll
    for (int i = 0; i < 4; ++i)
#pragma unroll
      for (int gq = 0; gq < 4; ++gq) {
        f32x4 v;
#pragma unroll
        for (int j = 0; j < 4; ++j) v[j] = (o[i][gq * 4 + j] + X[(rg * 64 + i * 16 + gq * 4 + j) * 64 + lane]) * gt;
        *(f32x4*)(trow + i * 32 + 8 * gq + 4 * hh) = v;
      }
  }
  __syncthreads();
  if (!dry) {
    float* obase = (float*)(ws + OFF_ON32) + (size_t)b * 4096 * 1024;
#pragma unroll
    for (int k = 0; k < 8; ++k) {
      const int R = wave * 16 + k * 2 + (lane >> 5), rgr = R >> 5, rr = R & 31, c4 = (lane & 31) * 4;
      float* dp = obase + (size_t)(qt * 32 + rr) * 1024 + (g * 4 + rgr) * 128 + c4;
      *(f32x4*)dp = *(const f32x4*)dp + *(const f32x4*)(Tt + R * 132 + c4);
    }
  }
  __syncthreads();
}

DI void cumsum_job(const Params& p, int bh) {
  int tid = threadIdx.x; asm volatile("" : "+v"(tid));
  const int b = bh >> 3, h = bh & 7, wave = tid >> 6, lane = tid & 63;
  const float* lf = (const float*)(p.ws + OFF_LOGF) + (size_t)b * 4096 * 8 + h;
  float* cum = (float*)(p.ws + OFF_CUM) + (size_t)bh * 4096;
  float* wt = (float*)g_smem;
  float v[8]; float s = 0.f;
#pragma unroll
  for (int i = 0; i < 8; ++i) { s += lf[(size_t)(tid * 8 + i) * 8]; v[i] = s; }
  float inc = s;
#pragma unroll
  for (int o = 1; o < 64; o <<= 1) { const float t = __shfl_up(inc, o); if (lane >= o) inc += t; }
  if (lane == 63) wt[wave] = inc;
  __syncthreads();
  float base = inc - s;
  for (int w = 0; w < wave; ++w) base += wt[w];
#pragma unroll
  for (int i = 0; i < 8; ++i) cum[tid * 8 + i] = base + v[i];
  __syncthreads();
}

DI void knorm_job(const Params& p, int j) {
  int tid = threadIdx.x; asm volatile("" : "+v"(tid));
  const int pair = tid >> 1, half = tid & 1, tl = pair >> 3, h = pair & 7;
  const bf16_t* kp = (const bf16_t*)(p.ws + OFF_KF) + (size_t)(j * 32 + tl) * 1024 + h * 128 + half * 64;
  float ss = 0.f;
#pragma unroll
  for (int i = 0; i < 8; ++i) {
    const bf16x8 v = *(const bf16x8*)(kp + i * 8);
#pragma unroll
    for (int e = 0; e < 8; ++e) { const float f = bf2f((unsigned short)v[e]); ss += f * f; }
  }
  ss += __shfl_xor(ss, 1);
  float* nr = (float*)g_smem;
  if (half == 0) nr[pair] = ss;
  __syncthreads();
  if (tid < 8) {
    float m = 0.f;
    for (int t = 0; t < 32; ++t) m = fmaxf(m, nr[t * 8 + tid]);
    ((float*)(p.ws + OFF_KNORM))[((j >> 7) * 8 + tid) * 128 + (j & 127)] = m;
  }
  __syncthreads();
}
DI void gemm1_job(const Params& p, int j) {
  char* ws = p.ws;
  GemmOp g; g.lda = 2048; g.ldb = 4096;
  if (j < 64) {
    const int pm = j >> 4, split = j & 15;
    const bf16_t* ah = (const bf16_t*)(ws + OFF_KCIN_HI) + split * 256; const bf16_t* al = (const bf16_t*)(ws + OFF_KCIN_LO) + split * 256;
    const bf16_t* bh = (const bf16_t*)(ws + OFF_W1K_HI) + split * 256; const bf16_t* bl = (const bf16_t*)(ws + OFF_W1K_LO) + split * 256;
    g.A0 = ah; g.A1 = ah; g.A2 = al; g.B0 = bh; g.B1 = bl; g.B2 = bh; g.nt = 12; g.shift = 2;
    EpiF32 e{(float*)(ws + OFF_H1P_K) + (size_t)split * 1024 * 256, 256};
    gemm_tile(g, pm * 256, 0, e);
  } else {
    const int jj = j - 64, pm = jj >> 3, split = jj & 7;
    const bf16_t* ah = (const bf16_t*)(ws + OFF_VCIN) + split * 512; const bf16_t* bh = (const bf16_t*)(ws + OFF_W1V) + split * 512;
    g.A0 = g.A1 = g.A2 = ah; g.B0 = g.B1 = g.B2 = bh; g.nt = 8; g.shift = 3;
    EpiF32 e{(float*)(ws + OFF_H1P_V) + (size_t)split * 1024 * 256, 256};
    gemm_tile(g, pm * 256, 0, e);
  }
}

DI void gemm2_job(const Params& p, int j) {
  char* ws = p.ws;
  int tid = threadIdx.x; asm volatile("" : "+v"(tid));
  const bool isv = j >= 128; const int r0 = (j & 127) * 8;
  const float* part = (const float*)(ws + (isv ? OFF_H1P_V : OFF_H1P_K));
  const float* bias = (const float*)(ws + OFF_BIAS1) + (isv ? 16 * 256 : 0);
  const float* w2 = isv ? p.w_vc2 : p.w_kc2;
  float* hs = (float*)g_smem;
  float* w2s = hs + 2048;
  float* os = w2s;
  {
    const f32x4* w2v = (const f32x4*)w2;
#pragma unroll 16
    for (int i = 0; i < 16; ++i) ((f32x4*)w2s)[tid + i * 512] = w2v[tid + i * 512];
  }
  for (int idx = tid; idx < 2048; idx += 512) {
    const int row = idx >> 8, col = idx & 255;
    float s = 0.f;
#pragma unroll
    for (int c16 = 0; c16 < 16; ++c16) s += bias[c16 * 256 + col];
    const int nsp = isv ? 8 : 16;
    for (int sp = 0; sp < nsp; ++sp) s += part[((size_t)sp * 1024 + r0 + row) * 256 + col];
    hs[idx] = gelu_tanh(s);
  }
  __syncthreads();
  float a0 = 0.f, a1 = 0.f;
  {
    const int col = tid & 127, rp = tid >> 7;
#pragma unroll 8
    for (int k = 0; k < 256; ++k) { const float w = w2s[k * 128 + col]; a0 += hs[(rp * 2) * 256 + k] * w; a1 += hs[(rp * 2 + 1) * 256 + k] * w; }
  }
  __syncthreads();
  { const int col = tid & 127, rp = tid >> 7; os[(rp * 2) * 128 + col] = a0; os[(rp * 2 + 1) * 128 + col] = a1; }
  __syncthreads();
  if (!isv) {
    const int row = tid >> 6, i = tid & 63;
    const int rr = r0 + row, bg = rr >> 8, n = rr & 255;
    float y1 = 0.f, y2 = 0.f;
    if (n < 255) {
      const int tk = (bg >> 1) * 4096 + 16 * n + 31;
      const float cv = ((const float*)(ws + OFF_COS))[(size_t)tk * 64 + i], sv = ((const float*)(ws + OFF_SIN))[(size_t)tk * 64 + i];
      const float x1 = os[row * 128 + i], x2 = os[row * 128 + 64 + i];
      y1 = x1 * cv - x2 * sv; y2 = x2 * cv + x1 * sv;
    }
    bf16_t* kh_ = (bf16_t*)(ws + OFF_KC_HI) + (size_t)rr * 128; bf16_t* kl_ = (bf16_t*)(ws + OFF_KC_LO) + (size_t)rr * 128;
    kh_[i] = f2bf(y1); kh_[i + 64] = f2bf(y2); kl_[i] = f2bf(lo_of(y1)); kl_[i + 64] = f2bf(lo_of(y2));
  } else {
    for (int idx = tid; idx < 1024; idx += 512) {
      const int row = idx & 7, d = idx >> 3;
      const int rr = r0 + row, bg = rr >> 8, n = rr & 255;
      ((bf16_t*)(ws + OFF_VCT))[((size_t)bg * 128 + d) * 256 + n] = n < 255 ? f2bf(os[row * 128 + d]) : (bf16_t)0;
    }
  }
  __syncthreads();
}

DI void phase3(const Params& p) {
  FOR_JOBS(job, 96) gemm1_job(p, job);
  for (int job = (int)gridDim.x - 1 - (int)blockIdx.x; job < 16; job += gridDim.x) cumsum_job(p, job);
  for (int job = (int)gridDim.x - 1 - (int)blockIdx.x; job < 256; job += gridDim.x) knorm_job(p, job);
}
DI void phase4(const Params& p, bool dry) {
  if (!dry) { FOR_JOBS(job, 256) gemm2_job(p, job); }
  unsigned* qctr = (unsigned*)(p.ws + OFF_BAR) + (dry ? 3616 : 3600);
  volatile int* qslot = (volatile int*)(g_smem + 143360 - 32);
  for (;;) {
    if (threadIdx.x == 0) *qslot = (int)__hip_atomic_fetch_add(qctr, 1u, __ATOMIC_RELAXED, __HIP_MEMORY_SCOPE_AGENT);
    __syncthreads();
    const int u = *qslot;
    __syncthreads();
    if (u >= 1024) break;
    if (u < 512) { const int qt = 31 - (u >> 4), bh = u & 15; attn_unit<0>(p, bh >> 3, bh & 7, qt, dry); }
    else { const int v = u - 512; const int qt = 127 - (v >> 2), bg = v & 3; attn_unit<1>(p, bg >> 1, bg & 1, qt, dry); }
  }
}
DI void phase5(const Params& p, bool dry) {
  FOR_JOBS(job, 512) { const int qt = job >> 2, bg = job & 3; cmp_unit(p, bg >> 1, bg & 1, qt, dry); }
}
DI void phase6(const Params& p, bool dry) {
  unsigned* qctr = (unsigned*)(p.ws + OFF_BAR) + (dry ? 3648 : 3632);
  volatile int* qslot = (volatile int*)(g_smem + 143360 - 32);
  for (;;) {
    if (threadIdx.x == 0) *qslot = (int)__hip_atomic_fetch_add(qctr, 1u, __ATOMIC_RELAXED, __HIP_MEMORY_SCOPE_AGENT);
    __syncthreads();
    const int job = *qslot;
    __syncthreads();
    if (job >= 512) break;
    const int qt = 127 - (job >> 2), bg = job & 3; attn_unit<2>(p, bg >> 1, bg & 1, qt, dry);
  }
}

DI void outproj_phase(const Params& p) {
  char* ws = p.ws;
  FOR_JOBS(job, 256) {
    const int pn = job >> 5, pm = job & 31;
    GemmOp g; g.lda = 2048; g.ldb = 2048; g.nt = 32; g.shift = 5;
    g.A0 = g.A1 = g.A2 = (const bf16_t*)(ws + OFF_U_HI); g.B0 = g.B1 = g.B2 = (const bf16_t*)(ws + OFF_WOUT);
    EpiResid e{(float*)(ws + OFF_H1), p.x, (const float*)(ws + OFF_MOD) + 4096};
    gemm_tile(g, pm * 256, pn * 256, e);
  }
}
DI void gateup_phase(const Params& p) {
  char* ws = p.ws;
  FOR_JOBS(job, 44 * 32) {
    const int pn = job >> 5, pm = job & 31;
    GemmOp g; g.lda = 2048; g.ldb = 2048; g.nt = 32; g.shift = 5;
    g.A0 = g.A1 = g.A2 = (const bf16_t*)(ws + OFF_U_HI); g.B0 = g.B1 = g.B2 = (const bf16_t*)(ws + OFF_WGU);
    EpiSwiglu e{(bf16_t*)(ws + OFF_ACT)};
    gemm_tile(g, pm * 256, pn * 256, e);
  }
}
DI void down_phase(const Params& p) {
  char* ws = p.ws;
  FOR_JOBS(job, 256) {
    const int pn = job >> 5, pm = job & 31;
    GemmOp g; g.lda = DFF; g.ldb = DFF; g.nt = 88; g.shift = 20;
    g.A0 = g.A1 = g.A2 = (const bf16_t*)(ws + OFF_ACT); g.B0 = g.B1 = g.B2 = (const bf16_t*)(ws + OFF_WDN);
    EpiResid e{p.out, (const float*)(ws + OFF_H1), (const float*)(ws + OFF_MOD) + 10240};
    gemm_tile(g, pm * 256, pn * 256, e);
  }
}


#define XB_TMO      128
#define XB_XCNT(j)  (256  + 64 * (j))
#define XB_XSUB(j)  (1280 + 64 * (j))
#define XB_XGEN(j)  (2304 + 64 * (j))
#define XB_TOP      3328
#define XB_TOPGEN   3392
#define XCD_BAR_WORDS 3456
#define XB_SPIN_CAP (1u << 22)
#define LAS __attribute__((address_space(3)))
constexpr int LDS_BAR_OFF = 143360 - 16;
DI unsigned xb_ld(unsigned* p) { return __hip_atomic_load(p, __ATOMIC_RELAXED, __HIP_MEMORY_SCOPE_AGENT); }
DI unsigned xb_add(unsigned* p, unsigned v) { return __hip_atomic_fetch_add(p, v, __ATOMIC_RELAXED, __HIP_MEMORY_SCOPE_AGENT); }
DI unsigned xb_xcc_id() { return (unsigned)__builtin_amdgcn_s_getreg((3 << 11) | 20) & 0xFu; }
#define XB_SPIN(cond, bar) do { unsigned _sp = 0; while (cond) { __builtin_amdgcn_s_sleep(1); \
    if ((++_sp & 255u) == 0u) { if (xb_ld(&(bar)[XB_TMO])) break; if (_sp > XB_SPIN_CAP) { atomicAdd(&(bar)[XB_TMO], 1u); break; } } } } while (0)
struct XcdBarrier { unsigned* bar; unsigned x; volatile LAS unsigned* st; };
DI XcdBarrier xcd_barrier_post(unsigned* bar, volatile LAS unsigned* st) {
  XcdBarrier b; b.bar = bar; b.x = xb_xcc_id(); b.st = st;
  if (threadIdx.x == 0) (void)xb_add(&bar[XB_XCNT(b.x)], 1u);
  return b;
}
DI void xcd_barrier_complete(unsigned* bar, unsigned x, unsigned& nloc, unsigned& nx) {
  const unsigned G = gridDim.x * gridDim.y * gridDim.z;
  unsigned sum, cnt, mine, sp = 0u;
  for (;;) {
    sum = 0u; cnt = 0u; mine = 0u;
#pragma unroll
    for (unsigned j = 0; j < 16; ++j) { const unsigned c = xb_ld(&bar[XB_XCNT(j)]); sum += c; cnt += (c > 0u) ? 1u : 0u; mine = (j == x) ? c : mine; }
    if (sum == G) break;
    __builtin_amdgcn_s_sleep(1);
    if ((++sp & 255u) == 0u) { if (xb_ld(&bar[XB_TMO])) break; if (sp > XB_SPIN_CAP) { atomicAdd(&bar[XB_TMO], 1u); break; } }
  }
  nloc = mine > 0u ? mine : 1u; nx = cnt > 0u ? cnt : 1u;
}
DI void xcd_barrier(const XcdBarrier& b) {
  asm volatile("s_waitcnt vmcnt(0)" ::: "memory");
  __syncthreads();
  if (threadIdx.x == 0) {
    unsigned* bar = b.bar;
    __builtin_amdgcn_s_waitcnt(0);
    unsigned nloc = b.st[0], nx = b.st[1];
    if (nloc == 0u) { xcd_barrier_complete(bar, b.x, nloc, nx); b.st[0] = nloc; b.st[1] = nx; }
    const unsigned old = xb_add(&bar[XB_XSUB(b.x)], 1u);
    const unsigned gen = old / nloc;
    if (old + 1u == (gen + 1u) * nloc) {
      __builtin_amdgcn_fence(__ATOMIC_RELEASE, "agent");
      asm volatile("s_waitcnt vmcnt(0)" ::: "memory");
      const unsigned og = xb_add(&bar[XB_TOP], 1u);
      const unsigned tg = og / nx;
      if (og + 1u == (tg + 1u) * nx) xb_add(&bar[XB_TOPGEN], 1u);
      else XB_SPIN(xb_ld(&bar[XB_TOPGEN]) == tg, bar);
      __builtin_amdgcn_fence(__ATOMIC_ACQUIRE, "agent");
      xb_add(&bar[XB_XGEN(b.x)], 1u);
      asm volatile("s_waitcnt vmcnt(0)" ::: "memory");
    } else {
      XB_SPIN(xb_ld(&bar[XB_XGEN(b.x)]) == gen, bar);
      __builtin_amdgcn_fence(__ATOMIC_ACQUIRE, "agent");
      asm volatile("s_waitcnt vmcnt(0)" ::: "memory");
    }
  }
  __syncthreads();
}

#ifdef ONLY_PHASE
#define PH_ON(k) ((k) == ONLY_PHASE)
#else
#define PH_ON(k) 1
#endif
#ifndef REP_MASK
#define REP_MASK 0
#endif
#define RUN_PHASE(k, call) do { if (PH_ON(k) && ph0 <= (k) && (k) < ph1) { \
    _Pragma("unroll 1") for (int _r = 0; _r <= ((REP_MASK >> (k)) & 1); ++_r) { const bool _dry = ((REP_MASK >> (k)) & 1) && _r == 0; (void)_dry; if ((k) > ph0 || _r) GRID_SYNC(); call; } } } while (0)
#ifndef NSYNC_EXTRA
#define NSYNC_EXTRA 0
#endif
#define GRID_SYNC() xcd_barrier(xb)
__global__ void __launch_bounds__(512) hymba_mega(Params p, int ph0, int ph1) {
  volatile LAS unsigned* xst = (volatile LAS unsigned*)(g_smem + LDS_BAR_OFF);
  if (threadIdx.x == 0) { xst[0] = 0u; xst[1] = 0u; }
  __syncthreads();
  const XcdBarrier xb = xcd_barrier_post((unsigned*)(p.ws + OFF_BAR), xst);
  if (ph1 > 1000) cg::this_grid().sync();
  RUN_PHASE(0, phase0(p));
  RUN_PHASE(1, rmsmod_phase(p.x, p.norm_attn, (const float*)(p.ws + OFF_MOD), 0, 2048, (bf16_t*)(p.ws + OFF_U_HI), (bf16_t*)(p.ws + OFF_U_LO)));
  RUN_PHASE(2, inproj_phase(p, _dry));
  RUN_PHASE(3, phase3(p));
  RUN_PHASE(4, phase4(p, _dry));
  RUN_PHASE(5, phase5(p, _dry));
  RUN_PHASE(6, phase6(p, _dry));
  RUN_PHASE(7, ymix_phase(p));
  RUN_PHASE(8, outproj_phase(p));
  RUN_PHASE(9, rmsmod_phase((const float*)(p.ws + OFF_H1), p.norm_ffn, (const float*)(p.ws + OFF_MOD), 6144, 8192, (bf16_t*)(p.ws + OFF_U_HI), nullptr));
  RUN_PHASE(10, gateup_phase(p));
  RUN_PHASE(11, down_phase(p));
  RUN_PHASE(12, final_phase(p));
  _Pragma("unroll 1") for (int i = 0; i < NSYNC_EXTRA; ++i) GRID_SYNC();
}

extern "C" void kernel_launch(void* const* d_in, const int* in_sizes, int n_in, void* d_out, int out_size, void* d_ws, size_t ws_size,
                              hipStream_t stream) {
  Params p{};
  p.x = (const float*)d_in[0]; p.c = (const float*)d_in[1]; p.pos = (const int*)d_in[2];
  p.w_ada = (const float*)d_in[3]; p.b_ada = (const float*)d_in[4]; p.norm_attn = (const float*)d_in[5]; p.norm_ffn = (const float*)d_in[6];
  p.w_in = (const float*)d_in[7]; p.b_fgate = (const float*)d_in[8]; p.cmp_pos = (const float*)d_in[9];
  p.w_kc1 = (const float*)d_in[10]; p.w_kc2 = (const float*)d_in[11]; p.w_vc1 = (const float*)d_in[12]; p.w_vc2 = (const float*)d_in[13];
  p.beta_fox = (const float*)d_in[14]; p.beta_nsa = (const float*)d_in[15]; p.w_out = (const float*)d_in[16];
  p.w_gate = (const float*)d_in[17]; p.w_up = (const float*)d_in[18]; p.w_down = (const float*)d_in[19]; p.final_norm = (const float*)d_in[20];
  p.out = (float*)d_out; p.ws = (char*)d_ws;
  static int grid_blocks = 0;
  if (!grid_blocks) {
    hipFuncSetAttribute((const void*)hymba_mega, hipFuncAttributeMaxDynamicSharedMemorySize, LDS_BYTES);
    int dev = 0, cus = 0, per_cu = 0;
    hipGetDevice(&dev);
    hipDeviceGetAttribute(&cus, hipDeviceAttributeMultiprocessorCount, dev);
    hipOccupancyMaxActiveBlocksPerMultiprocessor(&per_cu, hymba_mega, 512, LDS_BYTES);
    if (per_cu < 1) per_cu = 1;
    grid_blocks = cus * per_cu;
    if (ws_size < WS_END) fprintf(stderr, "workspace too small: %zu < %zu\n", ws_size, (size_t)WS_END);
  }
  hipMemsetAsync((char*)d_ws + OFF_BAR, 0, 16384, stream);
#if N_LAUNCH_MODE == 1
  int ph0 = 0, ph1 = NPH;
  void* args[] = {&p, &ph0, &ph1};
  hipError_t e = hipLaunchCooperativeKernel((const void*)hymba_mega, dim3(grid_blocks), dim3(512), args, LDS_BYTES, stream);
  if (e != hipSuccess) fprintf(stderr, "cooperative launch failed: %s (grid %d)\n", hipGetErrorString(e), grid_blocks);
#else
  for (int ph = 0; ph < NPH; ++ph) hipLaunchKernelGGL(hymba_mega, dim3(grid_blocks), dim3(512), LDS_BYTES, stream, p, ph, ph + 1);
#endif
}
```

```cpp
#include <hip/hip_runtime.h>
#include <hip/hip_cooperative_groups.h>
#include <stdint.h>
#include <cstdio>
namespace cg = cooperative_groups;

#define DI __device__ __forceinline__
typedef unsigned short bf16_t;
typedef short bf16x8 __attribute__((ext_vector_type(8)));
typedef short s16x4 __attribute__((ext_vector_type(4)));
typedef float f32x4 __attribute__((ext_vector_type(4)));
typedef float f32x16 __attribute__((ext_vector_type(16)));
typedef unsigned u32x2 __attribute__((ext_vector_type(2)));
typedef unsigned u32x4 __attribute__((ext_vector_type(4)));

#ifndef DRY_MODE
#define DRY_MODE 0
#endif
#ifndef ATTN_PREFETCH
#define ATTN_PREFETCH 0
#endif
#ifndef N_LAUNCH_MODE
#define N_LAUNCH_MODE 1
#endif

constexpr int T_TOK = 8192, SEQ = 4096, DM = 2048, DFF = 5632, DIN = 5664;
constexpr int NPH = 13;
constexpr float LOG2E = 1.4426950408889634f;
constexpr float QK_C1 = 0.08838834764831845f * 1.4426950408889634f;

constexpr size_t al256(size_t x) { return (x + 255) & ~(size_t)255; }
constexpr size_t OFF_WIN_HI = 0;
constexpr size_t OFF_WIN_LO = OFF_WIN_HI + al256((size_t)5888 * 2048 * 2);
constexpr size_t OFF_WOUT = OFF_WIN_LO + al256((size_t)1280 * 2048 * 2);
constexpr size_t OFF_WGU = OFF_WOUT + al256((size_t)2048 * 2048 * 2);
constexpr size_t OFF_WDN = OFF_WGU + al256((size_t)11264 * 2048 * 2);
constexpr size_t OFF_W1K_HI = OFF_WDN + al256((size_t)2048 * 5632 * 2);
constexpr size_t OFF_W1K_LO = OFF_W1K_HI + al256((size_t)256 * 4096 * 2);
constexpr size_t OFF_W1V = OFF_W1K_LO + al256((size_t)256 * 4096 * 2);
constexpr size_t OFF_MOD = OFF_W1V + al256((size_t)256 * 4096 * 2);
constexpr size_t OFF_COS = OFF_MOD + al256((size_t)2 * 12288 * 4);
constexpr size_t OFF_SIN = OFF_COS + al256((size_t)8192 * 64 * 4);
constexpr size_t OFF_BIAS1 = OFF_SIN + al256((size_t)8192 * 64 * 4);
constexpr size_t OFF_U_HI = OFF_BIAS1 + al256((size_t)2 * 16 * 256 * 4);
constexpr size_t OFF_LOGF = OFF_U_HI + al256((size_t)8192 * 2048 * 2);
constexpr size_t OFF_CUM = OFF_LOGF + al256((size_t)8192 * 8 * 4);
constexpr size_t OFF_GATES = OFF_CUM + al256((size_t)16 * 4096 * 4);
constexpr size_t KCIN_BYTES = al256((size_t)(4 * 4096 + 64) * 128 * 2);
constexpr size_t OFF_KCIN_HI = OFF_GATES + al256((size_t)8192 * 24 * 4);
constexpr size_t OFF_KCIN_LO = OFF_KCIN_HI + KCIN_BYTES;
constexpr size_t OFF_VCIN = OFF_KCIN_LO + KCIN_BYTES;
constexpr size_t KV4_BYTES = (size_t)4 * 4096 * 128 * 2;
constexpr size_t OFF_KS = OFF_VCIN + KCIN_BYTES;
constexpr size_t OFF_VST = OFF_KS + KV4_BYTES;
constexpr size_t OFF_KW = OFF_VST + KV4_BYTES;
constexpr size_t OFF_VWT = OFF_KW + KV4_BYTES;
constexpr size_t OFF_H1P_K = OFF_VWT + KV4_BYTES;
constexpr size_t OFF_H1P_V = OFF_H1P_K + (size_t)16 * 1024 * 256 * 4;
constexpr size_t OFF_KC_HI = OFF_H1P_V + (size_t)8 * 1024 * 256 * 4;
constexpr size_t OFF_KC_LO = OFF_KC_HI + (size_t)4 * 256 * 128 * 2;
constexpr size_t OFF_VCT = OFF_KC_LO + (size_t)4 * 256 * 128 * 2;
constexpr size_t OFF_SEL = OFF_VCT + (size_t)4 * 256 * 128 * 2;
constexpr size_t OFF_OF32 = OFF_SEL + (size_t)4 * 4096 * 8;
constexpr size_t OFF_ON32 = OFF_OF32 + (size_t)8192 * 1024 * 4;
constexpr size_t OFF_H1 = OFF_OF32;
constexpr size_t OFF_RA = OFF_ON32 + (size_t)8192 * 1024 * 4;
constexpr size_t OFF_U_LO = OFF_RA;
constexpr size_t OFF_QF = OFF_U_LO + (size_t)8192 * 2048 * 2;
constexpr size_t OFF_KF = OFF_QF + (size_t)8192 * 1024 * 2;
constexpr size_t OFF_VFT = OFF_KF + (size_t)8192 * 1024 * 2;
constexpr size_t OFF_QN_HI = OFF_VFT + (size_t)8192 * 1024 * 2;
constexpr size_t OFF_QN_LO = OFF_QN_HI + (size_t)8192 * 1024 * 2;
constexpr size_t OFF_ACT = OFF_RA;
constexpr size_t OFF_KNORM = OFF_QN_LO + (size_t)8192 * 1024 * 2;
constexpr size_t OFF_BAR = OFF_KNORM + 8192;
constexpr size_t WS_END = OFF_BAR + 16384;

struct Params {
  const float *x, *c; const int* pos;
  const float *w_ada, *b_ada, *norm_attn, *norm_ffn, *w_in, *b_fgate, *cmp_pos, *w_kc1, *w_kc2, *w_vc1, *w_vc2,
      *beta_fox, *beta_nsa, *w_out, *w_gate, *w_up, *w_down, *final_norm;
  float* out; char* ws;
};

extern __shared__ __attribute__((aligned(16))) char g_smem[];
constexpr int LDS_BYTES = 143360;

__device__ const float c_inv_freq[64] = {
1.000000000e+00f,8.659643531e-01f,7.498942614e-01f,6.493816376e-01f,5.623413324e-01f,4.869675338e-01f,4.216965139e-01f,3.651741147e-01f,3.162277639e-01f,2.738419771e-01f,2.371373773e-01f,2.053525001e-01f,1.778279394e-01f,1.539926529e-01f,1.333521307e-01f,1.154782027e-01f,1.000000015e-01f,8.659642935e-02f,7.498941571e-02f,6.493816525e-02f,5.623413250e-02f,4.869675264e-02f,4.216965288e-02f,3.651741147e-02f,3.162277490e-02f,2.738419734e-02f,2.371373773e-02f,2.053525113e-02f,1.778279431e-02f,1.539926510e-02f,1.333521493e-02f,1.154782064e-02f,9.999999776e-03f,8.659643121e-03f,7.498941850e-03f,6.493816152e-03f,5.623413250e-03f,4.869675264e-03f,4.216964822e-03f,3.651741194e-03f,3.162277630e-03f,2.738419687e-03f,2.371373586e-03f,2.053524833e-03f,1.778279431e-03f,1.539926510e-03f,1.333521446e-03f,1.154781901e-03f,1.000000047e-03f,8.659643354e-04f,7.498942432e-04f,6.493816618e-04f,5.623413017e-04f,4.869675322e-04f,4.216965172e-04f,3.651741426e-04f,3.162277571e-04f,2.738419571e-04f,2.371373703e-04f,2.053525095e-04f,1.778279402e-04f,1.539926452e-04f,1.333521504e-04f,1.154782003e-04f};

DI unsigned short f2bf(float x) { unsigned u = __float_as_uint(x); u += 0x7fffu + ((u >> 16) & 1u); return (unsigned short)(u >> 16); }
DI float bf2f(unsigned short h) { return __uint_as_float(((unsigned)h) << 16); }
typedef float f32x2 __attribute__((ext_vector_type(2)));
typedef __bf16 bf16v2 __attribute__((ext_vector_type(2)));
DI unsigned pack2(float a, float b) { const f32x2 v = {a, b}; return __builtin_bit_cast(unsigned, __builtin_convertvector(v, bf16v2)); }
DI void split2(float a, float b, unsigned& hi, unsigned& lo) {
  hi = pack2(a, b);
  lo = pack2(a - __uint_as_float(hi << 16), b - __uint_as_float(hi & 0xffff0000u));
}
DI float lo_of(float x) { return x - bf2f(f2bf(x)); }
DI float wave_sum(float v) {
#pragma unroll
  for (int o = 32; o > 0; o >>= 1) v += __shfl_xor(v, o);
  return v;
}
DI float xmax32(float v) { auto r = __builtin_amdgcn_permlane32_swap(__float_as_uint(v), __float_as_uint(v), false, false); return fmaxf(__uint_as_float(r[0]), __uint_as_float(r[1])); }
DI float xsum32(float v) { auto r = __builtin_amdgcn_permlane32_swap(__float_as_uint(v), __float_as_uint(v), false, false); return __uint_as_float(r[0]) + __uint_as_float(r[1]); }
DI float fexp2(float x) { return __builtin_amdgcn_exp2f(x); }
DI float sigmoidf_(float x) { return 1.f / (1.f + __expf(-x)); }
DI float siluf_(float x) { return x / (1.f + __expf(-x)); }
DI float silu_fast(float x) { return x * __builtin_amdgcn_rcpf(1.f + __builtin_amdgcn_exp2f(-LOG2E * x)); }
DI float gelu_tanh(float x) { float u = 0.7978845608028654f * (x + 0.044715f * x * x * x); float e = __expf(2.f * u); float t = 1.f - 2.f / (e + 1.f); return 0.5f * x * (1.f + t); }
DI float log_sigmoid(float x) { return fminf(x, 0.f) - log1pf(__expf(-fabsf(x))); }
DI f32x16 mfma32(bf16x8 a, bf16x8 b, f32x16 c) { return __builtin_amdgcn_mfma_f32_32x32x16_bf16(a, b, c, 0, 0, 0); }
DI f32x16 zero16() { f32x16 z;
#pragma unroll
  for (int i = 0; i < 16; ++i) z[i] = 0.f; return z; }
DI int perm_gu(int w) { const int r = w & 31; return (w & 96) + ((r >> 2) & 1) * 16 + (r >> 3) * 4 + (r & 3); }
DI int perm256(int w) { const int hl = (w >> 7) & 1, d = w & 127, bj = d >> 6, q = (d & 63) >> 3, n = (d >> 2) & 1, j = d & 3; return bj * 128 + (hl * 2 + (q >> 2)) * 32 + n * 16 + (q & 3) * 4 + j; }
DI int perm128(int d) { return ((d >> 4) & 3) * 32 + (d >> 6) * 16 + (d & 15); }

#define FOR_JOBS(job, njobs) \
  for (int _r = 0, job; _r * (int)gridDim.x < (njobs); ++_r) \
    if ((job = _r * (int)gridDim.x + ((_r & 1) ? ((int)gridDim.x - 1 - (int)blockIdx.x) : (int)blockIdx.x)) < (njobs))

constexpr int BM = 256, BK = 64, HALF = 128, HTB = HALF * BK * 2;
DI int lds_byte(int r, int c) { int st = (r >> 4) * 2 + (c >> 5), rr = r & 15, cc = c & 31, ob = rr * 64 + cc * 2; return st * 1024 + (ob ^ (((ob >> 9) & 1) << 5)); }
DI void stage_rc(int b, int& R, int& C) { int st = b / 1024, sb = b % 1024, swz = sb ^ (((sb >> 9) & 1) << 5); R = (st >> 1) * 16 + swz / 64; C = (st & 1) * 32 + (swz % 64) / 2; }

DI const char* uptr(const char* p) {
  const unsigned long long v = (unsigned long long)p;
  const unsigned lo = __builtin_amdgcn_readfirstlane((unsigned)v), hi = __builtin_amdgcn_readfirstlane((unsigned)(v >> 32));
  return (const char*)(((unsigned long long)hi << 32) | lo);
}
struct GemmOp { const bf16_t *A0, *A1, *A2, *B0, *B1, *B2; int lda, ldb, nt, shift; };

template <class Epi>
DI void gemm_tile(const GemmOp& g, int brow, int bcol, const Epi& epi) {
#define SA(b, h) (g_smem + ((b) * 2 + (h)) * HTB)
#define SB(b, h) (g_smem + (4 + (b) * 2 + (h)) * HTB)
  int tid = threadIdx.x; asm volatile("" : "+v"(tid));
  const int wid = tid >> 6, lane = tid & 63, wr = wid >> 2, wc = wid & 3, fr = lane & 15, fq = lane >> 4;
  int r0, c0, r1, c1; stage_rc(tid * 16, r0, c0); stage_rc(tid * 16 + 8192, r1, c1);
  const unsigned oa0 = (unsigned)(r0 * g.lda + c0) * 2u, oa1 = (unsigned)(r1 * g.lda + c1) * 2u, ob0 = (unsigned)(r0 * g.ldb + c0) * 2u, ob1 = (unsigned)(r1 * g.ldb + c1) * 2u;
  const int mask = (1 << g.shift) - 1;
#define STAGE_A(P, half, kt) do { const int _s = (kt) >> g.shift; const char* _b = uptr((const char*)((_s == 0 ? g.A0 : (_s == 1 ? g.A1 : g.A2)) + (size_t)(brow + (half) * HALF) * g.lda + (size_t)((kt) & mask) * BK)); \
    __builtin_amdgcn_global_load_lds((const unsigned*)(_b + oa0), (unsigned*)((P) + tid * 16), 16, 0, 0); \
    __builtin_amdgcn_global_load_lds((const unsigned*)(_b + oa1), (unsigned*)((P) + tid * 16 + 8192), 16, 0, 0); } while (0)
#define STAGE_B(P, half, kt) do { const int _s = (kt) >> g.shift; const char* _b = uptr((const char*)((_s == 0 ? g.B0 : (_s == 1 ? g.B1 : g.B2)) + (size_t)(bcol + (half) * HALF) * g.ldb + (size_t)((kt) & mask) * BK)); \
    __builtin_amdgcn_global_load_lds((const unsigned*)(_b + ob0), (unsigned*)((P) + tid * 16), 16, 0, 0); \
    __builtin_amdgcn_global_load_lds((const unsigned*)(_b + ob1), (unsigned*)((P) + tid * 16 + 8192), 16, 0, 0); } while (0)
#define LDA(dst, b, h) for (int m = 0; m < 4; ++m) for (int k = 0; k < 2; ++k) \
    dst[m][k] = *reinterpret_cast<const bf16x8*>(SA(b, h) + lds_byte(wr * 64 + m * 16 + fr, k * 32 + fq * 8))
#define LDB(dst, b, h) for (int n = 0; n < 2; ++n) for (int k = 0; k < 2; ++k) \
    dst[n][k] = *reinterpret_cast<const bf16x8*>(SB(b, h) + lds_byte(wc * 32 + n * 16 + fr, k * 32 + fq * 8))
#define MMA(ai, bj, At_, Bt_) do { __builtin_amdgcn_s_setprio(1); \
    for (int m = 0; m < 4; ++m) for (int n = 0; n < 2; ++n) for (int k = 0; k < 2; ++k) \
      acc[ai][bj][m][n] = __builtin_amdgcn_mfma_f32_16x16x32_bf16(Bt_[n][k], At_[m][k], acc[ai][bj][m][n], 0, 0, 0); \
    __builtin_amdgcn_s_setprio(0); } while (0)
#define WAIT_V(n) asm volatile("s_waitcnt vmcnt(" #n ")" ::: "memory")
#define WAIT_L(n) asm volatile("s_waitcnt lgkmcnt(" #n ")" ::: "memory")
#define BAR __builtin_amdgcn_s_barrier()
#define SCHED __builtin_amdgcn_sched_barrier(0)
  f32x4 acc[2][2][4][2] = {};
  bf16x8 At[4][2], B0[2][2], B1[2][2];
  const int nt = g.nt;
  STAGE_B(SB(0, 0), 0, 0); STAGE_A(SA(0, 0), 0, 0);
  STAGE_B(SB(0, 1), 1, 0); STAGE_A(SA(0, 1), 1, 0);
  if (wr == 1) BAR;
  WAIT_V(4); BAR;
  STAGE_B(SB(1, 0), 0, 1); STAGE_A(SA(1, 0), 0, 1); STAGE_B(SB(1, 1), 1, 1);
  WAIT_V(6); BAR;
  for (int t = 0; t < nt - 2; t += 2) {
    LDB(B0, 0, 0); SCHED; LDA(At, 0, 0); STAGE_A(SA(1, 1), 1, t + 1);
    WAIT_L(8); BAR; WAIT_L(0); MMA(0, 0, At, B0); BAR; SCHED;
    LDB(B1, 0, 1); STAGE_B(SB(0, 0), 0, t + 2);
    BAR; WAIT_L(0); MMA(0, 1, At, B1); BAR;
    LDA(At, 0, 1); STAGE_A(SA(0, 0), 0, t + 2);
    BAR; WAIT_L(0); MMA(1, 0, At, B0); BAR; SCHED;
    STAGE_B(SB(0, 1), 1, t + 2);
    WAIT_V(6); BAR; MMA(1, 1, At, B1); BAR;
    LDB(B0, 1, 0); SCHED; LDA(At, 1, 0); STAGE_A(SA(0, 1), 1, t + 2);
    WAIT_L(8); BAR; WAIT_L(0); MMA(0, 0, At, B0); BAR; SCHED;
    LDB(B1, 1, 1); STAGE_B(SB(1, 0), 0, t + 3);
    BAR; WAIT_L(0); MMA(0, 1, At, B1); BAR;
    LDA(At, 1, 1); STAGE_A(SA(1, 0), 0, t + 3);
    BAR; WAIT_L(0); MMA(1, 0, At, B0); BAR; SCHED;
    STAGE_B(SB(1, 1), 1, t + 3);
    WAIT_V(6); BAR; MMA(1, 1, At, B1); BAR;
  }
  { LDB(B0, 0, 0); LDA(At, 0, 0); STAGE_A(SA(1, 1), 1, nt - 1);
    BAR; WAIT_L(0); MMA(0, 0, At, B0); BAR;
    LDB(B1, 0, 1); BAR; WAIT_L(0); MMA(0, 1, At, B1); BAR;
    LDA(At, 0, 1); WAIT_V(4); BAR; WAIT_L(0); MMA(1, 0, At, B0); MMA(1, 1, At, B1); BAR; }
  { LDB(B0, 1, 0); LDA(At, 1, 0); WAIT_V(2); BAR; WAIT_L(0); MMA(0, 0, At, B0); BAR;
    LDB(B1, 1, 1); WAIT_V(0); BAR; WAIT_L(0); MMA(0, 1, At, B1); BAR;
    LDA(At, 1, 1); BAR; WAIT_L(0); MMA(1, 0, At, B0); MMA(1, 1, At, B1); BAR; }
  if (wr == 0) BAR;
  { int t2 = tid; asm volatile("" : "+v"(t2)); const int w2 = t2 >> 6, l2 = t2 & 63; epi(acc, brow, bcol, w2 >> 2, w2 & 3, l2 & 15, l2 >> 4); }
  __syncthreads();
#undef SA
#undef SB
}

typedef f32x4 AccT[2][2][4][2];

struct EpiInproj {
  const Params* p; int pn;
  DI void operator()(const AccT& acc, int brow, int bcol, int wr, int wc, int fr, int fq) const {
    char* ws = p->ws;
    const float* cs = (const float*)(ws + OFF_COS); const float* sn = (const float*)(ws + OFF_SIN);
    const int hl = wc >> 1, dlo = ((wc & 1) * 4 + fq) * 8;
    const bool rope = (pn >= 12 && pn < 16) || pn == 18 || pn == 20;
#pragma unroll
    for (int ai = 0; ai < 2; ++ai)
#pragma unroll
      for (int m = 0; m < 4; ++m) {
        const int token = brow + ai * 128 + wr * 64 + m * 16 + fr;
        const int b = token >> 12, s = token & 4095;
        f32x4 a0 = acc[ai][0][m][0], a1 = acc[ai][0][m][1], b0 = acc[ai][1][m][0], b1 = acc[ai][1][m][1];
        if (rope) {
          const f32x4 c0 = *(const f32x4*)(cs + (size_t)token * 64 + dlo), c1 = *(const f32x4*)(cs + (size_t)token * 64 + dlo + 4);
          const f32x4 s0 = *(const f32x4*)(sn + (size_t)token * 64 + dlo), s1 = *(const f32x4*)(sn + (size_t)token * 64 + dlo + 4);
          const f32x4 y0 = a0 * c0 - b0 * s0, y1 = a1 * c1 - b1 * s1, z0 = b0 * c0 + a0 * s0, z1 = b1 * c1 + a1 * s1;
          a0 = y0; a1 = y1; b0 = z0; b1 = z1;
        }
        unsigned h[8], l[8];
        split2(a0[0], a0[1], h[0], l[0]); split2(a0[2], a0[3], h[1], l[1]); split2(a1[0], a1[1], h[2], l[2]); split2(a1[2], a1[3], h[3], l[3]);
        split2(b0[0], b0[1], h[4], l[4]); split2(b0[2], b0[3], h[5], l[5]); split2(b1[0], b1[1], h[6], l[6]); split2(b1[2], b1[3], h[7], l[7]);
        size_t o; size_t off_hi; size_t off_lo = 0; bool has_lo = false;
        if (pn < 8) { o = (size_t)token * 1024 + ((pn & 3) * 2 + hl) * 128 + dlo; off_hi = pn < 4 ? OFF_QF : OFF_KF; }
        else if (pn < 16) { o = (size_t)token * 1024 + ((pn - 12) * 2 + hl) * 128 + dlo; off_hi = OFF_QN_HI; off_lo = OFF_QN_LO; has_lo = true; }
        else {
          o = ((size_t)(b * 2 + hl) * 4096 + s) * 128 + dlo;
          off_hi = pn == 16 ? OFF_KCIN_HI : (pn == 17 ? OFF_VCIN : (pn == 18 ? OFF_KS : OFF_KW));
          if (pn == 16) { off_lo = OFF_KCIN_LO; has_lo = true; }
        }
        bf16_t* dh = (bf16_t*)(ws + off_hi) + o;
        *(u32x4*)dh = (u32x4){h[0], h[1], h[2], h[3]};
        *(u32x4*)(dh + 64) = (u32x4){h[4], h[5], h[6], h[7]};
        if (has_lo) {
          bf16_t* dl = (bf16_t*)(ws + off_lo) + o;
          *(u32x4*)dl = (u32x4){l[0], l[1], l[2], l[3]};
          *(u32x4*)(dl + 64) = (u32x4){l[4], l[5], l[6], l[7]};
        }
      }
  }
};

struct EpiVT {
  bf16_t* dst; int nheads; int sec_row0;
  DI void operator()(const AccT& acc, int brow, int bcol, int wr, int wc, int fr, int fq) const {
#pragma unroll
    for (int ai = 0; ai < 2; ++ai)
#pragma unroll
      for (int m = 0; m < 4; ++m) {
        const int vr = brow - sec_row0 + ai * 128 + wr * 64 + m * 16 + fr;
        const int head = vr >> 7, d = vr & 127;
#pragma unroll
        for (int bj = 0; bj < 2; ++bj)
#pragma unroll
          for (int n = 0; n < 2; ++n) {
            const int tk = bcol + bj * 128 + wc * 32 + n * 16 + fq * 4;
            const int b = tk >> 12, s = tk & 4095;
            const f32x4 v = acc[ai][bj][m][n];
            *(u32x2*)(dst + ((size_t)(b * nheads + head) * 128 + d) * 4096 + s) = (u32x2){pack2(v[0], v[1]), pack2(v[2], v[3])};
          }
      }
  }
};

struct EpiF32 {
  float* dst; int ld;
  DI void operator()(const AccT& acc, int brow, int bcol, int wr, int wc, int fr, int fq) const {
#pragma unroll
    for (int ai = 0; ai < 2; ++ai)
#pragma unroll
      for (int m = 0; m < 4; ++m) {
        const int row = brow + ai * 128 + wr * 64 + m * 16 + fr;
#pragma unroll
        for (int bj = 0; bj < 2; ++bj)
#pragma unroll
          for (int n = 0; n < 2; ++n)
            *(f32x4*)(dst + (size_t)row * ld + bcol + bj * 128 + wc * 32 + n * 16 + fq * 4) = acc[ai][bj][m][n];
      }
  }
};

struct EpiResid {
  float* dst; const float* base; const float* gate;
  DI void operator()(const AccT& acc, int brow, int bcol, int wr, int wc, int fr, int fq) const {
#pragma unroll
    for (int ai = 0; ai < 2; ++ai)
#pragma unroll
      for (int m = 0; m < 4; ++m) {
        const int row = brow + ai * 128 + wr * 64 + m * 16 + fr;
        const int b = row >> 12;
#pragma unroll
        for (int bj = 0; bj < 2; ++bj)
#pragma unroll
          for (int n = 0; n < 2; ++n) {
            const int col = bcol + bj * 128 + wc * 32 + n * 16 + fq * 4;
            const f32x4 xv = __builtin_nontemporal_load((const f32x4*)(base + (size_t)row * 2048 + col));
            const f32x4 gv = *(const f32x4*)(gate + b * 12288 + col);
            *(f32x4*)(dst + (size_t)row * 2048 + col) = xv + gv * acc[ai][bj][m][n];
          }
      }
  }
};

struct EpiSwiglu {
  bf16_t* act;
  DI void operator()(const AccT& acc, int brow, int bcol, int wr, int wc, int fr, int fq) const {
    const int pn = bcol >> 8;
#pragma unroll
    for (int ai = 0; ai < 2; ++ai)
#pragma unroll
      for (int m = 0; m < 4; ++m) {
        const int row = brow + ai * 128 + wr * 64 + m * 16 + fr;
        float r[8];
#pragma unroll
        for (int n = 0; n < 2; ++n) {
          const f32x4 gt = acc[ai][0][m][n], up = acc[ai][1][m][n];
#pragma unroll
          for (int j = 0; j < 4; ++j) r[n * 4 + j] = silu_fast(gt[j]) * up[j];
        }
        *(u32x4*)(act + (size_t)row * DFF + pn * 128 + wc * 32 + fq * 8) = (u32x4){pack2(r[0], r[1]), pack2(r[2], r[3]), pack2(r[4], r[5]), pack2(r[6], r[7])};
      }
  }
};

DI int map_win(int c, int& lo_row) {
  lo_row = -1;
  if (c < 2048) return (c & ~255) + perm256(c & 255);
  if (c < 3072) return c;
  if (c < 3080) return 5632 + (c - 3072);
  if (c < 4104) { int cc = c - 3080; int d = 3072 + (cc & ~255) + perm256(cc & 255); lo_row = d - 3072; return d; }
  if (c < 4360) { int cc = c - 4104; int d = 4096 + perm256(cc); lo_row = d - 3072; return d; }
  if (c < 4616) { int cc = c - 4360; return 4352 + perm256(cc); }
  if (c < 4872) { int cc = c - 4616; return 4608 + perm256(cc); }
  if (c < 5128) return 4864 + (c - 4872);
  if (c < 5384) { int cc = c - 5128; return 5120 + perm256(cc); }
  if (c < 5640) return 5376 + (c - 5384);
  return c;
}

struct TInfo { const float* src; bf16_t* dh; bf16_t* dl; int N, Kd, mat, k0, n0; };
constexpr int TJ_WIN = 16 * 89, TJ_WOUT = 16 * 32, TJ_WG = 16 * 88, TJ_WD = 44 * 32, TJ_W1 = 32 * 4;
constexpr int TE0 = TJ_WIN, TE1 = TE0 + TJ_WOUT, TE2 = TE1 + TJ_WG, TE3 = TE2 + TJ_WG, TE4 = TE3 + TJ_WD, TE5 = TE4 + TJ_W1, TE6 = TE5 + TJ_W1;
DI void tile_info(const Params& p, int t, TInfo& ti) {
  char* ws = p.ws; ti.dl = nullptr; int nn;
  if (t < TE0) { ti.mat = 0; ti.src = p.w_in; ti.N = DIN; ti.Kd = 2048; ti.dh = (bf16_t*)(ws + OFF_WIN_HI); ti.dl = (bf16_t*)(ws + OFF_WIN_LO); nn = 89; }
  else if (t < TE1) { t -= TE0; ti.mat = 1; ti.src = p.w_out; ti.N = 2048; ti.Kd = 2048; ti.dh = (bf16_t*)(ws + OFF_WOUT); nn = 32; }
  else if (t < TE2) { t -= TE1; ti.mat = 2; ti.src = p.w_gate; ti.N = DFF; ti.Kd = 2048; ti.dh = (bf16_t*)(ws + OFF_WGU); nn = 88; }
  else if (t < TE3) { t -= TE2; ti.mat = 3; ti.src = p.w_up; ti.N = DFF; ti.Kd = 2048; ti.dh = (bf16_t*)(ws + OFF_WGU); nn = 88; }
  else if (t < TE4) { t -= TE3; ti.mat = 4; ti.src = p.w_down; ti.N = 2048; ti.Kd = DFF; ti.dh = (bf16_t*)(ws + OFF_WDN); nn = 32; }
  else if (t < TE5) { t -= TE4; ti.mat = 5; ti.src = p.w_kc1; ti.N = 256; ti.Kd = 4096; ti.dh = (bf16_t*)(ws + OFF_W1K_HI); ti.dl = (bf16_t*)(ws + OFF_W1K_LO); nn = 4; }
  else { t -= TE5; ti.mat = 6; ti.src = p.w_vc1; ti.N = 256; ti.Kd = 4096; ti.dh = (bf16_t*)(ws + OFF_W1V); nn = 4; }
  ti.k0 = (t / nn) * 128; ti.n0 = (t % nn) * 64;
}
DI void tr_load(const TInfo& ti, int tid, f32x4 (&r)[4]) {
#pragma unroll
  for (int i = 0; i < 4; ++i) {
    const int idx = tid + i * 512, k = idx >> 4, col = ti.n0 + (idx & 15) * 4;
    r[i] = col < ti.N ? __builtin_nontemporal_load((const f32x4*)(ti.src + (size_t)(ti.k0 + k) * ti.N + col)) : (f32x4){0.f, 0.f, 0.f, 0.f};
  }
}
DI void tr_lds_write(float* tile, int tid, const f32x4 (&r)[4]) {
#pragma unroll
  for (int i = 0; i < 4; ++i) {
    const int idx = tid + i * 512, k = idx >> 4, c = (idx & 15) * 4;
#pragma unroll
    for (int j = 0; j < 4; ++j) tile[k * 65 + c + j] = r[i][j];
  }
}
DI void tr_store(const TInfo& ti, const float* tile, int tid) {
#pragma unroll
  for (int i = 0; i < 2; ++i) {
    const int idx = tid + i * 512, nr = idx >> 4, kc = idx & 15, col = ti.n0 + nr;
    if (col < ti.N) {
      int row, lrow = -1;
      if (ti.mat == 0) row = map_win(col, lrow);
      else if (ti.mat == 2) row = (col >> 7) * 256 + perm_gu(col & 127);
      else if (ti.mat == 3) row = (col >> 7) * 256 + 128 + perm_gu(col & 127);
      else { row = col; if (ti.mat == 5) lrow = col; }
      float v[8];
#pragma unroll
      for (int e = 0; e < 8; ++e) v[e] = tile[(kc * 8 + e) * 65 + nr];
      *(u32x4*)(ti.dh + (size_t)row * ti.Kd + ti.k0 + kc * 8) = (u32x4){pack2(v[0], v[1]), pack2(v[2], v[3]), pack2(v[4], v[5]), pack2(v[6], v[7])};
      if (lrow >= 0)
        *(u32x4*)(ti.dl + (size_t)lrow * ti.Kd + ti.k0 + kc * 8) = (u32x4){pack2(lo_of(v[0]), lo_of(v[1])), pack2(lo_of(v[2]), lo_of(v[3])), pack2(lo_of(v[4]), lo_of(v[5])), pack2(lo_of(v[6]), lo_of(v[7]))};
    }
  }
}
DI void transpose_all(const Params& p) {
  float* lds = (float*)g_smem;
  int tid = threadIdx.x; asm volatile("" : "+v"(tid));
  const int G = gridDim.x;
  int t0 = blockIdx.x, t1 = t0 + G;
  TInfo ia, ib; f32x4 ra[4], rb[4];
  if (t0 < TE6) { tile_info(p, t0, ia); tr_load(ia, tid, ra); }
  if (t1 < TE6) { tile_info(p, t1, ib); tr_load(ib, tid, rb); }
  while (t0 < TE6) {
    tr_lds_write(lds, tid, ra);
    __syncthreads();
    const TInfo cura = ia;
    const int t2 = t0 + 2 * G;
    if (t2 < TE6) { tile_info(p, t2, ia); tr_load(ia, tid, ra); }
    tr_store(cura, lds, tid);
    if (t1 >= TE6) break;
    tr_lds_write(lds + 128 * 65, tid, rb);
    __syncthreads();
    const TInfo curb = ib;
    const int t3 = t1 + 2 * G;
    if (t3 < TE6) { tile_info(p, t3, ib); tr_load(ib, tid, rb); }
    tr_store(curb, lds + 128 * 65, tid);
    t0 = t2; t1 = t3;
  }
  __syncthreads();
}

DI void mod_job(const Params& p, int job) {
  float* sc = (float*)g_smem;
  float* red = sc + 4096;
  const int tid = threadIdx.x, wave = tid >> 6, lane = tid & 63;
  for (int i = tid; i < 4096; i += 512) sc[i] = siluf_(p.c[i]);
  __syncthreads();
  const int n0 = job * 64, cgp = lane & 15, kr = lane >> 4;
  f32x4 a0 = {0.f, 0.f, 0.f, 0.f}, a1 = {0.f, 0.f, 0.f, 0.f};
#pragma unroll 8
  for (int k = wave * 4 + kr; k < 2048; k += 32) {
    const f32x4 wv = __builtin_nontemporal_load((const f32x4*)(p.w_ada + (size_t)k * 12288 + n0 + cgp * 4));
    a0 += wv * sc[k]; a1 += wv * sc[2048 + k];
  }
#pragma unroll
  for (int j = 0; j < 4; ++j) {
    a0[j] += __shfl_xor(a0[j], 16); a0[j] += __shfl_xor(a0[j], 32);
    a1[j] += __shfl_xor(a1[j], 16); a1[j] += __shfl_xor(a1[j], 32);
  }
  if (kr == 0) {
#pragma unroll
    for (int j = 0; j < 4; ++j) { red[(wave * 2 + 0) * 64 + cgp * 4 + j] = a0[j]; red[(wave * 2 + 1) * 64 + cgp * 4 + j] = a1[j]; }
  }
  __syncthreads();
  if (tid < 128) {
    const int b = tid >> 6, col = tid & 63;
    float s = p.b_ada[n0 + col];
#pragma unroll
    for (int w = 0; w < 8; ++w) s += red[(w * 2 + b) * 64 + col];
    ((float*)(p.ws + OFF_MOD))[b * 12288 + n0 + col] = s;
  }
  __syncthreads();
}

DI void bias1_job(const Params& p, int j) {
  const int which = j >> 4, chunk = j & 15;
  const float* w1 = which ? p.w_vc1 : p.w_kc1;
  float* red = (float*)g_smem;
  const int tid = threadIdx.x, col = tid & 255, half = tid >> 8;
  float s = 0.f;
  const int kb = chunk * 256 + half * 128;
#pragma unroll 16
  for (int k = kb; k < kb + 128; ++k) s += p.cmp_pos[k] * w1[(size_t)k * 256 + col];
  red[tid] = s;
  __syncthreads();
  if (tid < 256) ((float*)(p.ws + OFF_BIAS1))[(which * 16 + chunk) * 256 + tid] = red[tid] + red[tid + 256];
  __syncthreads();
}

DI void rope_job(const Params& p, int job) {
  const int idx = job * 512 + threadIdx.x, token = idx >> 6, i = idx & 63;
  const float ang = (float)p.pos[token] * c_inv_freq[i];
  double t = (double)ang * 0.15915494309189535;
  t -= floor(t + 0.5);
  const float tf = (float)t;
  ((float*)(p.ws + OFF_COS))[idx] = __builtin_amdgcn_cosf(tf);
  ((float*)(p.ws + OFF_SIN))[idx] = __builtin_amdgcn_sinf(tf);
}

DI void phase0(const Params& p) {
  transpose_all(p);
  constexpr int J_MOD = 192, J_B1 = 32, J_ROPE = 1024;
  for (int job = blockIdx.x; job < J_MOD + J_B1 + J_ROPE; job += gridDim.x) {
    if (job < J_MOD) mod_job(p, job);
    else if (job < J_MOD + J_B1) bias1_job(p, job - J_MOD);
    else rope_job(p, job - J_MOD - J_B1);
  }
}

DI void rmsmod_phase(const float* src, const float* g, const float* mod, int sh_off, int sc_off, bf16_t* dhi, bf16_t* dlo) {
  const int wave = threadIdx.x >> 6, lane = threadIdx.x & 63;
  for (int row = blockIdx.x * 8 + wave; row < T_TOK; row += gridDim.x * 8) {
    const int b = row >> 12;
    const f32x4* xr = (const f32x4*)(src + (size_t)row * 2048);
    f32x4 v[8]; float ss = 0.f;
#pragma unroll
    for (int i = 0; i < 8; ++i) { v[i] = xr[lane + i * 64]; ss += v[i][0] * v[i][0] + v[i][1] * v[i][1] + v[i][2] * v[i][2] + v[i][3] * v[i][3]; }
    ss = wave_sum(ss);
    const float rstd = rsqrtf(ss * (1.f / 2048.f) + 1e-6f);
#pragma unroll
    for (int i = 0; i < 8; ++i) {
      const int col = (lane + i * 64) * 4;
      const f32x4 gv = *(const f32x4*)(g + col);
      const f32x4 sc = *(const f32x4*)(mod + b * 12288 + sc_off + col), sh = *(const f32x4*)(mod + b * 12288 + sh_off + col);
      f32x4 u = (v[i] * rstd) * gv; u = u * (1.f + sc) + sh;
      unsigned h0, h1, l0, l1; split2(u[0], u[1], h0, l0); split2(u[2], u[3], h1, l1);
      *(u32x2*)(dhi + (size_t)row * 2048 + col) = (u32x2){h0, h1};
      if (dlo) *(u32x2*)(dlo + (size_t)row * 2048 + col) = (u32x2){l0, l1};
    }
  }
}

DI void ymix_phase(const Params& p) {
  const int wave = threadIdx.x >> 6, lane = threadIdx.x & 63;
  bf16_t* ym = (bf16_t*)(p.ws + OFF_U_HI);
  for (int row = blockIdx.x * 8 + wave; row < T_TOK; row += gridDim.x * 8) {
#pragma unroll
    for (int part = 0; part < 2; ++part) {
      const f32x4* xr = (const f32x4*)((const float*)(p.ws + (part ? OFF_ON32 : OFF_OF32)) + (size_t)row * 1024);
      const float* beta = part ? p.beta_nsa : p.beta_fox;
      f32x4 v[4]; float ss = 0.f;
#pragma unroll
      for (int i = 0; i < 4; ++i) { v[i] = __builtin_nontemporal_load(xr + lane + i * 64); ss += v[i][0] * v[i][0] + v[i][1] * v[i][1] + v[i][2] * v[i][2] + v[i][3] * v[i][3]; }
      ss = wave_sum(ss);
      const float rstd = rsqrtf(ss * (1.f / 1024.f) + 1e-6f);
#pragma unroll
      for (int i = 0; i < 4; ++i) {
        const int col = (lane + i * 64) * 4;
        const f32x4 u = (v[i] * rstd) * *(const f32x4*)(beta + col);
        *(u32x2*)(ym + (size_t)row * 2048 + part * 1024 + col) = (u32x2){pack2(u[0], u[1]), pack2(u[2], u[3])};
      }
    }
  }
}

DI void final_phase(const Params& p) {
  const int wave = threadIdx.x >> 6, lane = threadIdx.x & 63;
  for (int row = blockIdx.x * 8 + wave; row < T_TOK; row += gridDim.x * 8) {
    f32x4* xr = (f32x4*)(p.out + (size_t)row * 2048);
    f32x4 v[8]; float ss = 0.f;
#pragma unroll
    for (int i = 0; i < 8; ++i) { v[i] = __builtin_nontemporal_load(xr + lane + i * 64); ss += v[i][0] * v[i][0] + v[i][1] * v[i][1] + v[i][2] * v[i][2] + v[i][3] * v[i][3]; }
    ss = wave_sum(ss);
    const float rstd = rsqrtf(ss * (1.f / 2048.f) + 1e-6f);
#pragma unroll
    for (int i = 0; i < 8; ++i) __builtin_nontemporal_store((v[i] * rstd) * *(const f32x4*)(p.final_norm + (lane + i * 64) * 4), xr + lane + i * 64);
  }
}

typedef float f32x4_ __attribute__((ext_vector_type(4)));
DI void misc_job(const Params& p, int piece) {
  char* ws = p.ws;
  int tid = threadIdx.x; asm volatile("" : "+v"(tid));
  const int wave = tid >> 6, lane = tid & 63, fr = lane & 15, fq = lane >> 4;
  const bf16_t* A = (const bf16_t*)(ws + OFF_U_HI) + (size_t)(piece * 32 + fr) * 2048 + fq * 8 + wave * 256;
  const bf16_t* B = (const bf16_t*)(ws + OFF_WIN_HI) + (size_t)(5632 + fr) * 2048 + fq * 8 + wave * 256;
  f32x4 acc[2][2] = {};
#pragma unroll
  for (int k = 0; k < 8; ++k) {
    const bf16x8 a0 = *(const bf16x8*)(A + k * 32), a1 = *(const bf16x8*)(A + 16 * 2048 + k * 32);
    const bf16x8 b0 = *(const bf16x8*)(B + k * 32), b1 = *(const bf16x8*)(B + 16 * 2048 + k * 32);
    acc[0][0] = __builtin_amdgcn_mfma_f32_16x16x32_bf16(a0, b0, acc[0][0], 0, 0, 0);
    acc[0][1] = __builtin_amdgcn_mfma_f32_16x16x32_bf16(a0, b1, acc[0][1], 0, 0, 0);
    acc[1][0] = __builtin_amdgcn_mfma_f32_16x16x32_bf16(a1, b0, acc[1][0], 0, 0, 0);
    acc[1][1] = __builtin_amdgcn_mfma_f32_16x16x32_bf16(a1, b1, acc[1][1], 0, 0, 0);
  }
  f32x4* red = (f32x4*)g_smem;
#pragma unroll
  for (int q = 0; q < 4; ++q) red[(wave * 4 + q) * 64 + lane] = acc[q >> 1][q & 1];
  __syncthreads();
  if (tid < 256) {
    const int q = tid >> 6, l = tid & 63, mb = q >> 1, nb = q & 1, fr2 = l & 15, fq2 = l >> 4;
    f32x4 sum = red[q * 64 + l];
#pragma unroll
    for (int w = 1; w < 8; ++w) sum += red[(w * 4 + q) * 64 + l];
    const int col = nb * 16 + fr2;
#pragma unroll
    for (int j = 0; j < 4; ++j) {
      const int token = piece * 32 + mb * 16 + fq2 * 4 + j;
      if (col < 8) ((float*)(ws + OFF_LOGF))[token * 8 + col] = log_sigmoid(sum[j] + p.b_fgate[col]);
      else ((float*)(ws + OFF_GATES))[token * 24 + col - 8] = sigmoidf_(sum[j]);
    }
  }
  __syncthreads();
}
DI void inproj_heavy(const Params& p, int job) {
  char* ws = p.ws;
  const bf16_t* uhi = (const bf16_t*)(ws + OFF_U_HI); const bf16_t* ulo = (const bf16_t*)(ws + OFF_U_LO);
  const bf16_t* whi = (const bf16_t*)(ws + OFF_WIN_HI); const bf16_t* wlo = (const bf16_t*)(ws + OFF_WIN_LO);
  const int pn = 12 + job / 32, pm = job % 32;
  GemmOp g; g.lda = 2048; g.ldb = 2048;
  g.A0 = uhi; g.A1 = uhi; g.A2 = ulo; g.B0 = whi; g.B1 = wlo - (size_t)3072 * 2048; g.B2 = whi; g.nt = 96; g.shift = 5;
  EpiInproj e{&p, pn};
  gemm_tile(g, pm * 256, pn * 256, e);
}
DI void inproj_light(const Params& p, int L) {
  char* ws = p.ws;
  const bf16_t* uhi = (const bf16_t*)(ws + OFF_U_HI); const bf16_t* whi = (const bf16_t*)(ws + OFF_WIN_HI);
  GemmOp g; g.lda = 2048; g.ldb = 2048; g.nt = 32; g.shift = 5;
  if (L < 352) {
    const int t = L / 32, pm = L % 32;
    const int pn = t < 8 ? t : (t == 8 ? 17 : (t == 9 ? 18 : 20));
    g.A0 = g.A1 = g.A2 = uhi; g.B0 = g.B1 = g.B2 = whi;
    EpiInproj e{&p, pn};
    gemm_tile(g, pm * 256, pn * 256, e);
  } else {
    const int j = L - 352, rt = j / 32, tt = j % 32;
    int wrow; bf16_t* dst; int nh, sec0;
    if (rt < 4) { wrow = 2048 + rt * 256; dst = (bf16_t*)(ws + OFF_VFT); nh = 8; sec0 = 2048; }
    else if (rt == 4) { wrow = 4864; dst = (bf16_t*)(ws + OFF_VST); nh = 2; sec0 = 4864; }
    else { wrow = 5376; dst = (bf16_t*)(ws + OFF_VWT); nh = 2; sec0 = 5376; }
    g.A0 = g.A1 = g.A2 = whi; g.B0 = g.B1 = g.B2 = uhi;
    EpiVT e{dst, nh, sec0};
    gemm_tile(g, wrow, tt * 256, e);
  }
}
DI void inproj_phase(const Params& p, bool dry) {
  if (gridDim.x == 256) {
    const int c = blockIdx.x;
    if (c < 160) { inproj_heavy(p, c); inproj_light(p, c); }
    else { for (int i = 0; i < 4; ++i) inproj_light(p, 160 + (c - 160) * 4 + i); }
    if (!dry) misc_job(p, c);
  } else {
    FOR_JOBS(job, 160) inproj_heavy(p, job);
    FOR_JOBS(job, 544) inproj_light(p, job);
    FOR_JOBS(job, 256) misc_job(p, job);
  }
}

constexpr int KSTR = 272, VSTR = 264;
constexpr int ST_K = 0, ST_V = 128 * KSTR, ST_C = ST_V + 128 * VSTR, ST_SIZE = ST_C + 512;
constexpr int LDS_LIST = 2 * ST_SIZE;

DI bf16x8 pack8(const f32x16& x, int s) {
  u32x4 r;
  r[0] = pack2(x[8 * s + 0], x[8 * s + 1]); r[1] = pack2(x[8 * s + 2], x[8 * s + 3]);
  r[2] = pack2(x[8 * s + 4], x[8 * s + 5]); r[3] = pack2(x[8 * s + 6], x[8 * s + 7]);
  return __builtin_bit_cast(bf16x8, r);
}
DI bf16x8 ldv8(const char* p) {
  const u32x2 a = *(const u32x2*)p, b = *(const u32x2*)(p + 16);
  u32x4 r = {a[0], a[1], b[0], b[1]};
  return __builtin_bit_cast(bf16x8, r);
}

constexpr int AS_K = 0, AS_V = 32768, AS_C = 65536, AS_SIZE = 66048;
constexpr int LDS_LIST2 = 2 * AS_SIZE;
DI int pi23(int r) { return (r & ~12) | ((r & 4) << 1) | ((r & 8) >> 1); }
template <int MODE>
DI void attn_unit(const Params& p, int b, int hg, int qt, bool dry = false) {
  char* ws = p.ws;
  int tid = threadIdx.x; asm volatile("" : "+v"(tid));
  const int wave = tid >> 6, lane = tid & 63, l32 = lane & 31, hh = lane >> 5, rg = wave & 3, kh = wave >> 2;
  int token, head; const bf16_t *qrow, *kbase, *vbase; int kstride;
  if (MODE == 0) {
    token = qt * 128 + rg * 32 + l32; head = hg;
    qrow = (const bf16_t*)(ws + OFF_QF) + (size_t)(b * 4096 + token) * 1024 + head * 128;
    kbase = (const bf16_t*)(ws + OFF_KF) + (size_t)b * 4096 * 1024 + head * 128; kstride = 1024;
    vbase = (const bf16_t*)(ws + OFF_VFT) + (size_t)(b * 8 + head) * 128 * 4096;
  } else {
    if (MODE == 1) { token = qt * 32 + l32; head = hg * 4 + rg; }
    else { token = qt * 32 + rg * 8 + (l32 >> 2); head = hg * 4 + (l32 & 3); }
    qrow = (const bf16_t*)(ws + OFF_QN_HI) + (size_t)(b * 4096 + token) * 1024 + head * 128;
    kbase = (const bf16_t*)(ws + (MODE == 1 ? OFF_KW : OFF_KS)) + (size_t)(b * 2 + hg) * 4096 * 128; kstride = 128;
    vbase = (const bf16_t*)(ws + (MODE == 1 ? OFF_VWT : OFF_VST)) + (size_t)(b * 2 + hg) * 128 * 4096;
  }
  const int wtmin = MODE == 0 ? qt * 128 + rg * 32 : (MODE == 1 ? qt * 32 : qt * 32 + rg * 8), wtmax = wtmin + (MODE == 2 ? 7 : 31);
  int nst, kv_start = 0;
  int* list = (int*)(g_smem + LDS_LIST2);
  unsigned long long selmask = 0;
  if (MODE == 0) nst = qt + 1;
  else if (MODE == 1) { int lo = qt * 32 - 511; if (lo < 0) lo = 0; kv_start = lo & ~63; nst = (qt * 32 + 32 - kv_start + 127) >> 7; }
  else {
    const unsigned long long* sel = (const unsigned long long*)(ws + OFF_SEL) + (size_t)(b * 2 + hg) * 4096;
    selmask = sel[token];
    if (wave == 0) {
      const unsigned long long sm0 = sel[qt * 32 + l32];
      unsigned lo = (unsigned)sm0, hi = (unsigned)(sm0 >> 32);
#pragma unroll
      for (int o = 16; o > 0; o >>= 1) { lo |= __shfl_xor(lo, o); hi |= __shfl_xor(hi, o); }
      const unsigned long long um = ((unsigned long long)hi << 32) | lo;
      if ((um >> lane) & 1ull) list[1 + __popcll(um & ((1ull << lane) - 1ull))] = lane;
      if (lane == 0) list[0] = __popcll(um);
    }
    __syncthreads();
    nst = (list[0] + 1) >> 1;
  }
  bf16x8 qf[8];
#pragma unroll
  for (int ks = 0; ks < 8; ++ks) qf[ks] = *(const bf16x8*)(qrow + ks * 16 + hh * 8);
  float cumq = 0.f;
  const float* cumrow = nullptr;
  if (MODE == 0) { cumrow = (const float*)(ws + OFF_CUM) + (size_t)(b * 8 + head) * 4096; cumq = cumrow[token]; }

  f32x16 o[4];
#pragma unroll
  for (int i = 0; i < 4; ++i) o[i] = zero16();
  float mrun = -1e30f, lrun = 0.f;

  auto tile_base = [&](int it, int half) -> int {
    if (MODE == 2) { const int i = 2 * it + half; return i < list[0] ? list[1 + i] * 64 : -1; }
    return kv_start + it * 128 + half * 64;
  };
  const int rsub = lane >> 4, slot = lane & 15;
  unsigned koff[4], voff[4]; bool vhalf[4];
#pragma unroll
  for (int j = 0; j < 4; ++j) {
    const int row = (j * 8 + wave) * 4 + rsub;
    const int c = slot ^ (row & 15);
    koff[j] = (unsigned)(pi23(row & 63) * kstride + c * 8) * 2u;
    vhalf[j] = (c >> 3) != 0;
    voff[j] = MODE == 2 ? (unsigned)(row * 4096 + (c & 7) * 8) * 2u : (unsigned)(row * 4096 + c * 8) * 2u;
  }
  auto issue_stage = [&](int it, int buf) {
    if (DRY_MODE == 2 && dry) return;
    int kb0 = tile_base(it, 0), kb1 = tile_base(it, 1);
    if (kb1 < 0) kb1 = 0;
    char* sb = g_smem + buf * AS_SIZE;
    const char* kp0 = uptr((const char*)(kbase + (size_t)kb0 * kstride));
    const char* kp1 = uptr((const char*)(kbase + (size_t)kb1 * kstride));
    const char* vp0 = uptr((const char*)(vbase + kb0));
    const char* vp1 = uptr((const char*)(vbase + kb1));
#pragma unroll
    for (int j = 0; j < 4; ++j) {
      __builtin_amdgcn_global_load_lds((const unsigned*)((j >> 1 ? kp1 : kp0) + koff[j]), (unsigned*)(sb + AS_K + (j * 8 + wave) * 1024 + lane * 16), 16, 0, 0);
      const char* vsrc = MODE == 2 ? ((vhalf[j] ? vp1 : vp0) + voff[j]) : (vp0 + voff[j]);
      __builtin_amdgcn_global_load_lds((const unsigned*)vsrc, (unsigned*)(sb + AS_V + (j * 8 + wave) * 1024 + lane * 16), 16, 0, 0);
    }
    if (MODE == 0 && wave < 2) {
      const int key = (wave ? kb1 : kb0) + lane;
      __builtin_amdgcn_global_load_lds((const unsigned*)(cumrow + key), (unsigned*)(sb + AS_C + wave * 256 + lane * 4), 4, 0, 0);
    }
  };

  int it0 = 0;
  if (MODE == 0) {
    float q2 = 0.f;
#pragma unroll
    for (int ks = 0; ks < 8; ++ks)
#pragma unroll
      for (int e = 0; e < 8; ++e) { const float f = bf2f((unsigned short)qf[ks][e]); q2 += f * f; }
    q2 = xsum32(q2);
#pragma unroll
    for (int o2 = 16; o2 > 0; o2 >>= 1) q2 = fmaxf(q2, __shfl_xor(q2, o2));
    const float* kn = (const float*)(ws + OFF_KNORM) + (size_t)(b * 8 + head) * 128;
    float k2 = fmaxf(kn[lane], kn[lane + 64]);
#pragma unroll
    for (int o2 = 32; o2 > 0; o2 >>= 1) k2 = fmaxf(k2, __shfl_xor(k2, o2));
    float* qx = (float*)(g_smem + LDS_LIST2);
    if (lane == 0) qx[wave] = q2;
    __syncthreads();
    const float q2m = fmaxf(fmaxf(qx[0], qx[1]), fmaxf(qx[2], qx[3]));
    const float xub = sqrtf(q2m * k2) * (QK_C1 * 1.001f) + 0.01f;
    const float cend = lane < qt ? cumrow[lane * 128 + 127] : cumrow[qt * 128];
    const float bub = (cumrow[qt * 128] - cend) * LOG2E;
    const bool skip = lane < qt && (2.f * xub + bub < -160.f);
    const unsigned long long sk = __ballot(skip);
    it0 = (int)__builtin_ctzll(~sk);
    if (it0 > qt) it0 = qt;
    it0 = __builtin_amdgcn_readfirstlane(it0);
  }
#pragma unroll
  for (int ks = 0; ks < 8; ++ks) asm volatile("" :: "v"(qf[ks]));
  asm volatile("" :: "v"(cumq));
  issue_stage(it0, it0 & 1);
  for (int it = it0; it < nst; ++it) {
    asm volatile("s_waitcnt vmcnt(0)" ::: "memory");
    __builtin_amdgcn_s_barrier();
    if (it + 1 < nst) issue_stage(it + 1, (it + 1) & 1);
    const char* sb = g_smem + (it & 1) * AS_SIZE;
    const int kbh = tile_base(it, kh);
    bool active;
    if (MODE == 0) active = kbh <= wtmax;
    else if (MODE == 1) active = kbh <= wtmax && kbh + 63 >= wtmin - 511;
    else active = kbh >= 0;
    if (DRY_MODE == 1 && dry) active = false;
    const bool selbit = (MODE == 2 && kbh >= 0) ? ((selmask >> (kbh >> 6)) & 1ull) != 0 : true;
    if (MODE == 2) active = active && __any(selbit);
    if (active) {
      f32x16 stA = zero16(), stB = zero16();
      {
        const int row = kh * 64 + l32;
        const char* kp = sb + AS_K + row * 256;
        const int sw = row & 15;
#pragma unroll
        for (int ks = 0; ks < 8; ++ks) stA = mfma32(*(const bf16x8*)(kp + (((ks * 2 + hh) ^ sw) << 4)), qf[ks], stA);
#pragma unroll
        for (int ks = 0; ks < 8; ++ks) stB = mfma32(*(const bf16x8*)(kp + 32 * 256 + (((ks * 2 + hh) ^ sw) << 4)), qf[ks], stB);
      }
      const int tq0 = token - kbh - hh * 8;
      bf16x8 pk0, pk1;
#define ATTN_SOFTMAX(ST, KB2) do { \
        const int kmin = kbh + (KB2) * 32, kmax = kmin + 31; \
        if (MODE == 0) { \
          f32x16 cs16; \
          _Pragma("unroll") for (int gq = 0; gq < 4; ++gq) { \
            const f32x4 cs = *(const f32x4*)(sb + AS_C + (kh * 64 + (KB2) * 32 + (gq >> 1) * 16 + hh * 8 + (gq & 1) * 4) * 4); \
            cs16[gq * 4] = cs[0]; cs16[gq * 4 + 1] = cs[1]; cs16[gq * 4 + 2] = cs[2]; cs16[gq * 4 + 3] = cs[3]; } \
          ST = ST * QK_C1 + (cs16 * (-LOG2E) + cumq * LOG2E); \
        } else ST = ST * QK_C1; \
        bool need_mask; \
        if (MODE == 0) need_mask = kmax > wtmin; \
        else if (MODE == 1) need_mask = kmax > wtmin || wtmax - kmin >= 512; \
        else need_mask = (kbh >> 6) == (wtmin >> 6); \
        if (need_mask) { \
          _Pragma("unroll") for (int gq = 0; gq < 4; ++gq) _Pragma("unroll") for (int j = 0; j < 4; ++j) { \
            const int kofs = (KB2) * 32 + (gq >> 1) * 16 + (gq & 1) * 4 + j; \
            bool valid = kofs <= tq0; \
            if (MODE == 1) valid = valid && (tq0 - kofs < 512); \
            ST[gq * 4 + j] = valid ? ST[gq * 4 + j] : -1e30f; } } \
        float mx = ST[0]; \
        _Pragma("unroll") for (int r = 1; r < 16; ++r) mx = fmaxf(mx, ST[r]); \
        mx = xmax32(mx); \
        if (MODE == 2) mx = selbit ? mx : -1e30f; \
        const float mnew = (mx > mrun + 8.f) ? mx : mrun;        \
        if (__any(mnew != mrun)) { \
          const float alpha = fexp2(mrun - mnew); \
          lrun *= alpha; \
          _Pragma("unroll") for (int i = 0; i < 4; ++i) o[i] = o[i] * alpha; } \
        mrun = mnew; \
        const float msub = (mnew > -1e29f && selbit) ? mnew : 1e30f; \
        ST = ST - msub; \
        float rs = 0.f; \
        _Pragma("unroll") for (int r = 0; r < 16; ++r) { ST[r] = fexp2(ST[r]); rs += ST[r]; } \
        rs = xsum32(rs); \
        lrun += rs; \
        pk0 = pack8(ST, 0); pk1 = pack8(ST, 1); } while (0)
#define ATTN_PV(KB2) do { \
        _Pragma("unroll") for (int dblk = 0; dblk < 4; ++dblk) { \
          const int d = dblk * 32 + l32; \
          const char* vp = sb + AS_V + d * 256; \
          const int sw = d & 15; \
          o[dblk] = mfma32(*(const bf16x8*)(vp + (((kh * 8 + (KB2) * 4 + hh) ^ sw) << 4)), pk0, o[dblk]); \
          o[dblk] = mfma32(*(const bf16x8*)(vp + (((kh * 8 + (KB2) * 4 + 2 + hh) ^ sw) << 4)), pk1, o[dblk]); } } while (0)
      ATTN_SOFTMAX(stA, 0);
      ATTN_PV(0);
      ATTN_SOFTMAX(stB, 1);
      ATTN_PV(1);
#undef ATTN_SOFTMAX
#undef ATTN_PV
    }
  }
  __syncthreads();
  float* X = (float*)g_smem;
  if (kh == 1) {
#pragma unroll
    for (int i = 0; i < 4; ++i)
#pragma unroll
      for (int r = 0; r < 16; ++r) X[(rg * 66 + i * 16 + r) * 64 + lane] = o[i][r];
    X[(rg * 66 + 64) * 64 + lane] = mrun; X[(rg * 66 + 65) * 64 + lane] = lrun;
  }
  __syncthreads();
  float* Tt = (float*)(g_smem + 67584);
  if (kh == 0) {
    const float m1 = X[(rg * 66 + 64) * 64 + lane], l1 = X[(rg * 66 + 65) * 64 + lane];
    const float mf = fmaxf(mrun, m1);
    const float a0 = fexp2(mrun - mf), a1 = fexp2(m1 - mf);
    const float lt = lrun * a0 + l1 * a1;
    float inv = lt > 0.f ? 1.f / lt : 0.f;
    if (MODE != 0) inv *= ((const float*)(ws + OFF_GATES))[(size_t)(b * 4096 + token) * 24 + head * 3 + (MODE == 1 ? 2 : 1)];
    const float s0 = a0 * inv, s1 = a1 * inv;
    float* trow = Tt + (rg * 32 + l32) * 132;
#pragma unroll
    for (int i = 0; i < 4; ++i)
#pragma unroll
      for (int gq = 0; gq < 4; ++gq) {
        f32x4 v;
#pragma unroll
        for (int j = 0; j < 4; ++j) v[j] = o[i][gq * 4 + j] * s0 + X[(rg * 66 + i * 16 + gq * 4 + j) * 64 + lane] * s1;
        *(f32x4*)(trow + i * 32 + 8 * gq + 4 * hh) = v;
      }
  }
  __syncthreads();
  if (!dry) {
    float* obase = (float*)(ws + (MODE == 0 ? OFF_OF32 : OFF_ON32)) + (size_t)b * 4096 * 1024;
#pragma unroll
    for (int k = 0; k < 8; ++k) {
      const int R = wave * 16 + k * 2 + (lane >> 5), rgr = R >> 5, rr = R & 31, c4 = (lane & 31) * 4;
      int tk, hd;
      if (MODE == 0) { tk = qt * 128 + rgr * 32 + rr; hd = hg; }
      else if (MODE == 1) { tk = qt * 32 + rr; hd = hg * 4 + rgr; }
      else { tk = qt * 32 + rgr * 8 + (rr >> 2); hd = hg * 4 + (rr & 3); }
      float* dp = obase + (size_t)tk * 1024 + hd * 128 + c4;
      f32x4 v = *(const f32x4*)(Tt + R * 132 + c4);
      if (MODE == 2) v += *(const f32x4*)dp;
      *(f32x4*)dp = v;
    }
  }
  __syncthreads();
}

constexpr int CV_STR = 520;
constexpr int C_V = 0, C_K = 128 * CV_STR  , C_KLO = C_K + 128 * KSTR, C_EX = C_KLO + 128 * KSTR  ;
DI void cmp_unit(const Params& p, int b, int g, int qt, bool dry = false) {
  char* ws = p.ws;
  int tid = threadIdx.x; asm volatile("" : "+v"(tid));
  const int wave = tid >> 6, lane = tid & 63, l32 = lane & 31, hh = lane >> 5, rg = wave & 3, kh = wave >> 2;
  const int token = qt * 32 + l32, head = g * 4 + rg, bg = b * 2 + g;
  const bf16_t* qh = (const bf16_t*)(ws + OFF_QN_HI) + (size_t)(b * 4096 + token) * 1024 + head * 128;
  const bf16_t* ql = (const bf16_t*)(ws + OFF_QN_LO) + (size_t)(b * 4096 + token) * 1024 + head * 128;
  const bf16_t* kch = (const bf16_t*)(ws + OFF_KC_HI) + (size_t)bg * 256 * 128;
  const bf16_t* kcl = (const bf16_t*)(ws + OFF_KC_LO) + (size_t)bg * 256 * 128;
  const bf16_t* vct = (const bf16_t*)(ws + OFF_VCT) + (size_t)bg * 128 * 256;
  bf16x8 qfh[8], qfl[8];
#pragma unroll
  for (int ks = 0; ks < 8; ++ks) { qfh[ks] = *(const bf16x8*)(qh + ks * 16 + hh * 8); qfl[ks] = *(const bf16x8*)(ql + ks * 16 + hh * 8); }
#pragma unroll
  for (int i = 0; i < 8; ++i) {
    const int c = tid + i * 512, d = c >> 5, cc = c & 31;
    const u32x4 v = *(const u32x4*)(vct + (size_t)d * 256 + cc * 8);
    char* vd = g_smem + C_V + d * CV_STR + cc * 16;
    *(u32x2*)vd = (u32x2){v[0], v[1]}; *(u32x2*)(vd + 8) = (u32x2){v[2], v[3]};
  }
  f32x16 t4[4];
#pragma unroll
  for (int s = 0; s < 2; ++s) {
#pragma unroll
    for (int i = 0; i < 4; ++i) {
      const int c = tid + i * 512, rr = c >> 4, cc = c & 15;
      const int key = (rr >> 6) * 128 + s * 64 + (rr & 63);
      *(u32x4*)(g_smem + C_K + rr * KSTR + cc * 16) = *(const u32x4*)(kch + (size_t)key * 128 + cc * 8);
      *(u32x4*)(g_smem + C_KLO + rr * KSTR + cc * 16) = *(const u32x4*)(kcl + (size_t)key * 128 + cc * 8);
    }
    __syncthreads();
    {
      f32x16 st0 = zero16(), st1 = zero16();
      const int off = (kh * 64 + l32) * KSTR + hh * 16;
      const int tmaxu = qt * 32 + 31;
      const bool act0 = 16 * (kh * 128 + s * 64) + 31 <= tmaxu, act1 = 16 * (kh * 128 + s * 64 + 32) + 31 <= tmaxu;
      if (act0) {
#pragma unroll
        for (int ks = 0; ks < 8; ++ks) {
          const bf16x8 ah0 = *(const bf16x8*)(g_smem + C_K + off + ks * 32), al0 = *(const bf16x8*)(g_smem + C_KLO + off + ks * 32);
          st0 = mfma32(al0, qfh[ks], st0); st0 = mfma32(ah0, qfl[ks], st0); st0 = mfma32(ah0, qfh[ks], st0);
        }
      }
      if (act1) {
#pragma unroll
        for (int ks = 0; ks < 8; ++ks) {
          const bf16x8 ah1 = *(const bf16x8*)(g_smem + C_K + off + 32 * KSTR + ks * 32), al1 = *(const bf16x8*)(g_smem + C_KLO + off + 32 * KSTR + ks * 32);
          st1 = mfma32(al1, qfh[ks], st1); st1 = mfma32(ah1, qfl[ks], st1); st1 = mfma32(ah1, qfh[ks], st1);
        }
      }
#pragma unroll
      for (int r = 0; r < 16; ++r) {
        const int c = kh * 128 + s * 64 + (r & 3) + 8 * (r >> 2) + 4 * hh;
        st0[r] = ((16 * c + 31 <= token) && c < 255) ? st0[r] * QK_C1 : -1e30f;
        st1[r] = ((16 * (c + 32) + 31 <= token) && (c + 32) < 255) ? st1[r] * QK_C1 : -1e30f;
      }
      t4[s * 2 + 0] = st0; t4[s * 2 + 1] = st1;
    }
    __syncthreads();
  }
  float* ex = (float*)(g_smem + C_EX);
  float mx = -1e30f;
#pragma unroll
  for (int i = 0; i < 4; ++i)
#pragma unroll
    for (int r = 0; r < 16; ++r) mx = fmaxf(mx, t4[i][r]);
  mx = xmax32(mx);
  if (hh == 0) ex[(rg * 2 + kh) * 32 + l32] = mx;
  __syncthreads();
  const float mf = fmaxf(ex[(rg * 2 + 0) * 32 + l32], ex[(rg * 2 + 1) * 32 + l32]);
  float rs = 0.f;
#pragma unroll
  for (int i = 0; i < 4; ++i)
#pragma unroll
    for (int r = 0; r < 16; ++r) { const float t = t4[i][r]; const float pv = t > -1e29f ? fexp2(t - mf) : 0.f; t4[i][r] = pv; rs += pv; }
  rs = xsum32(rs);
  if (hh == 0) ex[256 + (rg * 2 + kh) * 32 + l32] = rs;
  __syncthreads();
  const float lt = ex[256 + (rg * 2 + 0) * 32 + l32] + ex[256 + (rg * 2 + 1) * 32 + l32];
  const float inv = lt > 0.f ? 1.f / lt : 0.f;
  float* Ap = (float*)(g_smem + C_K); float* Bp = Ap + 4 * 32 * 64;
#pragma unroll
  for (int i = 0; i < 4; ++i) {
#pragma unroll
    for (int r = 0; r < 16; ++r) t4[i][r] *= inv;
#pragma unroll
    for (int gq = 0; gq < 4; ++gq) {
      const int n = kh * 32 + (i >> 1) * 16 + (i & 1) * 8 + 2 * gq + hh;
      const float p0 = t4[i][gq * 4], p1 = t4[i][gq * 4 + 1], p2 = t4[i][gq * 4 + 2], p3 = t4[i][gq * 4 + 3];
      Ap[(rg * 32 + l32) * 64 + n] = 2.f * (p0 + p1 + p2) + p3;
      Bp[(rg * 32 + l32) * 64 + n] = p3;
    }
  }
  f32x16 o[4];
#pragma unroll
  for (int i = 0; i < 4; ++i) o[i] = zero16();
#pragma unroll
  for (int i = 0; i < 4; ++i) {
    const int keyb = kh * 128 + (i >> 1) * 64 + (i & 1) * 32;
    if (16 * keyb + 31 > qt * 32 + 31) continue;
    const bf16x8 pk0 = pack8(t4[i], 0), pk1 = pack8(t4[i], 1);
#pragma unroll
    for (int dblk = 0; dblk < 4; ++dblk) {
      const char* vp = g_smem + C_V + (dblk * 32 + l32) * CV_STR + (keyb + 4 * hh) * 2;
      o[dblk] = mfma32(ldv8(vp), pk0, o[dblk]);
      o[dblk] = mfma32(ldv8(vp + 32), pk1, o[dblk]);
    }
  }
  __syncthreads();
  float* X = (float*)(g_smem + C_V);
  if (kh == 1) {
#pragma unroll
    for (int i = 0; i < 4; ++i)
#pragma unroll
      for (int r = 0; r < 16; ++r) X[(rg * 64 + i * 16 + r) * 64 + lane] = o[i][r];
  }
  {
    const int n = lane;
#pragma unroll
    for (int i = 0; i < 4; ++i) {
      const int tok = wave * 4 + i, tk = qt * 32 + tok, cur = tk >> 6;
      float imp = 0.f;
#pragma unroll
      for (int r4 = 0; r4 < 4; ++r4) { imp += Ap[(r4 * 32 + tok) * 64 + n]; if (n > 0) imp += Bp[(r4 * 32 + tok) * 64 + n - 1]; }
      const bool causal = n <= cur, forced = n == 0 || n == cur || n == cur - 1;
      const float score = causal ? (forced ? 1e6f : imp) : -1e6f;
      int rank = 0;
#pragma unroll 4
      for (int j = 0; j < 64; ++j) { const float sj = __int_as_float(__builtin_amdgcn_readlane(__float_as_int(score), j)); rank += (sj > score || (sj == score && j < n)) ? 1 : 0; }
      const unsigned long long msk = __ballot(causal && rank < 16);
      if (lane == 0) ((unsigned long long*)(ws + OFF_SEL))[(size_t)bg * 4096 + tk] = msk;
    }
  }
  __syncthreads();
  float* Tt = (float*)(g_smem + C_K);
  if (kh == 0) {
    const float gt = ((const float*)(ws + OFF_GATES))[(size_t)(b * 4096 + token) * 24 + head * 3 + 0];
    float* trow = Tt + (rg * 32 + l32) * 132;
#pragma unroll
    for (int i = 0; i < 4; ++i)
#pragma unroll
      for (int gq = 0; gq < 4; ++gq) {
        f32x4 v;
#pragma unroll
        for (int j = 0; j < 4; ++j) v[j] = (o[i][gq * 4 + j] + X[(rg * 64 + i * 16 + gq * 4 + j) * 64 + lane]) * gt;
        *(f32x4*)(trow + i * 32 + 8 * gq + 4 * hh) = v;
      }
  }
  __syncthreads();
  if (!dry) {
    float* obase = (float*)(ws + OFF_ON32) + (size_t)b * 4096 * 1024;
#pragma unroll
    for (int k = 0; k < 8; ++k) {
      const int R = wave * 16 + k * 2 + (lane >> 5), rgr = R >> 5, rr = R & 31, c4 = (lane & 31) * 4;
      float* dp = obase + (size_t)(qt * 32 + rr) * 1024 + (g * 4 + rgr) * 128 + c4;
      *(f32x4*)dp = *(const f32x4*)dp + *(const f32x4*)(Tt + R * 132 + c4);
    }
  }
  __syncthreads();
}

DI void cumsum_job(const Params& p, int bh) {
  int tid = threadIdx.x; asm volatile("" : "+v"(tid));
  const int b = bh >> 3, h = bh & 7, wave = tid >> 6, lane = tid & 63;
  const float* lf = (const float*)(p.ws + OFF_LOGF) + (size_t)b * 4096 * 8 + h;
  float* cum = (float*)(p.ws + OFF_CUM) + (size_t)bh * 4096;
  float* wt = (float*)g_smem;
  float v[8]; float s = 0.f;
#pragma unroll
  for (int i = 0; i < 8; ++i) { s += lf[(size_t)(tid * 8 + i) * 8]; v[i] = s; }
  float inc = s;
#pragma unroll
  for (int o = 1; o < 64; o <<= 1) { const float t = __shfl_up(inc, o); if (lane >= o) inc += t; }
  if (lane == 63) wt[wave] = inc;
  __syncthreads();
  float base = inc - s;
  for (int w = 0; w < wave; ++w) base += wt[w];
#pragma unroll
  for (int i = 0; i < 8; ++i) cum[tid * 8 + i] = base + v[i];
  __syncthreads();
}

DI void knorm_job(const Params& p, int j) {
  int tid = threadIdx.x; asm volatile("" : "+v"(tid));
  const int pair = tid >> 1, half = tid & 1, tl = pair >> 3, h = pair & 7;
  const bf16_t* kp = (const bf16_t*)(p.ws + OFF_KF) + (size_t)(j * 32 + tl) * 1024 + h * 128 + half * 64;
  float ss = 0.f;
#pragma unroll
  for (int i = 0; i < 8; ++i) {
    const bf16x8 v = *(const bf16x8*)(kp + i * 8);
#pragma unroll
    for (int e = 0; e < 8; ++e) { const float f = bf2f((unsigned short)v[e]); ss += f * f; }
  }
  ss += __shfl_xor(ss, 1);
  float* nr = (float*)g_smem;
  if (half == 0) nr[pair] = ss;
  __syncthreads();
  if (tid < 8) {
    float m = 0.f;
    for (int t = 0; t < 32; ++t) m = fmaxf(m, nr[t * 8 + tid]);
    ((float*)(p.ws + OFF_KNORM))[((j >> 7) * 8 + tid) * 128 + (j & 127)] = m;
  }
  __syncthreads();
}
DI void gemm1_job(const Params& p, int j) {
  char* ws = p.ws;
  GemmOp g; g.lda = 2048; g.ldb = 4096;
  if (j < 64) {
    const int pm = j >> 4, split = j & 15;
    const bf16_t* ah = (const bf16_t*)(ws + OFF_KCIN_HI) + split * 256; const bf16_t* al = (const bf16_t*)(ws + OFF_KCIN_LO) + split * 256;
    const bf16_t* bh = (const bf16_t*)(ws + OFF_W1K_HI) + split * 256; const bf16_t* bl = (const bf16_t*)(ws + OFF_W1K_LO) + split * 256;
    g.A0 = ah; g.A1 = ah; g.A2 = al; g.B0 = bh; g.B1 = bl; g.B2 = bh; g.nt = 12; g.shift = 2;
    EpiF32 e{(float*)(ws + OFF_H1P_K) + (size_t)split * 1024 * 256, 256};
    gemm_tile(g, pm * 256, 0, e);
  } else {
    const int jj = j - 64, pm = jj >> 3, split = jj & 7;
    const bf16_t* ah = (const bf16_t*)(ws + OFF_VCIN) + split * 512; const bf16_t* bh = (const bf16_t*)(ws + OFF_W1V) + split * 512;
    g.A0 = g.A1 = g.A2 = ah; g.B0 = g.B1 = g.B2 = bh; g.nt = 8; g.shift = 3;
    EpiF32 e{(float*)(ws + OFF_H1P_V) + (size_t)split * 1024 * 256, 256};
    gemm_tile(g, pm * 256, 0, e);
  }
}

DI void gemm2_job(const Params& p, int j) {
  char* ws = p.ws;
  int tid = threadIdx.x; asm volatile("" : "+v"(tid));
  const bool isv = j >= 128; const int r0 = (j & 127) * 8;
  const float* part = (const float*)(ws + (isv ? OFF_H1P_V : OFF_H1P_K));
  const float* bias = (const float*)(ws + OFF_BIAS1) + (isv ? 16 * 256 : 0);
  const float* w2 = isv ? p.w_vc2 : p.w_kc2;
  float* hs = (float*)g_smem;
  float* w2s = hs + 2048;
  float* os = w2s;
  {
    const f32x4* w2v = (const f32x4*)w2;
#pragma unroll 16
    for (int i = 0; i < 16; ++i) ((f32x4*)w2s)[tid + i * 512] = w2v[tid + i * 512];
  }
  for (int idx = tid; idx < 2048; idx += 512) {
    const int row = idx >> 8, col = idx & 255;
    float s = 0.f;
#pragma unroll
    for (int c16 = 0; c16 < 16; ++c16) s += bias[c16 * 256 + col];
    const int nsp = isv ? 8 : 16;
    for (int sp = 0; sp < nsp; ++sp) s += part[((size_t)sp * 1024 + r0 + row) * 256 + col];
    hs[idx] = gelu_tanh(s);
  }
  __syncthreads();
  float a0 = 0.f, a1 = 0.f;
  {
    const int col = tid & 127, rp = tid >> 7;
#pragma unroll 8
    for (int k = 0; k < 256; ++k) { const float w = w2s[k * 128 + col]; a0 += hs[(rp * 2) * 256 + k] * w; a1 += hs[(rp * 2 + 1) * 256 + k] * w; }
  }
  __syncthreads();
  { const int col = tid & 127, rp = tid >> 7; os[(rp * 2) * 128 + col] = a0; os[(rp * 2 + 1) * 128 + col] = a1; }
  __syncthreads();
  if (!isv) {
    const int row = tid >> 6, i = tid & 63;
    const int rr = r0 + row, bg = rr >> 8, n = rr & 255;
    float y1 = 0.f, y2 = 0.f;
    if (n < 255) {
      const int tk = (bg >> 1) * 4096 + 16 * n + 31;
      const float cv = ((const float*)(ws + OFF_COS))[(size_t)tk * 64 + i], sv = ((const float*)(ws + OFF_SIN))[(size_t)tk * 64 + i];
      const float x1 = os[row * 128 + i], x2 = os[row * 128 + 64 + i];
      y1 = x1 * cv - x2 * sv; y2 = x2 * cv + x1 * sv;
    }
    bf16_t* kh_ = (bf16_t*)(ws + OFF_KC_HI) + (size_t)rr * 128; bf16_t* kl_ = (bf16_t*)(ws + OFF_KC_LO) + (size_t)rr * 128;
    kh_[i] = f2bf(y1); kh_[i + 64] = f2bf(y2); kl_[i] = f2bf(lo_of(y1)); kl_[i + 64] = f2bf(lo_of(y2));
  } else {
    for (int idx = tid; idx < 1024; idx += 512) {
      const int row = idx & 7, d = idx >> 3;
      const int rr = r0 + row, bg = rr >> 8, n = rr & 255;
      ((bf16_t*)(ws + OFF_VCT))[((size_t)bg * 128 + d) * 256 + n] = n < 255 ? f2bf(os[row * 128 + d]) : (bf16_t)0;
    }
  }
  __syncthreads();
}

DI void phase3(const Params& p) {
  FOR_JOBS(job, 96) gemm1_job(p, job);
  for (int job = (int)gridDim.x - 1 - (int)blockIdx.x; job < 16; job += gridDim.x) cumsum_job(p, job);
  for (int job = (int)gridDim.x - 1 - (int)blockIdx.x; job < 256; job += gridDim.x) knorm_job(p, job);
}
DI void phase4(const Params& p, bool dry) {
  if (!dry) { FOR_JOBS(job, 256) gemm2_job(p, job); }
  unsigned* qctr = (unsigned*)(p.ws + OFF_BAR) + (dry ? 3616 : 3600);
  volatile int* qslot = (volatile int*)(g_smem + 143360 - 32);
  for (;;) {
    if (threadIdx.x == 0) *qslot = (int)__hip_atomic_fetch_add(qctr, 1u, __ATOMIC_RELAXED, __HIP_MEMORY_SCOPE_AGENT);
    __syncthreads();
    const int u = *qslot;
    __syncthreads();
    if (u >= 1024) break;
    if (u < 512) { const int qt = 31 - (u >> 4), bh = u & 15; attn_unit<0>(p, bh >> 3, bh & 7, qt, dry); }
    else { const int v = u - 512; const int qt = 127 - (v >> 2), bg = v & 3; attn_unit<1>(p, bg >> 1, bg & 1, qt, dry); }
  }
}
DI void phase5(const Params& p, bool dry) {
  FOR_JOBS(job, 512) { const int qt = job >> 2, bg = job & 3; cmp_unit(p, bg >> 1, bg & 1, qt, dry); }
}
DI void phase6(const Params& p, bool dry) {
  unsigned* qctr = (unsigned*)(p.ws + OFF_BAR) + (dry ? 3648 : 3632);
  volatile int* qslot = (volatile int*)(g_smem + 143360 - 32);
  for (;;) {
    if (threadIdx.x == 0) *qslot = (int)__hip_atomic_fetch_add(qctr, 1u, __ATOMIC_RELAXED, __HIP_MEMORY_SCOPE_AGENT);
    __syncthreads();
    const int job = *qslot;
    __syncthreads();
    if (job >= 512) break;
    const int qt = 127 - (job >> 2), bg = job & 3; attn_unit<2>(p, bg >> 1, bg & 1, qt, dry);
  }
}

DI void outproj_phase(const Params& p) {
  char* ws = p.ws;
  FOR_JOBS(job, 256) {
    const int pn = job >> 5, pm = job & 31;
    GemmOp g; g.lda = 2048; g.ldb = 2048; g.nt = 32; g.shift = 5;
    g.A0 = g.A1 = g.A2 = (const bf16_t*)(ws + OFF_U_HI); g.B0 = g.B1 = g.B2 = (const bf16_t*)(ws + OFF_WOUT);
    EpiResid e{(float*)(ws + OFF_H1), p.x, (const float*)(ws + OFF_MOD) + 4096};
    gemm_tile(g, pm * 256, pn * 256, e);
  }
}
DI void gateup_phase(const Params& p) {
  char* ws = p.ws;
  FOR_JOBS(job, 44 * 32) {
    const int pn = job >> 5, pm = job & 31;
    GemmOp g; g.lda = 2048; g.ldb = 2048; g.nt = 32; g.shift = 5;
    g.A0 = g.A1 = g.A2 = (const bf16_t*)(ws + OFF_U_HI); g.B0 = g.B1 = g.B2 = (const bf16_t*)(ws + OFF_WGU);
    EpiSwiglu e{(bf16_t*)(ws + OFF_ACT)};
    gemm_tile(g, pm * 256, pn * 256, e);
  }
}
DI void down_phase(const Params& p) {
  char* ws = p.ws;
  FOR_JOBS(job, 256) {
    const int pn = job >> 5, pm = job & 31;
    GemmOp g; g.lda = DFF; g.ldb = DFF; g.nt = 88; g.shift = 20;
    g.A0 = g.A1 = g.A2 = (const bf16_t*)(ws + OFF_ACT); g.B0 = g.B1 = g.B2 = (const bf16_t*)(ws + OFF_WDN);
    EpiResid e{p.out, (const float*)(ws + OFF_H1), (const float*)(ws + OFF_MOD) + 10240};
    gemm_tile(g, pm * 256, pn * 256, e);
  }
}


#define XB_TMO      128
#define XB_XCNT(j)  (256  + 64 * (j))
#define XB_XSUB(j)  (1280 + 64 * (j))
#define XB_XGEN(j)  (2304 + 64 * (j))
#define XB_TOP      3328
#define XB_TOPGEN   3392
#define XCD_BAR_WORDS 3456
#define XB_SPIN_CAP (1u << 22)
#define LAS __attribute__((address_space(3)))
constexpr int LDS_BAR_OFF = 143360 - 16;
DI unsigned xb_ld(unsigned* p) { return __hip_atomic_load(p, __ATOMIC_RELAXED, __HIP_MEMORY_SCOPE_AGENT); }
DI unsigned xb_add(unsigned* p, unsigned v) { return __hip_atomic_fetch_add(p, v, __ATOMIC_RELAXED, __HIP_MEMORY_SCOPE_AGENT); }
DI unsigned xb_xcc_id() { return (unsigned)__builtin_amdgcn_s_getreg((3 << 11) | 20) & 0xFu; }
#define XB_SPIN(cond, bar) do { unsigned _sp = 0; while (cond) { __builtin_amdgcn_s_sleep(1); \
    if ((++_sp & 255u) == 0u) { if (xb_ld(&(bar)[XB_TMO])) break; if (_sp > XB_SPIN_CAP) { atomicAdd(&(bar)[XB_TMO], 1u); break; } } } } while (0)
struct XcdBarrier { unsigned* bar; unsigned x; volatile LAS unsigned* st; };
DI XcdBarrier xcd_barrier_post(unsigned* bar, volatile LAS unsigned* st) {
  XcdBarrier b; b.bar = bar; b.x = xb_xcc_id(); b.st = st;
  if (threadIdx.x == 0) (void)xb_add(&bar[XB_XCNT(b.x)], 1u);
  return b;
}
DI void xcd_barrier_complete(unsigned* bar, unsigned x, unsigned& nloc, unsigned& nx) {
  const unsigned G = gridDim.x * gridDim.y * gridDim.z;
  unsigned sum, cnt, mine, sp = 0u;
  for (;;) {
    sum = 0u; cnt = 0u; mine = 0u;
#pragma unroll
    for (unsigned j = 0; j < 16; ++j) { const unsigned c = xb_ld(&bar[XB_XCNT(j)]); sum += c; cnt += (c > 0u) ? 1u : 0u; mine = (j == x) ? c : mine; }
    if (sum == G) break;
    __builtin_amdgcn_s_sleep(1);
    if ((++sp & 255u) == 0u) { if (xb_ld(&bar[XB_TMO])) break; if (sp > XB_SPIN_CAP) { atomicAdd(&bar[XB_TMO], 1u); break; } }
  }
  nloc = mine > 0u ? mine : 1u; nx = cnt > 0u ? cnt : 1u;
}
DI void xcd_barrier(const XcdBarrier& b) {
  asm volatile("s_waitcnt vmcnt(0)" ::: "memory");
  __syncthreads();
  if (threadIdx.x == 0) {
    unsigned* bar = b.bar;
    __builtin_amdgcn_s_waitcnt(0);
    unsigned nloc = b.st[0], nx = b.st[1];
    if (nloc == 0u) { xcd_barrier_complete(bar, b.x, nloc, nx); b.st[0] = nloc; b.st[1] = nx; }
    const unsigned old = xb_add(&bar[XB_XSUB(b.x)], 1u);
    const unsigned gen = old / nloc;
    if (old + 1u == (gen + 1u) * nloc) {
      __builtin_amdgcn_fence(__ATOMIC_RELEASE, "agent");
      asm volatile("s_waitcnt vmcnt(0)" ::: "memory");
      const unsigned og = xb_add(&bar[XB_TOP], 1u);
      const unsigned tg = og / nx;
      if (og + 1u == (tg + 1u) * nx) xb_add(&bar[XB_TOPGEN], 1u);
      else XB_SPIN(xb_ld(&bar[XB_TOPGEN]) == tg, bar);
      __builtin_amdgcn_fence(__ATOMIC_ACQUIRE, "agent");
      xb_add(&bar[XB_XGEN(b.x)], 1u);
      asm volatile("s_waitcnt vmcnt(0)" ::: "memory");
    } else {
      XB_SPIN(xb_ld(&bar[XB_XGEN(b.x)]) == gen, bar);
      __builtin_amdgcn_fence(__ATOMIC_ACQUIRE, "agent");
      asm volatile("s_waitcnt vmcnt(0)" ::: "memory");
    }
  }
  __syncthreads();
}

#ifdef ONLY_PHASE
#define PH_ON(k) ((k) == ONLY_PHASE)
#else
#define PH_ON(k) 1
#endif
#ifndef REP_MASK
#define REP_MASK 0
#endif
#define RUN_PHASE(k, call) do { if (PH_ON(k) && ph0 <= (k) && (k) < ph1) { \
    _Pragma("unroll 1") for (int _r = 0; _r <= ((REP_MASK >> (k)) & 1); ++_r) { const bool _dry = ((REP_MASK >> (k)) & 1) && _r == 0; (void)_dry; if ((k) > ph0 || _r) GRID_SYNC(); call; } } } while (0)
#ifndef NSYNC_EXTRA
#define NSYNC_EXTRA 0
#endif
#define GRID_SYNC() xcd_barrier(xb)
__global__ void __launch_bounds__(512) hymba_mega(Params p, int ph0, int ph1) {
  volatile LAS unsigned* xst = (volatile LAS unsigned*)(g_smem + LDS_BAR_OFF);
  if (threadIdx.x == 0) { xst[0] = 0u; xst[1] = 0u; }
  __syncthreads();
  const XcdBarrier xb = xcd_barrier_post((unsigned*)(p.ws + OFF_BAR), xst);
  if (ph1 > 1000) cg::this_grid().sync();
  RUN_PHASE(0, phase0(p));
  RUN_PHASE(1, rmsmod_phase(p.x, p.norm_attn, (const float*)(p.ws + OFF_MOD), 0, 2048, (bf16_t*)(p.ws + OFF_U_HI), (bf16_t*)(p.ws + OFF_U_LO)));
  RUN_PHASE(2, inproj_phase(p, _dry));
  RUN_PHASE(3, phase3(p));
  RUN_PHASE(4, phase4(p, _dry));
  RUN_PHASE(5, phase5(p, _dry));
  RUN_PHASE(6, phase6(p, _dry));
  RUN_PHASE(7, ymix_phase(p));
  RUN_PHASE(8, outproj_phase(p));
  RUN_PHASE(9, rmsmod_phase((const float*)(p.ws + OFF_H1), p.norm_ffn, (const float*)(p.ws + OFF_MOD), 6144, 8192, (bf16_t*)(p.ws + OFF_U_HI), nullptr));
  RUN_PHASE(10, gateup_phase(p));
  RUN_PHASE(11, down_phase(p));
  RUN_PHASE(12, final_phase(p));
  _Pragma("unroll 1") for (int i = 0; i < NSYNC_EXTRA; ++i) GRID_SYNC();
}

extern "C" void kernel_launch(void* const* d_in, const int* in_sizes, int n_in, void* d_out, int out_size, void* d_ws, size_t ws_size,
                              hipStream_t stream) {
  Params p{};
  p.x = (const float*)d_in[0]; p.c = (const float*)d_in[1]; p.pos = (const int*)d_in[2];
  p.w_ada = (const float*)d_in[3]; p.b_ada = (const float*)d_in[4]; p.norm_attn = (const float*)d_in[5]; p.norm_ffn = (const float*)d_in[6];
  p.w_in = (const float*)d_in[7]; p.b_fgate = (const float*)d_in[8]; p.cmp_pos = (const float*)d_in[9];
  p.w_kc1 = (const float*)d_in[10]; p.w_kc2 = (const float*)d_in[11]; p.w_vc1 = (const float*)d_in[12]; p.w_vc2 = (const float*)d_in[13];
  p.beta_fox = (const float*)d_in[14]; p.beta_nsa = (const float*)d_in[15]; p.w_out = (const float*)d_in[16];
  p.w_gate = (const float*)d_in[17]; p.w_up = (const float*)d_in[18]; p.w_down = (const float*)d_in[19]; p.final_norm = (const float*)d_in[20];
  p.out = (float*)d_out; p.ws = (char*)d_ws;
  static int grid_blocks = 0;
  if (!grid_blocks) {
    hipFuncSetAttribute((const void*)hymba_mega, hipFuncAttributeMaxDynamicSharedMemorySize, LDS_BYTES);
    int dev = 0, cus = 0, per_cu = 0;
    hipGetDevice(&dev);
    hipDeviceGetAttribute(&cus, hipDeviceAttributeMultiprocessorCount, dev);
    hipOccupancyMaxActiveBlocksPerMultiprocessor(&per_cu, hymba_mega, 512, LDS_BYTES);
    if (per_cu < 1) per_cu = 1;
    grid_blocks = cus * per_cu;
    if (ws_size < WS_END) fprintf(stderr, "workspace too small: %zu < %zu\n", ws_size, (size_t)WS_END);
  }
  hipMemsetAsync((char*)d_ws + OFF_BAR, 0, 16384, stream);
#if N_LAUNCH_MODE == 1
  int ph0 = 0, ph1 = NPH;
  void* args[] = {&p, &ph0, &ph1};
  hipError_t e = hipLaunchCooperativeKernel((const void*)hymba_mega, dim3(grid_blocks), dim3(512), args, LDS_BYTES, stream);
  if (e != hipSuccess) fprintf(stderr, "cooperative launch failed: %s (grid %d)\n", hipGetErrorString(e), grid_blocks);
#else
  for (int ph = 0; ph < NPH; ++ph) hipLaunchKernelGGL(hymba_mega, dim3(grid_blocks), dim3(512), LDS_BYTES, stream, p, ph, ph + 1);
#endif
}
```

```cpp
#include <hip/hip_runtime.h>
#include <hip/hip_cooperative_groups.h>
#include <stdint.h>
#include <cstdio>
namespace cg = cooperative_groups;

#define DI __device__ __forceinline__
typedef unsigned short bf16_t;
typedef short bf16x8 __attribute__((ext_vector_type(8)));
typedef short s16x4 __attribute__((ext_vector_type(4)));
typedef float f32x4 __attribute__((ext_vector_type(4)));
typedef float f32x16 __attribute__((ext_vector_type(16)));
typedef unsigned u32x2 __attribute__((ext_vector_type(2)));
typedef unsigned u32x4 __attribute__((ext_vector_type(4)));

#ifndef DRY_MODE
#define DRY_MODE 0
#endif
#ifndef ATTN_PREFETCH
#define ATTN_PREFETCH 0
#endif
#ifndef N_LAUNCH_MODE
#define N_LAUNCH_MODE 1
#endif

constexpr int T_TOK = 8192, SEQ = 4096, DM = 2048, DFF = 5632, DIN = 5664;
constexpr int NPH = 13;
constexpr float LOG2E = 1.4426950408889634f;
constexpr float QK_C1 = 0.08838834764831845f * 1.4426950408889634f;

constexpr size_t al256(size_t x) { return (x + 255) & ~(size_t)255; }
constexpr size_t OFF_WIN_HI = 0;
constexpr size_t OFF_WIN_LO = OFF_WIN_HI + al256((size_t)5888 * 2048 * 2);
constexpr size_t OFF_WOUT = OFF_WIN_LO + al256((size_t)1280 * 2048 * 2);
constexpr size_t OFF_WGU = OFF_WOUT + al256((size_t)2048 * 2048 * 2);
constexpr size_t OFF_WDN = OFF_WGU + al256((size_t)11264 * 2048 * 2);
constexpr size_t OFF_W1K_HI = OFF_WDN + al256((size_t)2048 * 5632 * 2);
constexpr size_t OFF_W1K_LO = OFF_W1K_HI + al256((size_t)256 * 4096 * 2);
constexpr size_t OFF_W1V = OFF_W1K_LO + al256((size_t)256 * 4096 * 2);
constexpr size_t OFF_MOD = OFF_W1V + al256((size_t)256 * 4096 * 2);
constexpr size_t OFF_COS = OFF_MOD + al256((size_t)2 * 12288 * 4);
constexpr size_t OFF_SIN = OFF_COS + al256((size_t)8192 * 64 * 4);
constexpr size_t OFF_BIAS1 = OFF_SIN + al256((size_t)8192 * 64 * 4);
constexpr size_t OFF_U_HI = OFF_BIAS1 + al256((size_t)2 * 16 * 256 * 4);
constexpr size_t OFF_LOGF = OFF_U_HI + al256((size_t)8192 * 2048 * 2);
constexpr size_t OFF_CUM = OFF_LOGF + al256((size_t)8192 * 8 * 4);
constexpr size_t OFF_GATES = OFF_CUM + al256((size_t)16 * 4096 * 4);
constexpr size_t KCIN_BYTES = al256((size_t)(4 * 4096 + 64) * 128 * 2);
constexpr size_t OFF_KCIN_HI = OFF_GATES + al256((size_t)8192 * 24 * 4);
constexpr size_t OFF_KCIN_LO = OFF_KCIN_HI + KCIN_BYTES;
constexpr size_t OFF_VCIN = OFF_KCIN_LO + KCIN_BYTES;
constexpr size_t KV4_BYTES = (size_t)4 * 4096 * 128 * 2;
constexpr size_t OFF_KS = OFF_VCIN + KCIN_BYTES;
constexpr size_t OFF_VST = OFF_KS + KV4_BYTES;
constexpr size_t OFF_KW = OFF_VST + KV4_BYTES;
constexpr size_t OFF_VWT = OFF_KW + KV4_BYTES;
constexpr size_t OFF_H1P_K = OFF_VWT + KV4_BYTES;
constexpr size_t OFF_H1P_V = OFF_H1P_K + (size_t)16 * 1024 * 256 * 4;
constexpr size_t OFF_KC_HI = OFF_H1P_V + (size_t)8 * 1024 * 256 * 4;
constexpr size_t OFF_KC_LO = OFF_KC_HI + (size_t)4 * 256 * 128 * 2;
constexpr size_t OFF_VCT = OFF_KC_LO + (size_t)4 * 256 * 128 * 2;
constexpr size_t OFF_SEL = OFF_VCT + (size_t)4 * 256 * 128 * 2;
constexpr size_t OFF_OF32 = OFF_SEL + (size_t)4 * 4096 * 8;
constexpr size_t OFF_ON32 = OFF_OF32 + (size_t)8192 * 1024 * 4;
constexpr size_t OFF_H1 = OFF_OF32;
constexpr size_t OFF_RA = OFF_ON32 + (size_t)8192 * 1024 * 4;
constexpr size_t OFF_U_LO = OFF_RA;
constexpr size_t OFF_QF = OFF_U_LO + (size_t)8192 * 2048 * 2;
constexpr size_t OFF_KF = OFF_QF + (size_t)8192 * 1024 * 2;
constexpr size_t OFF_VFT = OFF_KF + (size_t)8192 * 1024 * 2;
constexpr size_t OFF_QN_HI = OFF_VFT + (size_t)8192 * 1024 * 2;
constexpr size_t OFF_QN_LO = OFF_QN_HI + (size_t)8192 * 1024 * 2;
constexpr size_t OFF_ACT = OFF_RA;
constexpr size_t OFF_KNORM = OFF_QN_LO + (size_t)8192 * 1024 * 2;
constexpr size_t OFF_BAR = OFF_KNORM + 8192;
constexpr size_t WS_END = OFF_BAR + 16384;

struct Params {
  const float *x, *c; const int* pos;
  const float *w_ada, *b_ada, *norm_attn, *norm_ffn, *w_in, *b_fgate, *cmp_pos, *w_kc1, *w_kc2, *w_vc1, *w_vc2,
      *beta_fox, *beta_nsa, *w_out, *w_gate, *w_up, *w_down, *final_norm;
  float* out; char* ws;
};

extern __shared__ __attribute__((aligned(16))) char g_smem[];
constexpr int LDS_BYTES = 143360;

__device__ const float c_inv_freq[64] = {
1.000000000e+00f,8.659643531e-01f,7.498942614e-01f,6.493816376e-01f,5.623413324e-01f,4.869675338e-01f,4.216965139e-01f,3.651741147e-01f,3.162277639e-01f,2.738419771e-01f,2.371373773e-01f,2.053525001e-01f,1.778279394e-01f,1.539926529e-01f,1.333521307e-01f,1.154782027e-01f,1.000000015e-01f,8.659642935e-02f,7.498941571e-02f,6.493816525e-02f,5.623413250e-02f,4.869675264e-02f,4.216965288e-02f,3.651741147e-02f,3.162277490e-02f,2.738419734e-02f,2.371373773e-02f,2.053525113e-02f,1.778279431e-02f,1.539926510e-02f,1.333521493e-02f,1.154782064e-02f,9.999999776e-03f,8.659643121e-03f,7.498941850e-03f,6.493816152e-03f,5.623413250e-03f,4.869675264e-03f,4.216964822e-03f,3.651741194e-03f,3.162277630e-03f,2.738419687e-03f,2.371373586e-03f,2.053524833e-03f,1.778279431e-03f,1.539926510e-03f,1.333521446e-03f,1.154781901e-03f,1.000000047e-03f,8.659643354e-04f,7.498942432e-04f,6.493816618e-04f,5.623413017e-04f,4.869675322e-04f,4.216965172e-04f,3.651741426e-04f,3.162277571e-04f,2.738419571e-04f,2.371373703e-04f,2.053525095e-04f,1.778279402e-04f,1.539926452e-04f,1.333521504e-04f,1.154782003e-04f};

DI unsigned short f2bf(float x) { unsigned u = __float_as_uint(x); u += 0x7fffu + ((u >> 16) & 1u); return (unsigned short)(u >> 16); }
DI float bf2f(unsigned short h) { return __uint_as_float(((unsigned)h) << 16); }
typedef float f32x2 __attribute__((ext_vector_type(2)));
typedef __bf16 bf16v2 __attribute__((ext_vector_type(2)));
DI unsigned pack2(float a, float b) { const f32x2 v = {a, b}; return __builtin_bit_cast(unsigned, __builtin_convertvector(v, bf16v2)); }
DI void split2(float a, float b, unsigned& hi, unsigned& lo) {
  hi = pack2(a, b);
  lo = pack2(a - __uint_as_float(hi << 16), b - __uint_as_float(hi & 0xffff0000u));
}
DI float lo_of(float x) { return x - bf2f(f2bf(x)); }
DI float wave_sum(float v) {
#pragma unroll
  for (int o = 32; o > 0; o >>= 1) v += __shfl_xor(v, o);
  return v;
}
DI float xmax32(float v) { auto r = __builtin_amdgcn_permlane32_swap(__float_as_uint(v), __float_as_uint(v), false, false); return fmaxf(__uint_as_float(r[0]), __uint_as_float(r[1])); }
DI float xsum32(float v) { auto r = __builtin_amdgcn_permlane32_swap(__float_as_uint(v), __float_as_uint(v), false, false); return __uint_as_float(r[0]) + __uint_as_float(r[1]); }
DI float fexp2(float x) { return __builtin_amdgcn_exp2f(x); }
DI float sigmoidf_(float x) { return 1.f / (1.f + __expf(-x)); }
DI float siluf_(float x) { return x / (1.f + __expf(-x)); }
DI float silu_fast(float x) { return x * __builtin_amdgcn_rcpf(1.f + __builtin_amdgcn_exp2f(-LOG2E * x)); }
DI float gelu_tanh(float x) { float u = 0.7978845608028654f * (x + 0.044715f * x * x * x); float e = __expf(2.f * u); float t = 1.f - 2.f / (e + 1.f); return 0.5f * x * (1.f + t); }
DI float log_sigmoid(float x) { return fminf(x, 0.f) - log1pf(__expf(-fabsf(x))); }
DI f32x16 mfma32(bf16x8 a, bf16x8 b, f32x16 c) { return __builtin_amdgcn_mfma_f32_32x32x16_bf16(a, b, c, 0, 0, 0); }
DI f32x16 zero16() { f32x16 z;
#pragma unroll
  for (int i = 0; i < 16; ++i) z[i] = 0.f; return z; }
DI int perm_gu(int w) { const int r = w & 31; return (w & 96) + ((r >> 2) & 1) * 16 + (r >> 3) * 4 + (r & 3); }
DI int perm256(int w) { const int hl = (w >> 7) & 1, d = w & 127, bj = d >> 6, q = (d & 63) >> 3, n = (d >> 2) & 1, j = d & 3; return bj * 128 + (hl * 2 + (q >> 2)) * 32 + n * 16 + (q & 3) * 4 + j; }
DI int perm128(int d) { return ((d >> 4) & 3) * 32 + (d >> 6) * 16 + (d & 15); }

#define FOR_JOBS(job, njobs) \
  for (int _r = 0, job; _r * (int)gridDim.x < (njobs); ++_r) \
    if ((job = _r * (int)gridDim.x + ((_r & 1) ? ((int)gridDim.x - 1 - (int)blockIdx.x) : (int)blockIdx.x)) < (njobs))

constexpr int BM = 256, BK = 64, HALF = 128, HTB = HALF * BK * 2;
DI int lds_byte(int r, int c) { int st = (r >> 4) * 2 + (c >> 5), rr = r & 15, cc = c & 31, ob = rr * 64 + cc * 2; return st * 1024 + (ob ^ (((ob >> 9) & 1) << 5)); }
DI void stage_rc(int b, int& R, int& C) { int st = b / 1024, sb = b % 1024, swz = sb ^ (((sb >> 9) & 1) << 5); R = (st >> 1) * 16 + swz / 64; C = (st & 1) * 32 + (swz % 64) / 2; }

DI const char* uptr(const char* p) {
  const unsigned long long v = (unsigned long long)p;
  const unsigned lo = __builtin_amdgcn_readfirstlane((unsigned)v), hi = __builtin_amdgcn_readfirstlane((unsigned)(v >> 32));
  return (const char*)(((unsigned long long)hi << 32) | lo);
}
struct GemmOp { const bf16_t *A0, *A1, *A2, *B0, *B1, *B2; int lda, ldb, nt, shift; };

template <class Epi>
DI void gemm_tile(const GemmOp& g, int brow, int bcol, const Epi& epi) {
#define SA(b, h) (g_smem + ((b) * 2 + (h)) * HTB)
#define SB(b, h) (g_smem + (4 + (b) * 2 + (h)) * HTB)
  int tid = threadIdx.x; asm volatile("" : "+v"(tid));
  const int wid = tid >> 6, lane = tid & 63, wr = wid >> 2, wc = wid & 3, fr = lane & 15, fq = lane >> 4;
  int r0, c0, r1, c1; stage_rc(tid * 16, r0, c0); stage_rc(tid * 16 + 8192, r1, c1);
  const unsigned oa0 = (unsigned)(r0 * g.lda + c0) * 2u, oa1 = (unsigned)(r1 * g.lda + c1) * 2u, ob0 = (unsigned)(r0 * g.ldb + c0) * 2u, ob1 = (unsigned)(r1 * g.ldb + c1) * 2u;
  const int mask = (1 << g.shift) - 1;
#define STAGE_A(P, half, kt) do { const int _s = (kt) >> g.shift; const char* _b = uptr((const char*)((_s == 0 ? g.A0 : (_s == 1 ? g.A1 : g.A2)) + (size_t)(brow + (half) * HALF) * g.lda + (size_t)((kt) & mask) * BK)); \
    __builtin_amdgcn_global_load_lds((const unsigned*)(_b + oa0), (unsigned*)((P) + tid * 16), 16, 0, 0); \
    __builtin_amdgcn_global_load_lds((const unsigned*)(_b + oa1), (unsigned*)((P) + tid * 16 + 8192), 16, 0, 0); } while (0)
#define STAGE_B(P, half, kt) do { const int _s = (kt) >> g.shift; const char* _b = uptr((const char*)((_s == 0 ? g.B0 : (_s == 1 ? g.B1 : g.B2)) + (size_t)(bcol + (half) * HALF) * g.ldb + (size_t)((kt) & mask) * BK)); \
    __builtin_amdgcn_global_load_lds((const unsigned*)(_b + ob0), (unsigned*)((P) + tid * 16), 16, 0, 0); \
    __builtin_amdgcn_global_load_lds((const unsigned*)(_b + ob1), (unsigned*)((P) + tid * 16 + 8192), 16, 0, 0); } while (0)
#define LDA(dst, b, h) for (int m = 0; m < 4; ++m) for (int k = 0; k < 2; ++k) \
    dst[m][k] = *reinterpret_cast<const bf16x8*>(SA(b, h) + lds_byte(wr * 64 + m * 16 + fr, k * 32 + fq * 8))
#define LDB(dst, b, h) for (int n = 0; n < 2; ++n) for (int k = 0; k < 2; ++k) \
    dst[n][k] = *reinterpret_cast<const bf16x8*>(SB(b, h) + lds_byte(wc * 32 + n * 16 + fr, k * 32 + fq * 8))
#define MMA(ai, bj, At_, Bt_) do { __builtin_amdgcn_s_setprio(1); \
    for (int m = 0; m < 4; ++m) for (int n = 0; n < 2; ++n) for (int k = 0; k < 2; ++k) \
      acc[ai][bj][m][n] = __builtin_amdgcn_mfma_f32_16x16x32_bf16(Bt_[n][k], At_[m][k], acc[ai][bj][m][n], 0, 0, 0); \
    __builtin_amdgcn_s_setprio(0); } while (0)
#define WAIT_V(n) asm volatile("s_waitcnt vmcnt(" #n ")" ::: "memory")
#define WAIT_L(n) asm volatile("s_waitcnt lgkmcnt(" #n ")" ::: "memory")
#define BAR __builtin_amdgcn_s_barrier()
#define SCHED __builtin_amdgcn_sched_barrier(0)
  f32x4 acc[2][2][4][2] = {};
  bf16x8 At[4][2], B0[2][2], B1[2][2];
  const int nt = g.nt;
  STAGE_B(SB(0, 0), 0, 0); STAGE_A(SA(0, 0), 0, 0);
  STAGE_B(SB(0, 1), 1, 0); STAGE_A(SA(0, 1), 1, 0);
  if (wr == 1) BAR;
  WAIT_V(4); BAR;
  STAGE_B(SB(1, 0), 0, 1); STAGE_A(SA(1, 0), 0, 1); STAGE_B(SB(1, 1), 1, 1);
  WAIT_V(6); BAR;
  for (int t = 0; t < nt - 2; t += 2) {
    LDB(B0, 0, 0); SCHED; LDA(At, 0, 0); STAGE_A(SA(1, 1), 1, t + 1);
    WAIT_L(8); BAR; WAIT_L(0); MMA(0, 0, At, B0); BAR; SCHED;
    LDB(B1, 0, 1); STAGE_B(SB(0, 0), 0, t + 2);
    BAR; WAIT_L(0); MMA(0, 1, At, B1); BAR;
    LDA(At, 0, 1); STAGE_A(SA(0, 0), 0, t + 2);
    BAR; WAIT_L(0); MMA(1, 0, At, B0); BAR; SCHED;
    STAGE_B(SB(0, 1), 1, t + 2);
    WAIT_V(6); BAR; MMA(1, 1, At, B1); BAR;
    LDB(B0, 1, 0); SCHED; LDA(At, 1, 0); STAGE_A(SA(0, 1), 1, t + 2);
    WAIT_L(8); BAR; WAIT_L(0); MMA(0, 0, At, B0); BAR; SCHED;
    LDB(B1, 1, 1); STAGE_B(SB(1, 0), 0, t + 3);
    BAR; WAIT_L(0); MMA(0, 1, At, B1); BAR;
    LDA(At, 1, 1); STAGE_A(SA(1, 0), 0, t + 3);
    BAR; WAIT_L(0); MMA(1, 0, At, B0); BAR; SCHED;
    STAGE_B(SB(1, 1), 1, t + 3);
    WAIT_V(6); BAR; MMA(1, 1, At, B1); BAR;
  }
  { LDB(B0, 0, 0); LDA(At, 0, 0); STAGE_A(SA(1, 1), 1, nt - 1);
    BAR; WAIT_L(0); MMA(0, 0, At, B0); BAR;
    LDB(B1, 0, 1); BAR; WAIT_L(0); MMA(0, 1, At, B1); BAR;
    LDA(At, 0, 1); WAIT_V(4); BAR; WAIT_L(0); MMA(1, 0, At, B0); MMA(1, 1, At, B1); BAR; }
  { LDB(B0, 1, 0); LDA(At, 1, 0); WAIT_V(2); BAR; WAIT_L(0); MMA(0, 0, At, B0); BAR;
    LDB(B1, 1, 1); WAIT_V(0); BAR; WAIT_L(0); MMA(0, 1, At, B1); BAR;
    LDA(At, 1, 1); BAR; WAIT_L(0); MMA(1, 0, At, B0); MMA(1, 1, At, B1); BAR; }
  if (wr == 0) BAR;
  { int t2 = tid; asm volatile("" : "+v"(t2)); const int w2 = t2 >> 6, l2 = t2 & 63; epi(acc, brow, bcol, w2 >> 2, w2 & 3, l2 & 15, l2 >> 4); }
  __syncthreads();
#undef SA
#undef SB
}

typedef f32x4 AccT[2][2][4][2];

struct EpiInproj {
  const Params* p; int pn;
  DI void operator()(const AccT& acc, int brow, int bcol, int wr, int wc, int fr, int fq) const {
    char* ws = p->ws;
    const float* cs = (const float*)(ws + OFF_COS); const float* sn = (const float*)(ws + OFF_SIN);
    const int hl = wc >> 1, dlo = ((wc & 1) * 4 + fq) * 8;
    const bool rope = (pn >= 12 && pn < 16) || pn == 18 || pn == 20;
#pragma unroll
    for (int ai = 0; ai < 2; ++ai)
#pragma unroll
      for (int m = 0; m < 4; ++m) {
        const int token = brow + ai * 128 + wr * 64 + m * 16 + fr;
        const int b = token >> 12, s = token & 4095;
        f32x4 a0 = acc[ai][0][m][0], a1 = acc[ai][0][m][1], b0 = acc[ai][1][m][0], b1 = acc[ai][1][m][1];
        if (rope) {
          const f32x4 c0 = *(const f32x4*)(cs + (size_t)token * 64 + dlo), c1 = *(const f32x4*)(cs + (size_t)token * 64 + dlo + 4);
          const f32x4 s0 = *(const f32x4*)(sn + (size_t)token * 64 + dlo), s1 = *(const f32x4*)(sn + (size_t)token * 64 + dlo + 4);
          const f32x4 y0 = a0 * c0 - b0 * s0, y1 = a1 * c1 - b1 * s1, z0 = b0 * c0 + a0 * s0, z1 = b1 * c1 + a1 * s1;
          a0 = y0; a1 = y1; b0 = z0; b1 = z1;
        }
        unsigned h[8], l[8];
        split2(a0[0], a0[1], h[0], l[0]); split2(a0[2], a0[3], h[1], l[1]); split2(a1[0], a1[1], h[2], l[2]); split2(a1[2], a1[3], h[3], l[3]);
        split2(b0[0], b0[1], h[4], l[4]); split2(b0[2], b0[3], h[5], l[5]); split2(b1[0], b1[1], h[6], l[6]); split2(b1[2], b1[3], h[7], l[7]);
        size_t o; size_t off_hi; size_t off_lo = 0; bool has_lo = false;
        if (pn < 8) { o = (size_t)token * 1024 + ((pn & 3) * 2 + hl) * 128 + dlo; off_hi = pn < 4 ? OFF_QF : OFF_KF; }
        else if (pn < 16) { o = (size_t)token * 1024 + ((pn - 12) * 2 + hl) * 128 + dlo; off_hi = OFF_QN_HI; off_lo = OFF_QN_LO; has_lo = true; }
        else {
          o = ((size_t)(b * 2 + hl) * 4096 + s) * 128 + dlo;
          off_hi = pn == 16 ? OFF_KCIN_HI : (pn == 17 ? OFF_VCIN : (pn == 18 ? OFF_KS : OFF_KW));
          if (pn == 16) { off_lo = OFF_KCIN_LO; has_lo = true; }
        }
        bf16_t* dh = (bf16_t*)(ws + off_hi) + o;
        *(u32x4*)dh = (u32x4){h[0], h[1], h[2], h[3]};
        *(u32x4*)(dh + 64) = (u32x4){h[4], h[5], h[6], h[7]};
        if (has_lo) {
          bf16_t* dl = (bf16_t*)(ws + off_lo) + o;
          *(u32x4*)dl = (u32x4){l[0], l[1], l[2], l[3]};
          *(u32x4*)(dl + 64) = (u32x4){l[4], l[5], l[6], l[7]};
        }
      }
  }
};

struct EpiVT {
  bf16_t* dst; int nheads; int sec_row0;
  DI void operator()(const AccT& acc, int brow, int bcol, int wr, int wc, int fr, int fq) const {
#pragma unroll
    for (int ai = 0; ai < 2; ++ai)
#pragma unroll
      for (int m = 0; m < 4; ++m) {
        const int vr = brow - sec_row0 + ai * 128 + wr * 64 + m * 16 + fr;
        const int head = vr >> 7, d = vr & 127;
#pragma unroll
        for (int bj = 0; bj < 2; ++bj)
#pragma unroll
          for (int n = 0; n < 2; ++n) {
            const int tk = bcol + bj * 128 + wc * 32 + n * 16 + fq * 4;
            const int b = tk >> 12, s = tk & 4095;
            const f32x4 v = acc[ai][bj][m][n];
            *(u32x2*)(dst + ((size_t)(b * nheads + head) * 128 + d) * 4096 + s) = (u32x2){pack2(v[0], v[1]), pack2(v[2], v[3])};
          }
      }
  }
};

struct EpiF32 {
  float* dst; int ld;
  DI void operator()(const AccT& acc, int brow, int bcol, int wr, int wc, int fr, int fq) const {
#pragma unroll
    for (int ai = 0; ai < 2; ++ai)
#pragma unroll
      for (int m = 0; m < 4; ++m) {
        const int row = brow + ai * 128 + wr * 64 + m * 16 + fr;
#pragma unroll
        for (int bj = 0; bj < 2; ++bj)
#pragma unroll
          for (int n = 0; n < 2; ++n)
            *(f32x4*)(dst + (size_t)row * ld + bcol + bj * 128 + wc * 32 + n * 16 + fq * 4) = acc[ai][bj][m][n];
      }
  }
};

struct EpiResid {
  float* dst; const float* base; const float* gate;
  DI void operator()(const AccT& acc, int brow, int bcol, int wr, int wc, int fr, int fq) const {
#pragma unroll
    for (int ai = 0; ai < 2; ++ai)
#pragma unroll
      for (int m = 0; m < 4; ++m) {
        const int row = brow + ai * 128 + wr * 64 + m * 16 + fr;
        const int b = row >> 12;
#pragma unroll
        for (int bj = 0; bj < 2; ++bj)
#pragma unroll
          for (int n = 0; n < 2; ++n) {
            const int col = bcol + bj * 128 + wc * 32 + n * 16 + fq * 4;
            const f32x4 xv = __builtin_nontemporal_load((const f32x4*)(base + (size_t)row * 2048 + col));
            const f32x4 gv = *(const f32x4*)(gate + b * 12288 + col);
            *(f32x4*)(dst + (size_t)row * 2048 + col) = xv + gv * acc[ai][bj][m][n];
          }
      }
  }
};

struct EpiSwiglu {
  bf16_t* act;
  DI void operator()(const AccT& acc, int brow, int bcol, int wr, int wc, int fr, int fq) const {
    const int pn = bcol >> 8;
#pragma unroll
    for (int ai = 0; ai < 2; ++ai)
#pragma unroll
      for (int m = 0; m < 4; ++m) {
        const int row = brow + ai * 128 + wr * 64 + m * 16 + fr;
        float r[8];
#pragma unroll
        for (int n = 0; n < 2; ++n) {
          const f32x4 gt = acc[ai][0][m][n], up = acc[ai][1][m][n];
#pragma unroll
          for (int j = 0; j < 4; ++j) r[n * 4 + j] = silu_fast(gt[j]) * up[j];
        }
        *(u32x4*)(act + (size_t)row * DFF + pn * 128 + wc * 32 + fq * 8) = (u32x4){pack2(r[0], r[1]), pack2(r[2], r[3]), pack2(r[4], r[5]), pack2(r[6], r[7])};
      }
  }
};

DI int map_win(int c, int& lo_row) {
  lo_row = -1;
  if (c < 2048) return (c & ~255) + perm256(c & 255);
  if (c < 3072) return c;
  if (c < 3080) return 5632 + (c - 3072);
  if (c < 4104) { int cc = c - 3080; int d = 3072 + (cc & ~255) + perm256(cc & 255); lo_row = d - 3072; return d; }
  if (c < 4360) { int cc = c - 4104; int d = 4096 + perm256(cc); lo_row = d - 3072; return d; }
  if (c < 4616) { int cc = c - 4360; return 4352 + perm256(cc); }
  if (c < 4872) { int cc = c - 4616; return 4608 + perm256(cc); }
  if (c < 5128) return 4864 + (c - 4872);
  if (c < 5384) { int cc = c - 5128; return 5120 + perm256(cc); }
  if (c < 5640) return 5376 + (c - 5384);
  return c;
}

struct TInfo { const float* src; bf16_t* dh; bf16_t* dl; int N, Kd, mat, k0, n0; };
constexpr int TJ_WIN = 16 * 89, TJ_WOUT = 16 * 32, TJ_WG = 16 * 88, TJ_WD = 44 * 32, TJ_W1 = 32 * 4;
constexpr int TE0 = TJ_WIN, TE1 = TE0 + TJ_WOUT, TE2 = TE1 + TJ_WG, TE3 = TE2 + TJ_WG, TE4 = TE3 + TJ_WD, TE5 = TE4 + TJ_W1, TE6 = TE5 + TJ_W1;
DI void tile_info(const Params& p, int t, TInfo& ti) {
  char* ws = p.ws; ti.dl = nullptr; int nn;
  if (t < TE0) { ti.mat = 0; ti.src = p.w_in; ti.N = DIN; ti.Kd = 2048; ti.dh = (bf16_t*)(ws + OFF_WIN_HI); ti.dl = (bf16_t*)(ws + OFF_WIN_LO); nn = 89; }
  else if (t < TE1) { t -= TE0; ti.mat = 1; ti.src = p.w_out; ti.N = 2048; ti.Kd = 2048; ti.dh = (bf16_t*)(ws + OFF_WOUT); nn = 32; }
  else if (t < TE2) { t -= TE1; ti.mat = 2; ti.src = p.w_gate; ti.N = DFF; ti.Kd = 2048; ti.dh = (bf16_t*)(ws + OFF_WGU); nn = 88; }
  else if (t < TE3) { t -= TE2; ti.mat = 3; ti.src = p.w_up; ti.N = DFF; ti.Kd = 2048; ti.dh = (bf16_t*)(ws + OFF_WGU); nn = 88; }
  else if (t < TE4) { t -= TE3; ti.mat = 4; ti.src = p.w_down; ti.N = 2048; ti.Kd = DFF; ti.dh = (bf16_t*)(ws + OFF_WDN); nn = 32; }
  else if (t < TE5) { t -= TE4; ti.mat = 5; ti.src = p.w_kc1; ti.N = 256; ti.Kd = 4096; ti.dh = (bf16_t*)(ws + OFF_W1K_HI); ti.dl = (bf16_t*)(ws + OFF_W1K_LO); nn = 4; }
  else { t -= TE5; ti.mat = 6; ti.src = p.w_vc1; ti.N = 256; ti.Kd = 4096; ti.dh = (bf16_t*)(ws + OFF_W1V); nn = 4; }
  ti.k0 = (t / nn) * 128; ti.n0 = (t % nn) * 64;
}
DI void tr_load(const TInfo& ti, int tid, f32x4 (&r)[4]) {
#pragma unroll
  for (int i = 0; i < 4; ++i) {
    const int idx = tid + i * 512, k = idx >> 4, col = ti.n0 + (idx & 15) * 4;
    r[i] = col < ti.N ? __builtin_nontemporal_load((const f32x4*)(ti.src + (size_t)(ti.k0 + k) * ti.N + col)) : (f32x4){0.f, 0.f, 0.f, 0.f};
  }
}
DI void tr_lds_write(float* tile, int tid, const f32x4 (&r)[4]) {
#pragma unroll
  for (int i = 0; i < 4; ++i) {
    const int idx = tid + i * 512, k = idx >> 4, c = (idx & 15) * 4;
#pragma unroll
    for (int j = 0; j < 4; ++j) tile[k * 65 + c + j] = r[i][j];
  }
}
DI void tr_store(const TInfo& ti, const float* tile, int tid) {
#pragma unroll
  for (int i = 0; i < 2; ++i) {
    const int idx = tid + i * 512, nr = idx >> 4, kc = idx & 15, col = ti.n0 + nr;
    if (col < ti.N) {
      int row, lrow = -1;
      if (ti.mat == 0) row = map_win(col, lrow);
      else if (ti.mat == 2) row = (col >> 7) * 256 + perm_gu(col & 127);
      else if (ti.mat == 3) row = (col >> 7) * 256 + 128 + perm_gu(col & 127);
      else { row = col; if (ti.mat == 5) lrow = col; }
      float v[8];
#pragma unroll
      for (int e = 0; e < 8; ++e) v[e] = tile[(kc * 8 + e) * 65 + nr];
      const u32x4 hv = (u32x4){pack2(v[0], v[1]), pack2(v[2], v[3]), pack2(v[4], v[5]), pack2(v[6], v[7])};
      if (ti.mat >= 2 && ti.mat <= 4) __builtin_nontemporal_store(hv, (u32x4*)(ti.dh + (size_t)row * ti.Kd + ti.k0 + kc * 8));
      else *(u32x4*)(ti.dh + (size_t)row * ti.Kd + ti.k0 + kc * 8) = hv;
      if (lrow >= 0)
        *(u32x4*)(ti.dl + (size_t)lrow * ti.Kd + ti.k0 + kc * 8) = (u32x4){pack2(lo_of(v[0]), lo_of(v[1])), pack2(lo_of(v[2]), lo_of(v[3])), pack2(lo_of(v[4]), lo_of(v[5])), pack2(lo_of(v[6]), lo_of(v[7]))};
    }
  }
}
DI void transpose_all(const Params& p) {
  float* lds = (float*)g_smem;
  int tid = threadIdx.x; asm volatile("" : "+v"(tid));
  const int G = gridDim.x;
  int t0 = blockIdx.x, t1 = t0 + G;
  TInfo ia, ib; f32x4 ra[4], rb[4];
  if (t0 < TE6) { tile_info(p, t0, ia); tr_load(ia, tid, ra); }
  if (t1 < TE6) { tile_info(p, t1, ib); tr_load(ib, tid, rb); }
  while (t0 < TE6) {
    tr_lds_write(lds, tid, ra);
    __syncthreads();
    const TInfo cura = ia;
    const int t2 = t0 + 2 * G;
    if (t2 < TE6) { tile_info(p, t2, ia); tr_load(ia, tid, ra); }
    tr_store(cura, lds, tid);
    if (t1 >= TE6) break;
    tr_lds_write(lds + 128 * 65, tid, rb);
    __syncthreads();
    const TInfo curb = ib;
    const int t3 = t1 + 2 * G;
    if (t3 < TE6) { tile_info(p, t3, ib); tr_load(ib, tid, rb); }
    tr_store(curb, lds + 128 * 65, tid);
    t0 = t2; t1 = t3;
  }
  __syncthreads();
}

DI void mod_job(const Params& p, int job) {
  float* sc = (float*)g_smem;
  float* red = sc + 4096;
  const int tid = threadIdx.x, wave = tid >> 6, lane = tid & 63;
  for (int i = tid; i < 4096; i += 512) sc[i] = siluf_(p.c[i]);
  __syncthreads();
  const int n0 = job * 64, cgp = lane & 15, kr = lane >> 4;
  f32x4 a0 = {0.f, 0.f, 0.f, 0.f}, a1 = {0.f, 0.f, 0.f, 0.f};
#pragma unroll 8
  for (int k = wave * 4 + kr; k < 2048; k += 32) {
    const f32x4 wv = __builtin_nontemporal_load((const f32x4*)(p.w_ada + (size_t)k * 12288 + n0 + cgp * 4));
    a0 += wv * sc[k]; a1 += wv * sc[2048 + k];
  }
#pragma unroll
  for (int j = 0; j < 4; ++j) {
    a0[j] += __shfl_xor(a0[j], 16); a0[j] += __shfl_xor(a0[j], 32);
    a1[j] += __shfl_xor(a1[j], 16); a1[j] += __shfl_xor(a1[j], 32);
  }
  if (kr == 0) {
#pragma unroll
    for (int j = 0; j < 4; ++j) { red[(wave * 2 + 0) * 64 + cgp * 4 + j] = a0[j]; red[(wave * 2 + 1) * 64 + cgp * 4 + j] = a1[j]; }
  }
  __syncthreads();
  if (tid < 128) {
    const int b = tid >> 6, col = tid & 63;
    float s = p.b_ada[n0 + col];
#pragma unroll
    for (int w = 0; w < 8; ++w) s += red[(w * 2 + b) * 64 + col];
    ((float*)(p.ws + OFF_MOD))[b * 12288 + n0 + col] = s;
  }
  __syncthreads();
}

DI void bias1_job(const Params& p, int j) {
  const int which = j >> 4, chunk = j & 15;
  const float* w1 = which ? p.w_vc1 : p.w_kc1;
  float* red = (float*)g_smem;
  const int tid = threadIdx.x, col = tid & 255, half = tid >> 8;
  float s = 0.f;
  const int kb = chunk * 256 + half * 128;
#pragma unroll 16
  for (int k = kb; k < kb + 128; ++k) s += p.cmp_pos[k] * w1[(size_t)k * 256 + col];
  red[tid] = s;
  __syncthreads();
  if (tid < 256) ((float*)(p.ws + OFF_BIAS1))[(which * 16 + chunk) * 256 + tid] = red[tid] + red[tid + 256];
  __syncthreads();
}

DI void rope_job(const Params& p, int job) {
  const int idx = job * 512 + threadIdx.x, token = idx >> 6, i = idx & 63;
  const float ang = (float)p.pos[token] * c_inv_freq[i];
  double t = (double)ang * 0.15915494309189535;
  t -= floor(t + 0.5);
  const float tf = (float)t;
  ((float*)(p.ws + OFF_COS))[idx] = __builtin_amdgcn_cosf(tf);
  ((float*)(p.ws + OFF_SIN))[idx] = __builtin_amdgcn_sinf(tf);
}

DI void phase0(const Params& p) {
  transpose_all(p);
  constexpr int J_MOD = 192, J_B1 = 32, J_ROPE = 1024;
  for (int job = blockIdx.x; job < J_MOD + J_B1 + J_ROPE; job += gridDim.x) {
    if (job < J_MOD) mod_job(p, job);
    else if (job < J_MOD + J_B1) bias1_job(p, job - J_MOD);
    else rope_job(p, job - J_MOD - J_B1);
  }
}

DI void rmsmod_phase(const float* src, const float* g, const float* mod, int sh_off, int sc_off, bf16_t* dhi, bf16_t* dlo, bool nt_src) {
  const int wave = threadIdx.x >> 6, lane = threadIdx.x & 63;
  for (int row = blockIdx.x * 8 + wave; row < T_TOK; row += gridDim.x * 8) {
    const int b = row >> 12;
    const f32x4* xr = (const f32x4*)(src + (size_t)row * 2048);
    f32x4 v[8]; float ss = 0.f;
#pragma unroll
    for (int i = 0; i < 8; ++i) { v[i] = nt_src ? __builtin_nontemporal_load(xr + lane + i * 64) : xr[lane + i * 64]; ss += v[i][0] * v[i][0] + v[i][1] * v[i][1] + v[i][2] * v[i][2] + v[i][3] * v[i][3]; }
    ss = wave_sum(ss);
    const float rstd = rsqrtf(ss * (1.f / 2048.f) + 1e-6f);
#pragma unroll
    for (int i = 0; i < 8; ++i) {
      const int col = (lane + i * 64) * 4;
      const f32x4 gv = *(const f32x4*)(g + col);
      const f32x4 sc = *(const f32x4*)(mod + b * 12288 + sc_off + col), sh = *(const f32x4*)(mod + b * 12288 + sh_off + col);
      f32x4 u = (v[i] * rstd) * gv; u = u * (1.f + sc) + sh;
      unsigned h0, h1, l0, l1; split2(u[0], u[1], h0, l0); split2(u[2], u[3], h1, l1);
      *(u32x2*)(dhi + (size_t)row * 2048 + col) = (u32x2){h0, h1};
      if (dlo) *(u32x2*)(dlo + (size_t)row * 2048 + col) = (u32x2){l0, l1};
    }
  }
}

DI void ymix_phase(const Params& p) {
  const int wave = threadIdx.x >> 6, lane = threadIdx.x & 63;
  bf16_t* ym = (bf16_t*)(p.ws + OFF_U_HI);
  for (int row = blockIdx.x * 8 + wave; row < T_TOK; row += gridDim.x * 8) {
#pragma unroll
    for (int part = 0; part < 2; ++part) {
      const f32x4* xr = (const f32x4*)((const float*)(p.ws + (part ? OFF_ON32 : OFF_OF32)) + (size_t)row * 1024);
      const float* beta = part ? p.beta_nsa : p.beta_fox;
      f32x4 v[4]; float ss = 0.f;
#pragma unroll
      for (int i = 0; i < 4; ++i) { v[i] = __builtin_nontemporal_load(xr + lane + i * 64); ss += v[i][0] * v[i][0] + v[i][1] * v[i][1] + v[i][2] * v[i][2] + v[i][3] * v[i][3]; }
      ss = wave_sum(ss);
      const float rstd = rsqrtf(ss * (1.f / 1024.f) + 1e-6f);
#pragma unroll
      for (int i = 0; i < 4; ++i) {
        const int col = (lane + i * 64) * 4;
        const f32x4 u = (v[i] * rstd) * *(const f32x4*)(beta + col);
        *(u32x2*)(ym + (size_t)row * 2048 + part * 1024 + col) = (u32x2){pack2(u[0], u[1]), pack2(u[2], u[3])};
      }
    }
  }
}

DI void final_phase(const Params& p) {
  const int wave = threadIdx.x >> 6, lane = threadIdx.x & 63;
  for (int row = blockIdx.x * 8 + wave; row < T_TOK; row += gridDim.x * 8) {
    f32x4* xr = (f32x4*)(p.out + (size_t)row * 2048);
    f32x4 v[8]; float ss = 0.f;
#pragma unroll
    for (int i = 0; i < 8; ++i) { v[i] = __builtin_nontemporal_load(xr + lane + i * 64); ss += v[i][0] * v[i][0] + v[i][1] * v[i][1] + v[i][2] * v[i][2] + v[i][3] * v[i][3]; }
    ss = wave_sum(ss);
    const float rstd = rsqrtf(ss * (1.f / 2048.f) + 1e-6f);
#pragma unroll
    for (int i = 0; i < 8; ++i) __builtin_nontemporal_store((v[i] * rstd) * *(const f32x4*)(p.final_norm + (lane + i * 64) * 4), xr + lane + i * 64);
  }
}

typedef float f32x4_ __attribute__((ext_vector_type(4)));
DI void misc_job(const Params& p, int piece) {
  char* ws = p.ws;
  int tid = threadIdx.x; asm volatile("" : "+v"(tid));
  const int wave = tid >> 6, lane = tid & 63, fr = lane & 15, fq = lane >> 4;
  const bf16_t* A = (const bf16_t*)(ws + OFF_U_HI) + (size_t)(piece * 32 + fr) * 2048 + fq * 8 + wave * 256;
  const bf16_t* B = (const bf16_t*)(ws + OFF_WIN_HI) + (size_t)(5632 + fr) * 2048 + fq * 8 + wave * 256;
  f32x4 acc[2][2] = {};
#pragma unroll
  for (int k = 0; k < 8; ++k) {
    const bf16x8 a0 = *(const bf16x8*)(A + k * 32), a1 = *(const bf16x8*)(A + 16 * 2048 + k * 32);
    const bf16x8 b0 = *(const bf16x8*)(B + k * 32), b1 = *(const bf16x8*)(B + 16 * 2048 + k * 32);
    acc[0][0] = __builtin_amdgcn_mfma_f32_16x16x32_bf16(a0, b0, acc[0][0], 0, 0, 0);
    acc[0][1] = __builtin_amdgcn_mfma_f32_16x16x32_bf16(a0, b1, acc[0][1], 0, 0, 0);
    acc[1][0] = __builtin_amdgcn_mfma_f32_16x16x32_bf16(a1, b0, acc[1][0], 0, 0, 0);
    acc[1][1] = __builtin_amdgcn_mfma_f32_16x16x32_bf16(a1, b1, acc[1][1], 0, 0, 0);
  }
  f32x4* red = (f32x4*)g_smem;
#pragma unroll
  for (int q = 0; q < 4; ++q) red[(wave * 4 + q) * 64 + lane] = acc[q >> 1][q & 1];
  __syncthreads();
  if (tid < 256) {
    const int q = tid >> 6, l = tid & 63, mb = q >> 1, nb = q & 1, fr2 = l & 15, fq2 = l >> 4;
    f32x4 sum = red[q * 64 + l];
#pragma unroll
    for (int w = 1; w < 8; ++w) sum += red[(w * 4 + q) * 64 + l];
    const int col = nb * 16 + fr2;
#pragma unroll
    for (int j = 0; j < 4; ++j) {
      const int token = piece * 32 + mb * 16 + fq2 * 4 + j;
      if (col < 8) ((float*)(ws + OFF_LOGF))[token * 8 + col] = log_sigmoid(sum[j] + p.b_fgate[col]);
      else ((float*)(ws + OFF_GATES))[token * 24 + col - 8] = sigmoidf_(sum[j]);
    }
  }
  __syncthreads();
}
DI void inproj_heavy(const Params& p, int job) {
  char* ws = p.ws;
  const bf16_t* uhi = (const bf16_t*)(ws + OFF_U_HI); const bf16_t* ulo = (const bf16_t*)(ws + OFF_U_LO);
  const bf16_t* whi = (const bf16_t*)(ws + OFF_WIN_HI); const bf16_t* wlo = (const bf16_t*)(ws + OFF_WIN_LO);
  const int pn = 12 + job / 32, pm = job % 32;
  GemmOp g; g.lda = 2048; g.ldb = 2048;
  g.A0 = uhi; g.A1 = uhi; g.A2 = ulo; g.B0 = whi; g.B1 = wlo - (size_t)3072 * 2048; g.B2 = whi; g.nt = 96; g.shift = 5;
  EpiInproj e{&p, pn};
  gemm_tile(g, pm * 256, pn * 256, e);
}
DI void inproj_light(const Params& p, int L) {
  char* ws = p.ws;
  const bf16_t* uhi = (const bf16_t*)(ws + OFF_U_HI); const bf16_t* whi = (const bf16_t*)(ws + OFF_WIN_HI);
  GemmOp g; g.lda = 2048; g.ldb = 2048; g.nt = 32; g.shift = 5;
  if (L < 352) {
    const int t = L / 32, pm = L % 32;
    const int pn = t < 8 ? t : (t == 8 ? 17 : (t == 9 ? 18 : 20));
    g.A0 = g.A1 = g.A2 = uhi; g.B0 = g.B1 = g.B2 = whi;
    EpiInproj e{&p, pn};
    gemm_tile(g, pm * 256, pn * 256, e);
  } else {
    const int j = L - 352, rt = j / 32, tt = j % 32;
    int wrow; bf16_t* dst; int nh, sec0;
    if (rt < 4) { wrow = 2048 + rt * 256; dst = (bf16_t*)(ws + OFF_VFT); nh = 8; sec0 = 2048; }
    else if (rt == 4) { wrow = 4864; dst = (bf16_t*)(ws + OFF_VST); nh = 2; sec0 = 4864; }
    else { wrow = 5376; dst = (bf16_t*)(ws + OFF_VWT); nh = 2; sec0 = 5376; }
    g.A0 = g.A1 = g.A2 = whi; g.B0 = g.B1 = g.B2 = uhi;
    EpiVT e{dst, nh, sec0};
    gemm_tile(g, wrow, tt * 256, e);
  }
}
DI void inproj_phase(const Params& p, bool dry) {
  if (gridDim.x == 256) {
    const int c = blockIdx.x;
    if (c < 160) { inproj_heavy(p, c); inproj_light(p, c); }
    else { for (int i = 0; i < 4; ++i) inproj_light(p, 160 + (c - 160) * 4 + i); }
    if (!dry) misc_job(p, c);
  } else {
    FOR_JOBS(job, 160) inproj_heavy(p, job);
    FOR_JOBS(job, 544) inproj_light(p, job);
    FOR_JOBS(job, 256) misc_job(p, job);
  }
}

constexpr int KSTR = 272, VSTR = 264;
constexpr int ST_K = 0, ST_V = 128 * KSTR, ST_C = ST_V + 128 * VSTR, ST_SIZE = ST_C + 512;
constexpr int LDS_LIST = 2 * ST_SIZE;

DI bf16x8 pack8(const f32x16& x, int s) {
  u32x4 r;
  r[0] = pack2(x[8 * s + 0], x[8 * s + 1]); r[1] = pack2(x[8 * s + 2], x[8 * s + 3]);
  r[2] = pack2(x[8 * s + 4], x[8 * s + 5]); r[3] = pack2(x[8 * s + 6], x[8 * s + 7]);
  return __builtin_bit_cast(bf16x8, r);
}
DI bf16x8 ldv8(const char* p) {
  const u32x2 a = *(const u32x2*)p, b = *(const u32x2*)(p + 16);
  u32x4 r = {a[0], a[1], b[0], b[1]};
  return __builtin_bit_cast(bf16x8, r);
}

constexpr int AS_K = 0, AS_V = 32768, AS_C = 65536, AS_SIZE = 66048;
constexpr int LDS_LIST2 = 2 * AS_SIZE;
DI int pi23(int r) { return (r & ~12) | ((r & 4) << 1) | ((r & 8) >> 1); }
template <int MODE>
DI void attn_unit(const Params& p, int b, int hg, int qt, bool dry = false) {
  char* ws = p.ws;
  int tid = threadIdx.x; asm volatile("" : "+v"(tid));
  const int wave = tid >> 6, lane = tid & 63, l32 = lane & 31, hh = lane >> 5, rg = wave & 3, kh = wave >> 2;
  int token, head; const bf16_t *qrow, *kbase, *vbase; int kstride;
  if (MODE == 0) {
    token = qt * 128 + rg * 32 + l32; head = hg;
    qrow = (const bf16_t*)(ws + OFF_QF) + (size_t)(b * 4096 + token) * 1024 + head * 128;
    kbase = (const bf16_t*)(ws + OFF_KF) + (size_t)b * 4096 * 1024 + head * 128; kstride = 1024;
    vbase = (const bf16_t*)(ws + OFF_VFT) + (size_t)(b * 8 + head) * 128 * 4096;
  } else {
    if (MODE == 1) { token = qt * 32 + l32; head = hg * 4 + rg; }
    else { token = qt * 32 + rg * 8 + (l32 >> 2); head = hg * 4 + (l32 & 3); }
    qrow = (const bf16_t*)(ws + OFF_QN_HI) + (size_t)(b * 4096 + token) * 1024 + head * 128;
    kbase = (const bf16_t*)(ws + (MODE == 1 ? OFF_KW : OFF_KS)) + (size_t)(b * 2 + hg) * 4096 * 128; kstride = 128;
    vbase = (const bf16_t*)(ws + (MODE == 1 ? OFF_VWT : OFF_VST)) + (size_t)(b * 2 + hg) * 128 * 4096;
  }
  const int wtmin = MODE == 0 ? qt * 128 + rg * 32 : (MODE == 1 ? qt * 32 : qt * 32 + rg * 8), wtmax = wtmin + (MODE == 2 ? 7 : 31);
  int nst, kv_start = 0;
  int* list = (int*)(g_smem + LDS_LIST2);
  unsigned long long selmask = 0;
  if (MODE == 0) nst = qt + 1;
  else if (MODE == 1) { int lo = qt * 32 - 511; if (lo < 0) lo = 0; kv_start = lo & ~63; nst = (qt * 32 + 32 - kv_start + 127) >> 7; }
  else {
    const unsigned long long* sel = (const unsigned long long*)(ws + OFF_SEL) + (size_t)(b * 2 + hg) * 4096;
    selmask = sel[token];
    if (wave == 0) {
      const unsigned long long sm0 = sel[qt * 32 + l32];
      unsigned lo = (unsigned)sm0, hi = (unsigned)(sm0 >> 32);
#pragma unroll
      for (int o = 16; o > 0; o >>= 1) { lo |= __shfl_xor(lo, o); hi |= __shfl_xor(hi, o); }
      const unsigned long long um = ((unsigned long long)hi << 32) | lo;
      if ((um >> lane) & 1ull) list[1 + __popcll(um & ((1ull << lane) - 1ull))] = lane;
      if (lane == 0) list[0] = __popcll(um);
    }
    __syncthreads();
    nst = (list[0] + 1) >> 1;
  }
  bf16x8 qf[8];
#pragma unroll
  for (int ks = 0; ks < 8; ++ks) qf[ks] = *(const bf16x8*)(qrow + ks * 16 + hh * 8);
  float cumq = 0.f;
  const float* cumrow = nullptr;
  if (MODE == 0) { cumrow = (const float*)(ws + OFF_CUM) + (size_t)(b * 8 + head) * 4096; cumq = cumrow[token]; }

  f32x16 o[4];
#pragma unroll
  for (int i = 0; i < 4; ++i) o[i] = zero16();
  float mrun = -1e30f, lrun = 0.f;

  auto tile_base = [&](int it, int half) -> int {
    if (MODE == 2) { const int i = 2 * it + half; return i < list[0] ? list[1 + i] * 64 : -1; }
    return kv_start + it * 128 + half * 64;
  };
  const int rsub = lane >> 4, slot = lane & 15;
  unsigned koff[4], voff[4]; bool vhalf[4];
#pragma unroll
  for (int j = 0; j < 4; ++j) {
    const int row = (j * 8 + wave) * 4 + rsub;
    const int c = slot ^ (row & 15);
    koff[j] = (unsigned)(pi23(row & 63) * kstride + c * 8) * 2u;
    vhalf[j] = (c >> 3) != 0;
    voff[j] = MODE == 2 ? (unsigned)(row * 4096 + (c & 7) * 8) * 2u : (unsigned)(row * 4096 + c * 8) * 2u;
  }
  auto issue_stage = [&](int it, int buf) {
    if (DRY_MODE == 2 && dry) return;
    int kb0 = tile_base(it, 0), kb1 = tile_base(it, 1);
    if (kb1 < 0) kb1 = 0;
    char* sb = g_smem + buf * AS_SIZE;
    const char* kp0 = uptr((const char*)(kbase + (size_t)kb0 * kstride));
    const char* kp1 = uptr((const char*)(kbase + (size_t)kb1 * kstride));
    const char* vp0 = uptr((const char*)(vbase + kb0));
    const char* vp1 = uptr((const char*)(vbase + kb1));
#pragma unroll
    for (int j = 0; j < 4; ++j) {
      __builtin_amdgcn_global_load_lds((const unsigned*)((j >> 1 ? kp1 : kp0) + koff[j]), (unsigned*)(sb + AS_K + (j * 8 + wave) * 1024 + lane * 16), 16, 0, 0);
      const char* vsrc = MODE == 2 ? ((vhalf[j] ? vp1 : vp0) + voff[j]) : (vp0 + voff[j]);
      __builtin_amdgcn_global_load_lds((const unsigned*)vsrc, (unsigned*)(sb + AS_V + (j * 8 + wave) * 1024 + lane * 16), 16, 0, 0);
    }
    if (MODE == 0 && wave < 2) {
      const int key = (wave ? kb1 : kb0) + lane;
      __builtin_amdgcn_global_load_lds((const unsigned*)(cumrow + key), (unsigned*)(sb + AS_C + wave * 256 + lane * 4), 4, 0, 0);
    }
  };

  int it0 = 0;
  if (MODE == 0) {
    float q2 = 0.f;
#pragma unroll
    for (int ks = 0; ks < 8; ++ks)
#pragma unroll
      for (int e = 0; e < 8; ++e) { const float f = bf2f((unsigned short)qf[ks][e]); q2 += f * f; }
    q2 = xsum32(q2);
#pragma unroll
    for (int o2 = 16; o2 > 0; o2 >>= 1) q2 = fmaxf(q2, __shfl_xor(q2, o2));
    const float* kn = (const float*)(ws + OFF_KNORM) + (size_t)(b * 8 + head) * 128;
    float k2 = fmaxf(kn[lane], kn[lane + 64]);
#pragma unroll
    for (int o2 = 32; o2 > 0; o2 >>= 1) k2 = fmaxf(k2, __shfl_xor(k2, o2));
    float* qx = (float*)(g_smem + LDS_LIST2);
    if (lane == 0) qx[wave] = q2;
    __syncthreads();
    const float q2m = fmaxf(fmaxf(qx[0], qx[1]), fmaxf(qx[2], qx[3]));
    const float xub = sqrtf(q2m * k2) * (QK_C1 * 1.001f) + 0.01f;
    const float cend = lane < qt ? cumrow[lane * 128 + 127] : cumrow[qt * 128];
    const float bub = (cumrow[qt * 128] - cend) * LOG2E;
    const bool skip = lane < qt && (2.f * xub + bub < -160.f);
    const unsigned long long sk = __ballot(skip);
    it0 = (int)__builtin_ctzll(~sk);
    if (it0 > qt) it0 = qt;
    it0 = __builtin_amdgcn_readfirstlane(it0);
  }
#pragma unroll
  for (int ks = 0; ks < 8; ++ks) asm volatile("" :: "v"(qf[ks]));
  asm volatile("" :: "v"(cumq));
  issue_stage(it0, it0 & 1);
  for (int it = it0; it < nst; ++it) {
    asm volatile("s_waitcnt vmcnt(0)" ::: "memory");
    __builtin_amdgcn_s_barrier();
    if (it + 1 < nst) issue_stage(it + 1, (it + 1) & 1);
    const char* sb = g_smem + (it & 1) * AS_SIZE;
    const int kbh = tile_base(it, kh);
    bool active;
    if (MODE == 0) active = kbh <= wtmax;
    else if (MODE == 1) active = kbh <= wtmax && kbh + 63 >= wtmin - 511;
    else active = kbh >= 0;
    if (DRY_MODE == 1 && dry) active = false;
    const bool selbit = (MODE == 2 && kbh >= 0) ? ((selmask >> (kbh >> 6)) & 1ull) != 0 : true;
    if (MODE == 2) active = active && __any(selbit);
    if (active) {
      f32x16 stA = zero16(), stB = zero16();
      {
        const int row = kh * 64 + l32;
        const char* kp = sb + AS_K + row * 256;
        const int sw = row & 15;
#pragma unroll
        for (int ks = 0; ks < 8; ++ks) stA = mfma32(*(const bf16x8*)(kp + (((ks * 2 + hh) ^ sw) << 4)), qf[ks], stA);
#pragma unroll
        for (int ks = 0; ks < 8; ++ks) stB = mfma32(*(const bf16x8*)(kp + 32 * 256 + (((ks * 2 + hh) ^ sw) << 4)), qf[ks], stB);
      }
      const int tq0 = token - kbh - hh * 8;
      bf16x8 pk0, pk1;
#define ATTN_SOFTMAX(ST, KB2) do { \
        const int kmin = kbh + (KB2) * 32, kmax = kmin + 31; \
        if (MODE == 0) { \
          f32x16 cs16; \
          _Pragma("unroll") for (int gq = 0; gq < 4; ++gq) { \
            const f32x4 cs = *(const f32x4*)(sb + AS_C + (kh * 64 + (KB2) * 32 + (gq >> 1) * 16 + hh * 8 + (gq & 1) * 4) * 4); \
            cs16[gq * 4] = cs[0]; cs16[gq * 4 + 1] = cs[1]; cs16[gq * 4 + 2] = cs[2]; cs16[gq * 4 + 3] = cs[3]; } \
          ST = ST * QK_C1 + (cs16 * (-LOG2E) + cumq * LOG2E); \
        } else ST = ST * QK_C1; \
        bool need_mask; \
        if (MODE == 0) need_mask = kmax > wtmin; \
        else if (MODE == 1) need_mask = kmax > wtmin || wtmax - kmin >= 512; \
        else need_mask = (kbh >> 6) == (wtmin >> 6); \
        if (need_mask) { \
          _Pragma("unroll") for (int gq = 0; gq < 4; ++gq) _Pragma("unroll") for (int j = 0; j < 4; ++j) { \
            const int kofs = (KB2) * 32 + (gq >> 1) * 16 + (gq & 1) * 4 + j; \
            bool valid = kofs <= tq0; \
            if (MODE == 1) valid = valid && (tq0 - kofs < 512); \
            ST[gq * 4 + j] = valid ? ST[gq * 4 + j] : -1e30f; } } \
        float mx = ST[0]; \
        _Pragma("unroll") for (int r = 1; r < 16; ++r) mx = fmaxf(mx, ST[r]); \
        mx = xmax32(mx); \
        if (MODE == 2) mx = selbit ? mx : -1e30f; \
        const float mnew = (mx > mrun + 8.f) ? mx : mrun;        \
        if (__any(mnew != mrun)) { \
          const float alpha = fexp2(mrun - mnew); \
          lrun *= alpha; \
          _Pragma("unroll") for (int i = 0; i < 4; ++i) o[i] = o[i] * alpha; } \
        mrun = mnew; \
        const float msub = (mnew > -1e29f && selbit) ? mnew : 1e30f; \
        ST = ST - msub; \
        float rs = 0.f; \
        _Pragma("unroll") for (int r = 0; r < 16; ++r) { ST[r] = fexp2(ST[r]); rs += ST[r]; } \
        rs = xsum32(rs); \
        lrun += rs; \
        pk0 = pack8(ST, 0); pk1 = pack8(ST, 1); } while (0)
#define ATTN_PV(KB2) do { \
        _Pragma("unroll") for (int dblk = 0; dblk < 4; ++dblk) { \
          const int d = dblk * 32 + l32; \
          const char* vp = sb + AS_V + d * 256; \
          const int sw = d & 15; \
          o[dblk] = mfma32(*(const bf16x8*)(vp + (((kh * 8 + (KB2) * 4 + hh) ^ sw) << 4)), pk0, o[dblk]); \
          o[dblk] = mfma32(*(const bf16x8*)(vp + (((kh * 8 + (KB2) * 4 + 2 + hh) ^ sw) << 4)), pk1, o[dblk]); } } while (0)
      ATTN_SOFTMAX(stA, 0);
      ATTN_PV(0);
      ATTN_SOFTMAX(stB, 1);
      ATTN_PV(1);
#undef ATTN_SOFTMAX
#undef ATTN_PV
    }
  }
  __syncthreads();
  float* X = (float*)g_smem;
  if (kh == 1) {
#pragma unroll
    for (int i = 0; i < 4; ++i)
#pragma unroll
      for (int r = 0; r < 16; ++r) X[(rg * 66 + i * 16 + r) * 64 + lane] = o[i][r];
    X[(rg * 66 + 64) * 64 + lane] = mrun; X[(rg * 66 + 65) * 64 + lane] = lrun;
  }
  __syncthreads();
  float* Tt = (float*)(g_smem + 67584);
  if (kh == 0) {
    const float m1 = X[(rg * 66 + 64) * 64 + lane], l1 = X[(rg * 66 + 65) * 64 + lane];
    const float mf = fmaxf(mrun, m1);
    const float a0 = fexp2(mrun - mf), a1 = fexp2(m1 - mf);
    const float lt = lrun * a0 + l1 * a1;
    float inv = lt > 0.f ? 1.f / lt : 0.f;
    if (MODE != 0) inv *= ((const float*)(ws + OFF_GATES))[(size_t)(b * 4096 + token) * 24 + head * 3 + (MODE == 1 ? 2 : 1)];
    const float s0 = a0 * inv, s1 = a1 * inv;
    float* trow = Tt + (rg * 32 + l32) * 132;
#pragma unroll
    for (int i = 0; i < 4; ++i)
#pragma unroll
      for (int gq = 0; gq < 4; ++gq) {
        f32x4 v;
#pragma unroll
        for (int j = 0; j < 4; ++j) v[j] = o[i][gq * 4 + j] * s0 + X[(rg * 66 + i * 16 + gq * 4 + j) * 64 + lane] * s1;
        *(f32x4*)(trow + i * 32 + 8 * gq + 4 * hh) = v;
      }
  }
  __syncthreads();
  if (!dry) {
    float* obase = (float*)(ws + (MODE == 0 ? OFF_OF32 : OFF_ON32)) + (size_t)b * 4096 * 1024;
#pragma unroll
    for (int k = 0; k < 8; ++k) {
      const int R = wave * 16 + k * 2 + (lane >> 5), rgr = R >> 5, rr = R & 31, c4 = (lane & 31) * 4;
      int tk, hd;
      if (MODE == 0) { tk = qt * 128 + rgr * 32 + rr; hd = hg; }
      else if (MODE == 1) { tk = qt * 32 + rr; hd = hg * 4 + rgr; }
      else { tk = qt * 32 + rgr * 8 + (rr >> 2); hd = hg * 4 + (rr & 3); }
      float* dp = obase + (size_t)tk * 1024 + hd * 128 + c4;
      f32x4 v = *(const f32x4*)(Tt + R * 132 + c4);
      if (MODE == 2) v += *(const f32x4*)dp;
      *(f32x4*)dp = v;
    }
  }
  __syncthreads();
}

constexpr int CV_STR = 520;
constexpr int C_V = 0, C_K = 128 * CV_STR  , C_KLO = C_K + 128 * KSTR, C_EX = C_KLO + 128 * KSTR  ;
DI void cmp_unit(const Params& p, int b, int g, int qt, bool dry = false) {
  char* ws = p.ws;
  int tid = threadIdx.x; asm volatile("" : "+v"(tid));
  const int wave = tid >> 6, lane = tid & 63, l32 = lane & 31, hh = lane >> 5, rg = wave & 3, kh = wave >> 2;
  const int token = qt * 32 + l32, head = g * 4 + rg, bg = b * 2 + g;
  const bf16_t* qh = (const bf16_t*)(ws + OFF_QN_HI) + (size_t)(b * 4096 + token) * 1024 + head * 128;
  const bf16_t* ql = (const bf16_t*)(ws + OFF_QN_LO) + (size_t)(b * 4096 + token) * 1024 + head * 128;
  const bf16_t* kch = (const bf16_t*)(ws + OFF_KC_HI) + (size_t)bg * 256 * 128;
  const bf16_t* kcl = (const bf16_t*)(ws + OFF_KC_LO) + (size_t)bg * 256 * 128;
  const bf16_t* vct = (const bf16_t*)(ws + OFF_VCT) + (size_t)bg * 128 * 256;
  bf16x8 qfh[8], qfl[8];
#pragma unroll
  for (int ks = 0; ks < 8; ++ks) { qfh[ks] = *(const bf16x8*)(qh + ks * 16 + hh * 8); qfl[ks] = *(const bf16x8*)(ql + ks * 16 + hh * 8); }
#pragma unroll
  for (int i = 0; i < 8; ++i) {
    const int c = tid + i * 512, d = c >> 5, cc = c & 31;
    const u32x4 v = *(const u32x4*)(vct + (size_t)d * 256 + cc * 8);
    char* vd = g_smem + C_V + d * CV_STR + cc * 16;
    *(u32x2*)vd = (u32x2){v[0], v[1]}; *(u32x2*)(vd + 8) = (u32x2){v[2], v[3]};
  }
  f32x16 t4[4];
#pragma unroll
  for (int s = 0; s < 2; ++s) {
#pragma unroll
    for (int i = 0; i < 4; ++i) {
      const int c = tid + i * 512, rr = c >> 4, cc = c & 15;
      const int key = (rr >> 6) * 128 + s * 64 + (rr & 63);
      *(u32x4*)(g_smem + C_K + rr * KSTR + cc * 16) = *(const u32x4*)(kch + (size_t)key * 128 + cc * 8);
      *(u32x4*)(g_smem + C_KLO + rr * KSTR + cc * 16) = *(const u32x4*)(kcl + (size_t)key * 128 + cc * 8);
    }
    __syncthreads();
    {
      f32x16 st0 = zero16(), st1 = zero16();
      const int off = (kh * 64 + l32) * KSTR + hh * 16;
      const int tmaxu = qt * 32 + 31;
      const bool act0 = 16 * (kh * 128 + s * 64) + 31 <= tmaxu, act1 = 16 * (kh * 128 + s * 64 + 32) + 31 <= tmaxu;
      if (act0) {
#pragma unroll
        for (int ks = 0; ks < 8; ++ks) {
          const bf16x8 ah0 = *(const bf16x8*)(g_smem + C_K + off + ks * 32), al0 = *(const bf16x8*)(g_smem + C_KLO + off + ks * 32);
          st0 = mfma32(al0, qfh[ks], st0); st0 = mfma32(ah0, qfl[ks], st0); st0 = mfma32(ah0, qfh[ks], st0);
        }
      }
      if (act1) {
#pragma unroll
        for (int ks = 0; ks < 8; ++ks) {
          const bf16x8 ah1 = *(const bf16x8*)(g_smem + C_K + off + 32 * KSTR + ks * 32), al1 = *(const bf16x8*)(g_smem + C_KLO + off + 32 * KSTR + ks * 32);
          st1 = mfma32(al1, qfh[ks], st1); st1 = mfma32(ah1, qfl[ks], st1); st1 = mfma32(ah1, qfh[ks], st1);
        }
      }
#pragma unroll
      for (int r = 0; r < 16; ++r) {
        const int c = kh * 128 + s * 64 + (r & 3) + 8 * (r >> 2) + 4 * hh;
        st0[r] = ((16 * c + 31 <= token) && c < 255) ? st0[r] * QK_C1 : -1e30f;
        st1[r] = ((16 * (c + 32) + 31 <= token) && (c + 32) < 255) ? st1[r] * QK_C1 : -1e30f;
      }
      t4[s * 2 + 0] = st0; t4[s * 2 + 1] = st1;
    }
    __syncthreads();
  }
  float* ex = (float*)(g_smem + C_EX);
  float mx = -1e30f;
#pragma unroll
  for (int i = 0; i < 4; ++i)
#pragma unroll
    for (int r = 0; r < 16; ++r) mx = fmaxf(mx, t4[i][r]);
  mx = xmax32(mx);
  if (hh == 0) ex[(rg * 2 + kh) * 32 + l32] = mx;
  __syncthreads();
  const float mf = fmaxf(ex[(rg * 2 + 0) * 32 + l32], ex[(rg * 2 + 1) * 32 + l32]);
  float rs = 0.f;
#pragma unroll
  for (int i = 0; i < 4; ++i)
#pragma unroll
    for (int r = 0; r < 16; ++r) { const float t = t4[i][r]; const float pv = t > -1e29f ? fexp2(t - mf) : 0.f; t4[i][r] = pv; rs += pv; }
  rs = xsum32(rs);
  if (hh == 0) ex[256 + (rg * 2 + kh) * 32 + l32] = rs;
  __syncthreads();
  const float lt = ex[256 + (rg * 2 + 0) * 32 + l32] + ex[256 + (rg * 2 + 1) * 32 + l32];
  const float inv = lt > 0.f ? 1.f / lt : 0.f;
  float* Ap = (float*)(g_smem + C_K); float* Bp = Ap + 4 * 32 * 64;
#pragma unroll
  for (int i = 0; i < 4; ++i) {
#pragma unroll
    for (int r = 0; r < 16; ++r) t4[i][r] *= inv;
#pragma unroll
    for (int gq = 0; gq < 4; ++gq) {
      const int n = kh * 32 + (i >> 1) * 16 + (i & 1) * 8 + 2 * gq + hh;
      const float p0 = t4[i][gq * 4], p1 = t4[i][gq * 4 + 1], p2 = t4[i][gq * 4 + 2], p3 = t4[i][gq * 4 + 3];
      Ap[(rg * 32 + l32) * 64 + n] = 2.f * (p0 + p1 + p2) + p3;
      Bp[(rg * 32 + l32) * 64 + n] = p3;
    }
  }
  f32x16 o[4];
#pragma unroll
  for (int i = 0; i < 4; ++i) o[i] = zero16();
#pragma unroll
  for (int i = 0; i < 4; ++i) {
    const int keyb = kh * 128 + (i >> 1) * 64 + (i & 1) * 32;
    if (16 * keyb + 31 > qt * 32 + 31) continue;
    const bf16x8 pk0 = pack8(t4[i], 0), pk1 = pack8(t4[i], 1);
#pragma unroll
    for (int dblk = 0; dblk < 4; ++dblk) {
      const char* vp = g_smem + C_V + (dblk * 32 + l32) * CV_STR + (keyb + 4 * hh) * 2;
      o[dblk] = mfma32(ldv8(vp), pk0, o[dblk]);
      o[dblk] = mfma32(ldv8(vp + 32), pk1, o[dblk]);
    }
  }
  __syncthreads();
  float* X = (float*)(g_smem + C_V);
  if (kh == 1) {
#pragma unroll
    for (int i = 0; i < 4; ++i)
#pragma unroll
      for (int r = 0; r < 16; ++r) X[(rg * 64 + i * 16 + r) * 64 + lane] = o[i][r];
  }
  {
    const int n = lane;
#pragma unroll
    for (int i = 0; i < 4; ++i) {
      const int tok = wave * 4 + i, tk = qt * 32 + tok, cur = tk >> 6;
      float imp = 0.f;
#pragma unroll
      for (int r4 = 0; r4 < 4; ++r4) { imp += Ap[(r4 * 32 + tok) * 64 + n]; if (n > 0) imp += Bp[(r4 * 32 + tok) * 64 + n - 1]; }
      const bool causal = n <= cur, forced = n == 0 || n == cur || n == cur - 1;
      const float score = causal ? (forced ? 1e6f : imp) : -1e6f;
      int rank = 0;
#pragma unroll 4
      for (int j = 0; j < 64; ++j) { const float sj = __int_as_float(__builtin_amdgcn_readlane(__float_as_int(score), j)); rank += (sj > score || (sj == score && j < n)) ? 1 : 0; }
      const unsigned long long msk = __ballot(causal && rank < 16);
      if (lane == 0) ((unsigned long long*)(ws + OFF_SEL))[(size_t)bg * 4096 + tk] = msk;
    }
  }
  __syncthreads();
  float* Tt = (float*)(g_smem + C_K);
  if (kh == 0) {
    const float gt = ((const float*)(ws + OFF_GATES))[(size_t)(b * 4096 + token) * 24 + head * 3 + 0];
    float* trow = Tt + (rg * 32 + l32) * 132;
#pragma unroll
    for (int i = 0; i < 4; ++i)
#pragma unroll
      for (int gq = 0; gq < 4; ++gq) {
        f32x4 v;
#pragma unroll
        for (int j = 0; j < 4; ++j) v[j] = (o[i][gq * 4 + j] + X[(rg * 64 + i * 16 + gq * 4 + j) * 64 + lane]) * gt;
        *(f32x4*)(trow + i * 32 + 8 * gq + 4 * hh) = v;
      }
  }
  __syncthreads();
  if (!dry) {
    float* obase = (float*)(ws + OFF_ON32) + (size_t)b * 4096 * 1024;
#pragma unroll
    for (int k = 0; k < 8; ++k) {
      const int R = wave * 16 + k * 2 + (lane >> 5), rgr = R >> 5, rr = R & 31, c4 = (lane & 31) * 4;
      float* dp = obase + (size_t)(qt * 32 + rr) * 1024 + (g * 4 + rgr) * 128 + c4;
      *(f32x4*)dp = *(const f32x4*)dp + *(const f32x4*)(Tt + R * 132 + c4);
    }
  }
  __syncthreads();
}

DI void cumsum_job(const Params& p, int bh) {
  int tid = threadIdx.x; asm volatile("" : "+v"(tid));
  const int b = bh >> 3, h = bh & 7, wave = tid >> 6, lane = tid & 63;
  const float* lf = (const float*)(p.ws + OFF_LOGF) + (size_t)b * 4096 * 8 + h;
  float* cum = (float*)(p.ws + OFF_CUM) + (size_t)bh * 4096;
  float* wt = (float*)g_smem;
  float v[8]; float s = 0.f;
#pragma unroll
  for (int i = 0; i < 8; ++i) { s += lf[(size_t)(tid * 8 + i) * 8]; v[i] = s; }
  float inc = s;
#pragma unroll
  for (int o = 1; o < 64; o <<= 1) { const float t = __shfl_up(inc, o); if (lane >= o) inc += t; }
  if (lane == 63) wt[wave] = inc;
  __syncthreads();
  float base = inc - s;
  for (int w = 0; w < wave; ++w) base += wt[w];
#pragma unroll
  for (int i = 0; i < 8; ++i) cum[tid * 8 + i] = base + v[i];
  __syncthreads();
}

DI void knorm_job(const Params& p, int j) {
  int tid = threadIdx.x; asm volatile("" : "+v"(tid));
  const int pair = tid >> 1, half = tid & 1, tl = pair >> 3, h = pair & 7;
  const bf16_t* kp = (const bf16_t*)(p.ws + OFF_KF) + (size_t)(j * 32 + tl) * 1024 + h * 128 + half * 64;
  float ss = 0.f;
#pragma unroll
  for (int i = 0; i < 8; ++i) {
    const bf16x8 v = *(const bf16x8*)(kp + i * 8);
#pragma unroll
    for (int e = 0; e < 8; ++e) { const float f = bf2f((unsigned short)v[e]); ss += f * f; }
  }
  ss += __shfl_xor(ss, 1);
  float* nr = (float*)g_smem;
  if (half == 0) nr[pair] = ss;
  __syncthreads();
  if (tid < 8) {
    float m = 0.f;
    for (int t = 0; t < 32; ++t) m = fmaxf(m, nr[t * 8 + tid]);
    ((float*)(p.ws + OFF_KNORM))[((j >> 7) * 8 + tid) * 128 + (j & 127)] = m;
  }
  __syncthreads();
}
DI void gemm1_job(const Params& p, int j) {
  char* ws = p.ws;
  GemmOp g; g.lda = 2048; g.ldb = 4096;
  if (j < 64) {
    const int pm = j >> 4, split = j & 15;
    const bf16_t* ah = (const bf16_t*)(ws + OFF_KCIN_HI) + split * 256; const bf16_t* al = (const bf16_t*)(ws + OFF_KCIN_LO) + split * 256;
    const bf16_t* bh = (const bf16_t*)(ws + OFF_W1K_HI) + split * 256; const bf16_t* bl = (const bf16_t*)(ws + OFF_W1K_LO) + split * 256;
    g.A0 = ah; g.A1 = ah; g.A2 = al; g.B0 = bh; g.B1 = bl; g.B2 = bh; g.nt = 12; g.shift = 2;
    EpiF32 e{(float*)(ws + OFF_H1P_K) + (size_t)split * 1024 * 256, 256};
    gemm_tile(g, pm * 256, 0, e);
  } else {
    const int jj = j - 64, pm = jj >> 3, split = jj & 7;
    const bf16_t* ah = (const bf16_t*)(ws + OFF_VCIN) + split * 512; const bf16_t* bh = (const bf16_t*)(ws + OFF_W1V) + split * 512;
    g.A0 = g.A1 = g.A2 = ah; g.B0 = g.B1 = g.B2 = bh; g.nt = 8; g.shift = 3;
    EpiF32 e{(float*)(ws + OFF_H1P_V) + (size_t)split * 1024 * 256, 256};
    gemm_tile(g, pm * 256, 0, e);
  }
}

DI void gemm2_job(const Params& p, int j) {
  char* ws = p.ws;
  int tid = threadIdx.x; asm volatile("" : "+v"(tid));
  const bool isv = j >= 128; const int r0 = (j & 127) * 8;
  const float* part = (const float*)(ws + (isv ? OFF_H1P_V : OFF_H1P_K));
  const float* bias = (const float*)(ws + OFF_BIAS1) + (isv ? 16 * 256 : 0);
  const float* w2 = isv ? p.w_vc2 : p.w_kc2;
  float* hs = (float*)g_smem;
  float* w2s = hs + 2048;
  float* os = w2s;
  {
    const f32x4* w2v = (const f32x4*)w2;
#pragma unroll 16
    for (int i = 0; i < 16; ++i) ((f32x4*)w2s)[tid + i * 512] = w2v[tid + i * 512];
  }
  for (int idx = tid; idx < 2048; idx += 512) {
    const int row = idx >> 8, col = idx & 255;
    float s = 0.f;
#pragma unroll
    for (int c16 = 0; c16 < 16; ++c16) s += bias[c16 * 256 + col];
    const int nsp = isv ? 8 : 16;
    for (int sp = 0; sp < nsp; ++sp) s += part[((size_t)sp * 1024 + r0 + row) * 256 + col];
    hs[idx] = gelu_tanh(s);
  }
  __syncthreads();
  float a0 = 0.f, a1 = 0.f;
  {
    const int col = tid & 127, rp = tid >> 7;
#pragma unroll 8
    for (int k = 0; k < 256; ++k) { const float w = w2s[k * 128 + col]; a0 += hs[(rp * 2) * 256 + k] * w; a1 += hs[(rp * 2 + 1) * 256 + k] * w; }
  }
  __syncthreads();
  { const int col = tid & 127, rp = tid >> 7; os[(rp * 2) * 128 + col] = a0; os[(rp * 2 + 1) * 128 + col] = a1; }
  __syncthreads();
  if (!isv) {
    const int row = tid >> 6, i = tid & 63;
    const int rr = r0 + row, bg = rr >> 8, n = rr & 255;
    float y1 = 0.f, y2 = 0.f;
    if (n < 255) {
      const int tk = (bg >> 1) * 4096 + 16 * n + 31;
      const float cv = ((const float*)(ws + OFF_COS))[(size_t)tk * 64 + i], sv = ((const float*)(ws + OFF_SIN))[(size_t)tk * 64 + i];
      const float x1 = os[row * 128 + i], x2 = os[row * 128 + 64 + i];
      y1 = x1 * cv - x2 * sv; y2 = x2 * cv + x1 * sv;
    }
    bf16_t* kh_ = (bf16_t*)(ws + OFF_KC_HI) + (size_t)rr * 128; bf16_t* kl_ = (bf16_t*)(ws + OFF_KC_LO) + (size_t)rr * 128;
    kh_[i] = f2bf(y1); kh_[i + 64] = f2bf(y2); kl_[i] = f2bf(lo_of(y1)); kl_[i + 64] = f2bf(lo_of(y2));
  } else {
    for (int idx = tid; idx < 1024; idx += 512) {
      const int row = idx & 7, d = idx >> 3;
      const int rr = r0 + row, bg = rr >> 8, n = rr & 255;
      ((bf16_t*)(ws + OFF_VCT))[((size_t)bg * 128 + d) * 256 + n] = n < 255 ? f2bf(os[row * 128 + d]) : (bf16_t)0;
    }
  }
  __syncthreads();
}

DI void phase3(const Params& p) {
  FOR_JOBS(job, 96) gemm1_job(p, job);
  for (int job = (int)gridDim.x - 1 - (int)blockIdx.x; job < 16; job += gridDim.x) cumsum_job(p, job);
  for (int job = (int)gridDim.x - 1 - (int)blockIdx.x; job < 256; job += gridDim.x) knorm_job(p, job);
}
DI void phase4(const Params& p, bool dry) {
  if (!dry) { FOR_JOBS(job, 256) gemm2_job(p, job); }
  unsigned* qctr = (unsigned*)(p.ws + OFF_BAR) + (dry ? 3616 : 3600);
  volatile int* qslot = (volatile int*)(g_smem + 143360 - 32);
  for (;;) {
    if (threadIdx.x == 0) *qslot = (int)__hip_atomic_fetch_add(qctr, 1u, __ATOMIC_RELAXED, __HIP_MEMORY_SCOPE_AGENT);
    __syncthreads();
    const int u = *qslot;
    __syncthreads();
    if (u >= 1024) break;
    if (u < 512) { const int qt = 31 - (u >> 4), bh = u & 15; attn_unit<0>(p, bh >> 3, bh & 7, qt, dry); }
    else { const int v = u - 512; const int qt = 127 - (v >> 2), bg = v & 3; attn_unit<1>(p, bg >> 1, bg & 1, qt, dry); }
  }
}
DI void phase5(const Params& p, bool dry) {
  FOR_JOBS(job, 512) { const int qt = job >> 2, bg = job & 3; cmp_unit(p, bg >> 1, bg & 1, qt, dry); }
}
DI void phase6(const Params& p, bool dry) {
  unsigned* qctr = (unsigned*)(p.ws + OFF_BAR) + (dry ? 3648 : 3632);
  volatile int* qslot = (volatile int*)(g_smem + 143360 - 32);
  for (;;) {
    if (threadIdx.x == 0) *qslot = (int)__hip_atomic_fetch_add(qctr, 1u, __ATOMIC_RELAXED, __HIP_MEMORY_SCOPE_AGENT);
    __syncthreads();
    const int job = *qslot;
    __syncthreads();
    if (job >= 512) break;
    const int qt = 127 - (job >> 2), bg = job & 3; attn_unit<2>(p, bg >> 1, bg & 1, qt, dry);
  }
}

DI void outproj_phase(const Params& p) {
  char* ws = p.ws;
  FOR_JOBS(job, 256) {
    const int pn = job >> 5, pm = job & 31;
    GemmOp g; g.lda = 2048; g.ldb = 2048; g.nt = 32; g.shift = 5;
    g.A0 = g.A1 = g.A2 = (const bf16_t*)(ws + OFF_U_HI); g.B0 = g.B1 = g.B2 = (const bf16_t*)(ws + OFF_WOUT);
    EpiResid e{(float*)(ws + OFF_H1), p.x, (const float*)(ws + OFF_MOD) + 4096};
    gemm_tile(g, pm * 256, pn * 256, e);
  }
}
DI void gateup_phase(const Params& p) {
  char* ws = p.ws;
  FOR_JOBS(job, 44 * 32) {
    const int pn = job >> 5, pm = job & 31;
    GemmOp g; g.lda = 2048; g.ldb = 2048; g.nt = 32; g.shift = 5;
    g.A0 = g.A1 = g.A2 = (const bf16_t*)(ws + OFF_U_HI); g.B0 = g.B1 = g.B2 = (const bf16_t*)(ws + OFF_WGU);
    EpiSwiglu e{(bf16_t*)(ws + OFF_ACT)};
    gemm_tile(g, pm * 256, pn * 256, e);
  }
}
DI void down_phase(const Params& p) {
  char* ws = p.ws;
  FOR_JOBS(job, 256) {
    const int pn = job >> 5, pm = job & 31;
    GemmOp g; g.lda = DFF; g.ldb = DFF; g.nt = 88; g.shift = 20;
    g.A0 = g.A1 = g.A2 = (const bf16_t*)(ws + OFF_ACT); g.B0 = g.B1 = g.B2 = (const bf16_t*)(ws + OFF_WDN);
    EpiResid e{p.out, (const float*)(ws + OFF_H1), (const float*)(ws + OFF_MOD) + 10240};
    gemm_tile(g, pm * 256, pn * 256, e);
  }
}


#define XB_TMO      128
#define XB_XCNT(j)  (256  + 64 * (j))
#define XB_XSUB(j)  (1280 + 64 * (j))
#define XB_XGEN(j)  (2304 + 64 * (j))
#define XB_TOP      3328
#define XB_TOPGEN   3392
#define XCD_BAR_WORDS 3456
#define XB_SPIN_CAP (1u << 22)
#define LAS __attribute__((address_space(3)))
constexpr int LDS_BAR_OFF = 143360 - 16;
DI unsigned xb_ld(unsigned* p) { return __hip_atomic_load(p, __ATOMIC_RELAXED, __HIP_MEMORY_SCOPE_AGENT); }
DI unsigned xb_add(unsigned* p, unsigned v) { return __hip_atomic_fetch_add(p, v, __ATOMIC_RELAXED, __HIP_MEMORY_SCOPE_AGENT); }
DI unsigned xb_xcc_id() { return (unsigned)__builtin_amdgcn_s_getreg((3 << 11) | 20) & 0xFu; }
#define XB_SPIN(cond, bar) do { unsigned _sp = 0; while (cond) { __builtin_amdgcn_s_sleep(1); \
    if ((++_sp & 255u) == 0u) { if (xb_ld(&(bar)[XB_TMO])) break; if (_sp > XB_SPIN_CAP) { atomicAdd(&(bar)[XB_TMO], 1u); break; } } } } while (0)
struct XcdBarrier { unsigned* bar; unsigned x; volatile LAS unsigned* st; };
DI XcdBarrier xcd_barrier_post(unsigned* bar, volatile LAS unsigned* st) {
  XcdBarrier b; b.bar = bar; b.x = xb_xcc_id(); b.st = st;
  if (threadIdx.x == 0) (void)xb_add(&bar[XB_XCNT(b.x)], 1u);
  return b;
}
DI void xcd_barrier_complete(unsigned* bar, unsigned x, unsigned& nloc, unsigned& nx) {
  const unsigned G = gridDim.x * gridDim.y * gridDim.z;
  unsigned sum, cnt, mine, sp = 0u;
  for (;;) {
    sum = 0u; cnt = 0u; mine = 0u;
#pragma unroll
    for (unsigned j = 0; j < 16; ++j) { const unsigned c = xb_ld(&bar[XB_XCNT(j)]); sum += c; cnt += (c > 0u) ? 1u : 0u; mine = (j == x) ? c : mine; }
    if (sum == G) break;
    __builtin_amdgcn_s_sleep(1);
    if ((++sp & 255u) == 0u) { if (xb_ld(&bar[XB_TMO])) break; if (sp > XB_SPIN_CAP) { atomicAdd(&bar[XB_TMO], 1u); break; } }
  }
  nloc = mine > 0u ? mine : 1u; nx = cnt > 0u ? cnt : 1u;
}
DI void xcd_barrier(const XcdBarrier& b) {
  asm volatile("s_waitcnt vmcnt(0)" ::: "memory");
  __syncthreads();
  if (threadIdx.x == 0) {
    unsigned* bar = b.bar;
    __builtin_amdgcn_s_waitcnt(0);
    unsigned nloc = b.st[0], nx = b.st[1];
    if (nloc == 0u) { xcd_barrier_complete(bar, b.x, nloc, nx); b.st[0] = nloc; b.st[1] = nx; }
    const unsigned old = xb_add(&bar[XB_XSUB(b.x)], 1u);
    const unsigned gen = old / nloc;
    if (old + 1u == (gen + 1u) * nloc) {
      __builtin_amdgcn_fence(__ATOMIC_RELEASE, "agent");
      asm volatile("s_waitcnt vmcnt(0)" ::: "memory");
      const unsigned og = xb_add(&bar[XB_TOP], 1u);
      const unsigned tg = og / nx;
      if (og + 1u == (tg + 1u) * nx) xb_add(&bar[XB_TOPGEN], 1u);
      else XB_SPIN(xb_ld(&bar[XB_TOPGEN]) == tg, bar);
      __builtin_amdgcn_fence(__ATOMIC_ACQUIRE, "agent");
      xb_add(&bar[XB_XGEN(b.x)], 1u);
      asm volatile("s_waitcnt vmcnt(0)" ::: "memory");
    } else {
      XB_SPIN(xb_ld(&bar[XB_XGEN(b.x)]) == gen, bar);
      __builtin_amdgcn_fence(__ATOMIC_ACQUIRE, "agent");
      asm volatile("s_waitcnt vmcnt(0)" ::: "memory");
    }
  }
  __syncthreads();
}

#ifdef ONLY_PHASE
#define PH_ON(k) ((k) == ONLY_PHASE)
#else
#define PH_ON(k) 1
#endif
#ifndef REP_MASK
#define REP_MASK 0
#endif
#define RUN_PHASE(k, call) do { if (PH_ON(k) && ph0 <= (k) && (k) < ph1) { \
    _Pragma("unroll 1") for (int _r = 0; _r <= ((REP_MASK >> (k)) & 1); ++_r) { const bool _dry = ((REP_MASK >> (k)) & 1) && _r == 0; (void)_dry; if ((k) > ph0 || _r) GRID_SYNC(); call; } } } while (0)
#ifndef NSYNC_EXTRA
#define NSYNC_EXTRA 0
#endif
#define GRID_SYNC() xcd_barrier(xb)
__global__ void __launch_bounds__(512) hymba_mega(Params p, int ph0, int ph1) {
  volatile LAS unsigned* xst = (volatile LAS unsigned*)(g_smem + LDS_BAR_OFF);
  if (threadIdx.x == 0) { xst[0] = 0u; xst[1] = 0u; }
  __syncthreads();
  const XcdBarrier xb = xcd_barrier_post((unsigned*)(p.ws + OFF_BAR), xst);
  if (ph1 > 1000) cg::this_grid().sync();
  RUN_PHASE(0, phase0(p));
  RUN_PHASE(1, rmsmod_phase(p.x, p.norm_attn, (const float*)(p.ws + OFF_MOD), 0, 2048, (bf16_t*)(p.ws + OFF_U_HI), (bf16_t*)(p.ws + OFF_U_LO), true));
  RUN_PHASE(2, inproj_phase(p, _dry));
  RUN_PHASE(3, phase3(p));
  RUN_PHASE(4, phase4(p, _dry));
  RUN_PHASE(5, phase5(p, _dry));
  RUN_PHASE(6, phase6(p, _dry));
  RUN_PHASE(7, ymix_phase(p));
  RUN_PHASE(8, outproj_phase(p));
  RUN_PHASE(9, rmsmod_phase((const float*)(p.ws + OFF_H1), p.norm_ffn, (const float*)(p.ws + OFF_MOD), 6144, 8192, (bf16_t*)(p.ws + OFF_U_HI), nullptr, false));
  RUN_PHASE(10, gateup_phase(p));
  RUN_PHASE(11, down_phase(p));
  RUN_PHASE(12, final_phase(p));
  _Pragma("unroll 1") for (int i = 0; i < NSYNC_EXTRA; ++i) GRID_SYNC();
}

extern "C" void kernel_launch(void* const* d_in, const int* in_sizes, int n_in, void* d_out, int out_size, void* d_ws, size_t ws_size,
                              hipStream_t stream) {
  Params p{};
  p.x = (const float*)d_in[0]; p.c = (const float*)d_in[1]; p.pos = (const int*)d_in[2];
  p.w_ada = (const float*)d_in[3]; p.b_ada = (const float*)d_in[4]; p.norm_attn = (const float*)d_in[5]; p.norm_ffn = (const float*)d_in[6];
  p.w_in = (const float*)d_in[7]; p.b_fgate = (const float*)d_in[8]; p.cmp_pos = (const float*)d_in[9];
  p.w_kc1 = (const float*)d_in[10]; p.w_kc2 = (const float*)d_in[11]; p.w_vc1 = (const float*)d_in[12]; p.w_vc2 = (const float*)d_in[13];
  p.beta_fox = (const float*)d_in[14]; p.beta_nsa = (const float*)d_in[15]; p.w_out = (const float*)d_in[16];
  p.w_gate = (const float*)d_in[17]; p.w_up = (const float*)d_in[18]; p.w_down = (const float*)d_in[19]; p.final_norm = (const float*)d_in[20];
  p.out = (float*)d_out; p.ws = (char*)d_ws;
  static int grid_blocks = 0;
  if (!grid_blocks) {
    hipFuncSetAttribute((const void*)hymba_mega, hipFuncAttributeMaxDynamicSharedMemorySize, LDS_BYTES);
    int dev = 0, cus = 0, per_cu = 0;
    hipGetDevice(&dev);
    hipDeviceGetAttribute(&cus, hipDeviceAttributeMultiprocessorCount, dev);
    hipOccupancyMaxActiveBlocksPerMultiprocessor(&per_cu, hymba_mega, 512, LDS_BYTES);
    if (per_cu < 1) per_cu = 1;
    grid_blocks = cus * per_cu;
    if (ws_size < WS_END) fprintf(stderr, "workspace too small: %zu < %zu\n", ws_size, (size_t)WS_END);
  }
  hipMemsetAsync((char*)d_ws + OFF_BAR, 0, 16384, stream);
#if N_LAUNCH_MODE == 1
  int ph0 = 0, ph1 = NPH;
  void* args[] = {&p, &ph0, &ph1};
  hipError_t e = hipLaunchCooperativeKernel((const void*)hymba_mega, dim3(grid_blocks), dim3(512), args, LDS_BYTES, stream);
  if (e != hipSuccess) fprintf(stderr, "cooperative launch failed: %s (grid %d)\n", hipGetErrorString(e), grid_blocks);
#else
  for (int ph = 0; ph < NPH; ++ph) hipLaunchKernelGGL(hymba_mega, dim3(grid_blocks), dim3(512), LDS_BYTES, stream, p, ph, ph + 1);
#endif
}
```

```cpp
#include <hip/hip_runtime.h>
#include <hip/hip_cooperative_groups.h>
#include <stdint.h>
#include <cstdio>
namespace cg = cooperative_groups;

#define DI __device__ __forceinline__
typedef unsigned short bf16_t;
typedef short bf16x8 __attribute__((ext_vector_type(8)));
typedef short s16x4 __attribute__((ext_vector_type(4)));
typedef float f32x4 __attribute__((ext_vector_type(4)));
typedef float f32x16 __attribute__((ext_vector_type(16)));
typedef unsigned u32x2 __attribute__((ext_vector_type(2)));
typedef unsigned u32x4 __attribute__((ext_vector_type(4)));

#ifndef DRY_MODE
#define DRY_MODE 0
#endif
#ifndef ATTN_PREFETCH
#define ATTN_PREFETCH 0
#endif
#ifndef N_LAUNCH_MODE
#define N_LAUNCH_MODE 1
#endif

constexpr int T_TOK = 8192, SEQ = 4096, DM = 2048, DFF = 5632, DIN = 5664;
constexpr int NPH = 13;
constexpr float LOG2E = 1.4426950408889634f;
constexpr float QK_C1 = 0.08838834764831845f * 1.4426950408889634f;

constexpr size_t al256(size_t x) { return (x + 255) & ~(size_t)255; }
constexpr size_t OFF_WIN_HI = 0;
constexpr size_t OFF_WIN_LO = OFF_WIN_HI + al256((size_t)5888 * 2048 * 2);
constexpr size_t OFF_WOUT = OFF_WIN_LO + al256((size_t)1280 * 2048 * 2);
constexpr size_t OFF_WGU = OFF_WOUT + al256((size_t)2048 * 2048 * 2);
constexpr size_t OFF_WDN = OFF_WGU + al256((size_t)11264 * 2048 * 2);
constexpr size_t OFF_W1K_HI = OFF_WDN + al256((size_t)2048 * 5632 * 2);
constexpr size_t OFF_W1K_LO = OFF_W1K_HI + al256((size_t)256 * 4096 * 2);
constexpr size_t OFF_W1V = OFF_W1K_LO + al256((size_t)256 * 4096 * 2);
constexpr size_t OFF_MOD = OFF_W1V + al256((size_t)256 * 4096 * 2);
constexpr size_t OFF_COS = OFF_MOD + al256((size_t)2 * 12288 * 4);
constexpr size_t OFF_SIN = OFF_COS + al256((size_t)8192 * 64 * 4);
constexpr size_t OFF_BIAS1 = OFF_SIN + al256((size_t)8192 * 64 * 4);
constexpr size_t OFF_U_HI = OFF_BIAS1 + al256((size_t)2 * 16 * 256 * 4);
constexpr size_t OFF_LOGF = OFF_U_HI + al256((size_t)8192 * 2048 * 2);
constexpr size_t OFF_CUM = OFF_LOGF + al256((size_t)8192 * 8 * 4);
constexpr size_t OFF_GATES = OFF_CUM + al256((size_t)16 * 4096 * 4);
constexpr size_t KCIN_BYTES = al256((size_t)(4 * 4096 + 64) * 128 * 2);
constexpr size_t OFF_KCIN_HI = OFF_GATES + al256((size_t)8192 * 24 * 4);
constexpr size_t OFF_KCIN_LO = OFF_KCIN_HI + KCIN_BYTES;
constexpr size_t OFF_VCIN = OFF_KCIN_LO + KCIN_BYTES;
constexpr size_t KV4_BYTES = (size_t)4 * 4096 * 128 * 2;
constexpr size_t OFF_KS = OFF_VCIN + KCIN_BYTES;
constexpr size_t OFF_VST = OFF_KS + KV4_BYTES;
constexpr size_t OFF_KW = OFF_VST + KV4_BYTES;
constexpr size_t OFF_VWT = OFF_KW + KV4_BYTES;
constexpr size_t OFF_H1P_K = OFF_VWT + KV4_BYTES;
constexpr size_t OFF_H1P_V = OFF_H1P_K + (size_t)16 * 1024 * 256 * 4;
constexpr size_t OFF_KC_HI = OFF_H1P_V + (size_t)8 * 1024 * 256 * 4;
constexpr size_t OFF_KC_LO = OFF_KC_HI + (size_t)4 * 256 * 128 * 2;
constexpr size_t OFF_VCT = OFF_KC_LO + (size_t)4 * 256 * 128 * 2;
constexpr size_t OFF_SEL = OFF_VCT + (size_t)4 * 256 * 128 * 2;
constexpr size_t OFF_OF32 = OFF_SEL + (size_t)4 * 4096 * 8;
constexpr size_t OFF_ON32 = OFF_OF32 + (size_t)8192 * 1024 * 4;
constexpr size_t OFF_H1 = OFF_OF32;
constexpr size_t OFF_RA = OFF_ON32 + (size_t)8192 * 1024 * 4;
constexpr size_t OFF_U_LO = OFF_RA;
constexpr size_t OFF_QF = OFF_U_LO + (size_t)8192 * 2048 * 2;
constexpr size_t OFF_KF = OFF_QF + (size_t)8192 * 1024 * 2;
constexpr size_t OFF_VFT = OFF_KF + (size_t)8192 * 1024 * 2;
constexpr size_t OFF_QN_HI = OFF_VFT + (size_t)8192 * 1024 * 2;
constexpr size_t OFF_QN_LO = OFF_QN_HI + (size_t)8192 * 1024 * 2;
constexpr size_t OFF_ACT = OFF_RA;
constexpr size_t OFF_KNORM = OFF_QN_LO + (size_t)8192 * 1024 * 2;
constexpr size_t OFF_BAR = OFF_KNORM + 8192;
constexpr size_t WS_END = OFF_BAR + 16384;

struct Params {
  const float *x, *c; const int* pos;
  const float *w_ada, *b_ada, *norm_attn, *norm_ffn, *w_in, *b_fgate, *cmp_pos, *w_kc1, *w_kc2, *w_vc1, *w_vc2,
      *beta_fox, *beta_nsa, *w_out, *w_gate, *w_up, *w_down, *final_norm;
  float* out; char* ws;
};

extern __shared__ __attribute__((aligned(16))) char g_smem[];
constexpr int LDS_BYTES = 143360;

__device__ const float c_inv_freq[64] = {
1.000000000e+00f,8.659643531e-01f,7.498942614e-01f,6.493816376e-01f,5.623413324e-01f,4.869675338e-01f,4.216965139e-01f,3.651741147e-01f,3.162277639e-01f,2.738419771e-01f,2.371373773e-01f,2.053525001e-01f,1.778279394e-01f,1.539926529e-01f,1.333521307e-01f,1.154782027e-01f,1.000000015e-01f,8.659642935e-02f,7.498941571e-02f,6.493816525e-02f,5.623413250e-02f,4.869675264e-02f,4.216965288e-02f,3.651741147e-02f,3.162277490e-02f,2.738419734e-02f,2.371373773e-02f,2.053525113e-02f,1.778279431e-02f,1.539926510e-02f,1.333521493e-02f,1.154782064e-02f,9.999999776e-03f,8.659643121e-03f,7.498941850e-03f,6.493816152e-03f,5.623413250e-03f,4.869675264e-03f,4.216964822e-03f,3.651741194e-03f,3.162277630e-03f,2.738419687e-03f,2.371373586e-03f,2.053524833e-03f,1.778279431e-03f,1.539926510e-03f,1.333521446e-03f,1.154781901e-03f,1.000000047e-03f,8.659643354e-04f,7.498942432e-04f,6.493816618e-04f,5.623413017e-04f,4.869675322e-04f,4.216965172e-04f,3.651741426e-04f,3.162277571e-04f,2.738419571e-04f,2.371373703e-04f,2.053525095e-04f,1.778279402e-04f,1.539926452e-04f,1.333521504e-04f,1.154782003e-04f};

DI unsigned short f2bf(float x) { unsigned u = __float_as_uint(x); u += 0x7fffu + ((u >> 16) & 1u); return (unsigned short)(u >> 16); }
DI float bf2f(unsigned short h) { return __uint_as_float(((unsigned)h) << 16); }
typedef float f32x2 __attribute__((ext_vector_type(2)));
typedef __bf16 bf16v2 __attribute__((ext_vector_type(2)));
DI unsigned pack2(float a, float b) { const f32x2 v = {a, b}; return __builtin_bit_cast(unsigned, __builtin_convertvector(v, bf16v2)); }
DI void split2(float a, float b, unsigned& hi, unsigned& lo) {
  hi = pack2(a, b);
  lo = pack2(a - __uint_as_float(hi << 16), b - __uint_as_float(hi & 0xffff0000u));
}
DI float lo_of(float x) { return x - bf2f(f2bf(x)); }
DI float wave_sum(float v) {
#pragma unroll
  for (int o = 32; o > 0; o >>= 1) v += __shfl_xor(v, o);
  return v;
}
DI float xmax32(float v) { auto r = __builtin_amdgcn_permlane32_swap(__float_as_uint(v), __float_as_uint(v), false, false); return fmaxf(__uint_as_float(r[0]), __uint_as_float(r[1])); }
DI float xsum32(float v) { auto r = __builtin_amdgcn_permlane32_swap(__float_as_uint(v), __float_as_uint(v), false, false); return __uint_as_float(r[0]) + __uint_as_float(r[1]); }
DI float fexp2(float x) { return __builtin_amdgcn_exp2f(x); }
DI float sigmoidf_(float x) { return 1.f / (1.f + __expf(-x)); }
DI float siluf_(float x) { return x / (1.f + __expf(-x)); }
DI float silu_fast(float x) { return x * __builtin_amdgcn_rcpf(1.f + __builtin_amdgcn_exp2f(-LOG2E * x)); }
DI float gelu_tanh(float x) { float u = 0.7978845608028654f * (x + 0.044715f * x * x * x); float e = __expf(2.f * u); float t = 1.f - 2.f / (e + 1.f); return 0.5f * x * (1.f + t); }
DI float log_sigmoid(float x) { return fminf(x, 0.f) - log1pf(__expf(-fabsf(x))); }
DI f32x16 mfma32(bf16x8 a, bf16x8 b, f32x16 c) { return __builtin_amdgcn_mfma_f32_32x32x16_bf16(a, b, c, 0, 0, 0); }
DI f32x16 zero16() { f32x16 z;
#pragma unroll
  for (int i = 0; i < 16; ++i) z[i] = 0.f; return z; }
DI int perm_gu(int w) { const int r = w & 31; return (w & 96) + ((r >> 2) & 1) * 16 + (r >> 3) * 4 + (r & 3); }
DI int perm256(int w) { const int hl = (w >> 7) & 1, d = w & 127, bj = d >> 6, q = (d & 63) >> 3, n = (d >> 2) & 1, j = d & 3; return bj * 128 + (hl * 2 + (q >> 2)) * 32 + n * 16 + (q & 3) * 4 + j; }
DI int perm128(int d) { return ((d >> 4) & 3) * 32 + (d >> 6) * 16 + (d & 15); }

#define FOR_JOBS(job, njobs) \
  for (int _r = 0, job; _r * (int)gridDim.x < (njobs); ++_r) \
    if ((job = _r * (int)gridDim.x + ((_r & 1) ? ((int)gridDim.x - 1 - (int)blockIdx.x) : (int)blockIdx.x)) < (njobs))

constexpr int BM = 256, BK = 64, HALF = 128, HTB = HALF * BK * 2;
DI int lds_byte(int r, int c) { int st = (r >> 4) * 2 + (c >> 5), rr = r & 15, cc = c & 31, ob = rr * 64 + cc * 2; return st * 1024 + (ob ^ (((ob >> 9) & 1) << 5)); }
DI void stage_rc(int b, int& R, int& C) { int st = b / 1024, sb = b % 1024, swz = sb ^ (((sb >> 9) & 1) << 5); R = (st >> 1) * 16 + swz / 64; C = (st & 1) * 32 + (swz % 64) / 2; }

DI const char* uptr(const char* p) {
  const unsigned long long v = (unsigned long long)p;
  const unsigned lo = __builtin_amdgcn_readfirstlane((unsigned)v), hi = __builtin_amdgcn_readfirstlane((unsigned)(v >> 32));
  return (const char*)(((unsigned long long)hi << 32) | lo);
}
struct GemmOp { const bf16_t *A0, *A1, *A2, *B0, *B1, *B2; int lda, ldb, nt, shift; };

template <class Epi>
DI void gemm_tile(const GemmOp& g, int brow, int bcol, const Epi& epi) {
#define SA(b, h) (g_smem + ((b) * 2 + (h)) * HTB)
#define SB(b, h) (g_smem + (4 + (b) * 2 + (h)) * HTB)
  int tid = threadIdx.x; asm volatile("" : "+v"(tid));
  const int wid = tid >> 6, lane = tid & 63, wr = wid >> 2, wc = wid & 3, fr = lane & 15, fq = lane >> 4;
  int r0, c0, r1, c1; stage_rc(tid * 16, r0, c0); stage_rc(tid * 16 + 8192, r1, c1);
  const unsigned oa0 = (unsigned)(r0 * g.lda + c0) * 2u, oa1 = (unsigned)(r1 * g.lda + c1) * 2u, ob0 = (unsigned)(r0 * g.ldb + c0) * 2u, ob1 = (unsigned)(r1 * g.ldb + c1) * 2u;
  const int mask = (1 << g.shift) - 1;
#define STAGE_A(P, half, kt) do { const int _s = (kt) >> g.shift; const char* _b = uptr((const char*)((_s == 0 ? g.A0 : (_s == 1 ? g.A1 : g.A2)) + (size_t)(brow + (half) * HALF) * g.lda + (size_t)((kt) & mask) * BK)); \
    __builtin_amdgcn_global_load_lds((const unsigned*)(_b + oa0), (unsigned*)((P) + tid * 16), 16, 0, 0); \
    __builtin_amdgcn_global_load_lds((const unsigned*)(_b + oa1), (unsigned*)((P) + tid * 16 + 8192), 16, 0, 0); } while (0)
#define STAGE_B(P, half, kt) do { const int _s = (kt) >> g.shift; const char* _b = uptr((const char*)((_s == 0 ? g.B0 : (_s == 1 ? g.B1 : g.B2)) + (size_t)(bcol + (half) * HALF) * g.ldb + (size_t)((kt) & mask) * BK)); \
    __builtin_amdgcn_global_load_lds((const unsigned*)(_b + ob0), (unsigned*)((P) + tid * 16), 16, 0, 0); \
    __builtin_amdgcn_global_load_lds((const unsigned*)(_b + ob1), (unsigned*)((P) + tid * 16 + 8192), 16, 0, 0); } while (0)
#define LDA(dst, b, h) for (int m = 0; m < 4; ++m) for (int k = 0; k < 2; ++k) \
    dst[m][k] = *reinterpret_cast<const bf16x8*>(SA(b, h) + lds_byte(wr * 64 + m * 16 + fr, k * 32 + fq * 8))
#define LDB(dst, b, h) for (int n = 0; n < 2; ++n) for (int k = 0; k < 2; ++k) \
    dst[n][k] = *reinterpret_cast<const bf16x8*>(SB(b, h) + lds_byte(wc * 32 + n * 16 + fr, k * 32 + fq * 8))
#define MMA(ai, bj, At_, Bt_) do { __builtin_amdgcn_s_setprio(1); \
    for (int m = 0; m < 4; ++m) for (int n = 0; n < 2; ++n) for (int k = 0; k < 2; ++k) \
      acc[ai][bj][m][n] = __builtin_amdgcn_mfma_f32_16x16x32_bf16(Bt_[n][k], At_[m][k], acc[ai][bj][m][n], 0, 0, 0); \
    __builtin_amdgcn_s_setprio(0); } while (0)
#define WAIT_V(n) asm volatile("s_waitcnt vmcnt(" #n ")" ::: "memory")
#define WAIT_L(n) asm volatile("s_waitcnt lgkmcnt(" #n ")" ::: "memory")
#define BAR __builtin_amdgcn_s_barrier()
#define SCHED __builtin_amdgcn_sched_barrier(0)
  f32x4 acc[2][2][4][2] = {};
  bf16x8 At[4][2], B0[2][2], B1[2][2];
  const int nt = g.nt;
  STAGE_B(SB(0, 0), 0, 0); STAGE_A(SA(0, 0), 0, 0);
  STAGE_B(SB(0, 1), 1, 0); STAGE_A(SA(0, 1), 1, 0);
  if (wr == 1) BAR;
  WAIT_V(4); BAR;
  STAGE_B(SB(1, 0), 0, 1); STAGE_A(SA(1, 0), 0, 1); STAGE_B(SB(1, 1), 1, 1);
  WAIT_V(6); BAR;
  for (int t = 0; t < nt - 2; t += 2) {
    LDB(B0, 0, 0); SCHED; LDA(At, 0, 0); STAGE_A(SA(1, 1), 1, t + 1);
    WAIT_L(8); BAR; WAIT_L(0); MMA(0, 0, At, B0); BAR; SCHED;
    LDB(B1, 0, 1); STAGE_B(SB(0, 0), 0, t + 2);
    BAR; WAIT_L(0); MMA(0, 1, At, B1); BAR;
    LDA(At, 0, 1); STAGE_A(SA(0, 0), 0, t + 2);
    BAR; WAIT_L(0); MMA(1, 0, At, B0); BAR; SCHED;
    STAGE_B(SB(0, 1), 1, t + 2);
    WAIT_V(6); BAR; MMA(1, 1, At, B1); BAR;
    LDB(B0, 1, 0); SCHED; LDA(At, 1, 0); STAGE_A(SA(0, 1), 1, t + 2);
    WAIT_L(8); BAR; WAIT_L(0); MMA(0, 0, At, B0); BAR; SCHED;
    LDB(B1, 1, 1); STAGE_B(SB(1, 0), 0, t + 3);
    BAR; WAIT_L(0); MMA(0, 1, At, B1); BAR;
    LDA(At, 1, 1); STAGE_A(SA(1, 0), 0, t + 3);
    BAR; WAIT_L(0); MMA(1, 0, At, B0); BAR; SCHED;
    STAGE_B(SB(1, 1), 1, t + 3);
    WAIT_V(6); BAR; MMA(1, 1, At, B1); BAR;
  }
  { LDB(B0, 0, 0); LDA(At, 0, 0); STAGE_A(SA(1, 1), 1, nt - 1);
    BAR; WAIT_L(0); MMA(0, 0, At, B0); BAR;
    LDB(B1, 0, 1); BAR; WAIT_L(0); MMA(0, 1, At, B1); BAR;
    LDA(At, 0, 1); WAIT_V(4); BAR; WAIT_L(0); MMA(1, 0, At, B0); MMA(1, 1, At, B1); BAR; }
  { LDB(B0, 1, 0); LDA(At, 1, 0); WAIT_V(2); BAR; WAIT_L(0); MMA(0, 0, At, B0); BAR;
    LDB(B1, 1, 1); WAIT_V(0); BAR; WAIT_L(0); MMA(0, 1, At, B1); BAR;
    LDA(At, 1, 1); BAR; WAIT_L(0); MMA(1, 0, At, B0); MMA(1, 1, At, B1); BAR; }
  if (wr == 0) BAR;
  { int t2 = tid; asm volatile("" : "+v"(t2)); const int w2 = t2 >> 6, l2 = t2 & 63; epi(acc, brow, bcol, w2 >> 2, w2 & 3, l2 & 15, l2 >> 4); }
  __syncthreads();
#undef SA
#undef SB
}

typedef f32x4 AccT[2][2][4][2];

struct EpiInproj {
  const Params* p; int pn;
  DI void operator()(const AccT& acc, int brow, int bcol, int wr, int wc, int fr, int fq) const {
    char* ws = p->ws;
    const float* cs = (const float*)(ws + OFF_COS); const float* sn = (const float*)(ws + OFF_SIN);
    const int hl = wc >> 1, dlo = ((wc & 1) * 4 + fq) * 8;
    const bool rope = (pn >= 12 && pn < 16) || pn == 18 || pn == 20;
#pragma unroll
    for (int ai = 0; ai < 2; ++ai)
#pragma unroll
      for (int m = 0; m < 4; ++m) {
        const int token = brow + ai * 128 + wr * 64 + m * 16 + fr;
        const int b = token >> 12, s = token & 4095;
        f32x4 a0 = acc[ai][0][m][0], a1 = acc[ai][0][m][1], b0 = acc[ai][1][m][0], b1 = acc[ai][1][m][1];
        if (rope) {
          const f32x4 c0 = *(const f32x4*)(cs + (size_t)token * 64 + dlo), c1 = *(const f32x4*)(cs + (size_t)token * 64 + dlo + 4);
          const f32x4 s0 = *(const f32x4*)(sn + (size_t)token * 64 + dlo), s1 = *(const f32x4*)(sn + (size_t)token * 64 + dlo + 4);
          const f32x4 y0 = a0 * c0 - b0 * s0, y1 = a1 * c1 - b1 * s1, z0 = b0 * c0 + a0 * s0, z1 = b1 * c1 + a1 * s1;
          a0 = y0; a1 = y1; b0 = z0; b1 = z1;
        }
        unsigned h[8], l[8];
        split2(a0[0], a0[1], h[0], l[0]); split2(a0[2], a0[3], h[1], l[1]); split2(a1[0], a1[1], h[2], l[2]); split2(a1[2], a1[3], h[3], l[3]);
        split2(b0[0], b0[1], h[4], l[4]); split2(b0[2], b0[3], h[5], l[5]); split2(b1[0], b1[1], h[6], l[6]); split2(b1[2], b1[3], h[7], l[7]);
        size_t o; size_t off_hi; size_t off_lo = 0; bool has_lo = false;
        if (pn < 8) { o = (size_t)token * 1024 + ((pn & 3) * 2 + hl) * 128 + dlo; off_hi = pn < 4 ? OFF_QF : OFF_KF; }
        else if (pn < 16) { o = (size_t)token * 1024 + ((pn - 12) * 2 + hl) * 128 + dlo; off_hi = OFF_QN_HI; off_lo = OFF_QN_LO; has_lo = true; }
        else {
          o = ((size_t)(b * 2 + hl) * 4096 + s) * 128 + dlo;
          off_hi = pn == 16 ? OFF_KCIN_HI : (pn == 17 ? OFF_VCIN : (pn == 18 ? OFF_KS : OFF_KW));
          if (pn == 16) { off_lo = OFF_KCIN_LO; has_lo = true; }
        }
        bf16_t* dh = (bf16_t*)(ws + off_hi) + o;
        *(u32x4*)dh = (u32x4){h[0], h[1], h[2], h[3]};
        *(u32x4*)(dh + 64) = (u32x4){h[4], h[5], h[6], h[7]};
        if (has_lo) {
          bf16_t* dl = (bf16_t*)(ws + off_lo) + o;
          *(u32x4*)dl = (u32x4){l[0], l[1], l[2], l[3]};
          *(u32x4*)(dl + 64) = (u32x4){l[4], l[5], l[6], l[7]};
        }
      }
  }
};

struct EpiVT {
  bf16_t* dst; int nheads; int sec_row0;
  DI void operator()(const AccT& acc, int brow, int bcol, int wr, int wc, int fr, int fq) const {
#pragma unroll
    for (int ai = 0; ai < 2; ++ai)
#pragma unroll
      for (int m = 0; m < 4; ++m) {
        const int vr = brow - sec_row0 + ai * 128 + wr * 64 + m * 16 + fr;
        const int head = vr >> 7, d = vr & 127;
#pragma unroll
        for (int bj = 0; bj < 2; ++bj)
#pragma unroll
          for (int n = 0; n < 2; ++n) {
            const int tk = bcol + bj * 128 + wc * 32 + n * 16 + fq * 4;
            const int b = tk >> 12, s = tk & 4095;
            const f32x4 v = acc[ai][bj][m][n];
            *(u32x2*)(dst + ((size_t)(b * nheads + head) * 128 + d) * 4096 + s) = (u32x2){pack2(v[0], v[1]), pack2(v[2], v[3])};
          }
      }
  }
};

struct EpiF32 {
  float* dst; int ld;
  DI void operator()(const AccT& acc, int brow, int bcol, int wr, int wc, int fr, int fq) const {
#pragma unroll
    for (int ai = 0; ai < 2; ++ai)
#pragma unroll
      for (int m = 0; m < 4; ++m) {
        const int row = brow + ai * 128 + wr * 64 + m * 16 + fr;
#pragma unroll
        for (int bj = 0; bj < 2; ++bj)
#pragma unroll
          for (int n = 0; n < 2; ++n)
            *(f32x4*)(dst + (size_t)row * ld + bcol + bj * 128 + wc * 32 + n * 16 + fq * 4) = acc[ai][bj][m][n];
      }
  }
};

struct EpiResid {
  float* dst; const float* base; const float* gate;
  DI void operator()(const AccT& acc, int brow, int bcol, int wr, int wc, int fr, int fq) const {
#pragma unroll
    for (int ai = 0; ai < 2; ++ai)
#pragma unroll
      for (int m = 0; m < 4; ++m) {
        const int row = brow + ai * 128 + wr * 64 + m * 16 + fr;
        const int b = row >> 12;
#pragma unroll
        for (int bj = 0; bj < 2; ++bj)
#pragma unroll
          for (int n = 0; n < 2; ++n) {
            const int col = bcol + bj * 128 + wc * 32 + n * 16 + fq * 4;
            const f32x4 xv = __builtin_nontemporal_load((const f32x4*)(base + (size_t)row * 2048 + col));
            const f32x4 gv = *(const f32x4*)(gate + b * 12288 + col);
            *(f32x4*)(dst + (size_t)row * 2048 + col) = xv + gv * acc[ai][bj][m][n];
          }
      }
  }
};

struct EpiSwiglu {
  bf16_t* act;
  DI void operator()(const AccT& acc, int brow, int bcol, int wr, int wc, int fr, int fq) const {
    const int pn = bcol >> 8;
#pragma unroll
    for (int ai = 0; ai < 2; ++ai)
#pragma unroll
      for (int m = 0; m < 4; ++m) {
        const int row = brow + ai * 128 + wr * 64 + m * 16 + fr;
        float r[8];
#pragma unroll
        for (int n = 0; n < 2; ++n) {
          const f32x4 gt = acc[ai][0][m][n], up = acc[ai][1][m][n];
#pragma unroll
          for (int j = 0; j < 4; ++j) r[n * 4 + j] = silu_fast(gt[j]) * up[j];
        }
        *(u32x4*)(act + (size_t)row * DFF + pn * 128 + wc * 32 + fq * 8) = (u32x4){pack2(r[0], r[1]), pack2(r[2], r[3]), pack2(r[4], r[5]), pack2(r[6], r[7])};
      }
  }
};

DI int map_win(int c, int& lo_row) {
  lo_row = -1;
  if (c < 2048) return (c & ~255) + perm256(c & 255);
  if (c < 3072) return c;
  if (c < 3080) return 5632 + (c - 3072);
  if (c < 4104) { int cc = c - 3080; int d = 3072 + (cc & ~255) + perm256(cc & 255); lo_row = d - 3072; return d; }
  if (c < 4360) { int cc = c - 4104; int d = 4096 + perm256(cc); lo_row = d - 3072; return d; }
  if (c < 4616) { int cc = c - 4360; return 4352 + perm256(cc); }
  if (c < 4872) { int cc = c - 4616; return 4608 + perm256(cc); }
  if (c < 5128) return 4864 + (c - 4872);
  if (c < 5384) { int cc = c - 5128; return 5120 + perm256(cc); }
  if (c < 5640) return 5376 + (c - 5384);
  return c;
}

struct TInfo { const float* src; bf16_t* dh; bf16_t* dl; int N, Kd, mat, k0, n0; };
constexpr int TJ_WIN = 16 * 89, TJ_WOUT = 16 * 32, TJ_WG = 16 * 88, TJ_WD = 44 * 32, TJ_W1 = 32 * 4;
constexpr int TE0 = TJ_WIN, TE1 = TE0 + TJ_WOUT, TE2 = TE1 + TJ_WG, TE3 = TE2 + TJ_WG, TE4 = TE3 + TJ_WD, TE5 = TE4 + TJ_W1, TE6 = TE5 + TJ_W1;
DI void tile_info(const Params& p, int t, TInfo& ti) {
  char* ws = p.ws; ti.dl = nullptr; int nn;
  if (t < TE0) { ti.mat = 0; ti.src = p.w_in; ti.N = DIN; ti.Kd = 2048; ti.dh = (bf16_t*)(ws + OFF_WIN_HI); ti.dl = (bf16_t*)(ws + OFF_WIN_LO); nn = 89; }
  else if (t < TE1) { t -= TE0; ti.mat = 1; ti.src = p.w_out; ti.N = 2048; ti.Kd = 2048; ti.dh = (bf16_t*)(ws + OFF_WOUT); nn = 32; }
  else if (t < TE2) { t -= TE1; ti.mat = 2; ti.src = p.w_gate; ti.N = DFF; ti.Kd = 2048; ti.dh = (bf16_t*)(ws + OFF_WGU); nn = 88; }
  else if (t < TE3) { t -= TE2; ti.mat = 3; ti.src = p.w_up; ti.N = DFF; ti.Kd = 2048; ti.dh = (bf16_t*)(ws + OFF_WGU); nn = 88; }
  else if (t < TE4) { t -= TE3; ti.mat = 4; ti.src = p.w_down; ti.N = 2048; ti.Kd = DFF; ti.dh = (bf16_t*)(ws + OFF_WDN); nn = 32; }
  else if (t < TE5) { t -= TE4; ti.mat = 5; ti.src = p.w_kc1; ti.N = 256; ti.Kd = 4096; ti.dh = (bf16_t*)(ws + OFF_W1K_HI); ti.dl = (bf16_t*)(ws + OFF_W1K_LO); nn = 4; }
  else { t -= TE5; ti.mat = 6; ti.src = p.w_vc1; ti.N = 256; ti.Kd = 4096; ti.dh = (bf16_t*)(ws + OFF_W1V); nn = 4; }
  ti.k0 = (t / nn) * 128; ti.n0 = (t % nn) * 64;
}
DI void tr_load(const TInfo& ti, int tid, f32x4 (&r)[4]) {
#pragma unroll
  for (int i = 0; i < 4; ++i) {
    const int idx = tid + i * 512, k = idx >> 4, col = ti.n0 + (idx & 15) * 4;
    r[i] = col < ti.N ? __builtin_nontemporal_load((const f32x4*)(ti.src + (size_t)(ti.k0 + k) * ti.N + col)) : (f32x4){0.f, 0.f, 0.f, 0.f};
  }
}
DI void tr_lds_write(float* tile, int tid, const f32x4 (&r)[4]) {
#pragma unroll
  for (int i = 0; i < 4; ++i) {
    const int idx = tid + i * 512, k = idx >> 4, c = (idx & 15) * 4;
#pragma unroll
    for (int j = 0; j < 4; ++j) tile[k * 65 + c + j] = r[i][j];
  }
}
DI void tr_store(const TInfo& ti, const float* tile, int tid) {
#pragma unroll
  for (int i = 0; i < 2; ++i) {
    const int idx = tid + i * 512, nr = idx >> 4, kc = idx & 15, col = ti.n0 + nr;
    if (col < ti.N) {
      int row, lrow = -1;
      if (ti.mat == 0) row = map_win(col, lrow);
      else if (ti.mat == 2) row = (col >> 7) * 256 + perm_gu(col & 127);
      else if (ti.mat == 3) row = (col >> 7) * 256 + 128 + perm_gu(col & 127);
      else { row = col; if (ti.mat == 5) lrow = col; }
      float v[8];
#pragma unroll
      for (int e = 0; e < 8; ++e) v[e] = tile[(kc * 8 + e) * 65 + nr];
      const u32x4 hv = (u32x4){pack2(v[0], v[1]), pack2(v[2], v[3]), pack2(v[4], v[5]), pack2(v[6], v[7])};
      if (ti.mat >= 2 && ti.mat <= 4) __builtin_nontemporal_store(hv, (u32x4*)(ti.dh + (size_t)row * ti.Kd + ti.k0 + kc * 8));
      else *(u32x4*)(ti.dh + (size_t)row * ti.Kd + ti.k0 + kc * 8) = hv;
      if (lrow >= 0)
        *(u32x4*)(ti.dl + (size_t)lrow * ti.Kd + ti.k0 + kc * 8) = (u32x4){pack2(lo_of(v[0]), lo_of(v[1])), pack2(lo_of(v[2]), lo_of(v[3])), pack2(lo_of(v[4]), lo_of(v[5])), pack2(lo_of(v[6]), lo_of(v[7]))};
    }
  }
}
DI void transpose_all(const Params& p) {
  float* lds = (float*)g_smem;
  int tid = threadIdx.x; asm volatile("" : "+v"(tid));
  const int G = gridDim.x;
  int t0 = blockIdx.x, t1 = t0 + G;
  TInfo ia, ib; f32x4 ra[4], rb[4];
  if (t0 < TE6) { tile_info(p, t0, ia); tr_load(ia, tid, ra); }
  if (t1 < TE6) { tile_info(p, t1, ib); tr_load(ib, tid, rb); }
  while (t0 < TE6) {
    tr_lds_write(lds, tid, ra);
    __syncthreads();
    const TInfo cura = ia;
    const int t2 = t0 + 2 * G;
    if (t2 < TE6) { tile_info(p, t2, ia); tr_load(ia, tid, ra); }
    tr_store(cura, lds, tid);
    if (t1 >= TE6) break;
    tr_lds_write(lds + 128 * 65, tid, rb);
    __syncthreads();
    const TInfo curb = ib;
    const int t3 = t1 + 2 * G;
    if (t3 < TE6) { tile_info(p, t3, ib); tr_load(ib, tid, rb); }
    tr_store(curb, lds + 128 * 65, tid);
    t0 = t2; t1 = t3;
  }
  __syncthreads();
}

DI void mod_job(const Params& p, int job) {
  float* sc = (float*)g_smem;
  float* red = sc + 4096;
  const int tid = threadIdx.x, wave = tid >> 6, lane = tid & 63;
  for (int i = tid; i < 4096; i += 512) sc[i] = siluf_(p.c[i]);
  __syncthreads();
  const int n0 = job * 64, cgp = lane & 15, kr = lane >> 4;
  f32x4 a0 = {0.f, 0.f, 0.f, 0.f}, a1 = {0.f, 0.f, 0.f, 0.f};
#pragma unroll 8
  for (int k = wave * 4 + kr; k < 2048; k += 32) {
    const f32x4 wv = __builtin_nontemporal_load((const f32x4*)(p.w_ada + (size_t)k * 12288 + n0 + cgp * 4));
    a0 += wv * sc[k]; a1 += wv * sc[2048 + k];
  }
#pragma unroll
  for (int j = 0; j < 4; ++j) {
    a0[j] += __shfl_xor(a0[j], 16); a0[j] += __shfl_xor(a0[j], 32);
    a1[j] += __shfl_xor(a1[j], 16); a1[j] += __shfl_xor(a1[j], 32);
  }
  if (kr == 0) {
#pragma unroll
    for (int j = 0; j < 4; ++j) { red[(wave * 2 + 0) * 64 + cgp * 4 + j] = a0[j]; red[(wave * 2 + 1) * 64 + cgp * 4 + j] = a1[j]; }
  }
  __syncthreads();
  if (tid < 128) {
    const int b = tid >> 6, col = tid & 63;
    float s = p.b_ada[n0 + col];
#pragma unroll
    for (int w = 0; w < 8; ++w) s += red[(w * 2 + b) * 64 + col];
    ((float*)(p.ws + OFF_MOD))[b * 12288 + n0 + col] = s;
  }
  __syncthreads();
}

DI void bias1_job(const Params& p, int j) {
  const int which = j >> 4, chunk = j & 15;
  const float* w1 = which ? p.w_vc1 : p.w_kc1;
  float* red = (float*)g_smem;
  const int tid = threadIdx.x, col = tid & 255, half = tid >> 8;
  float s = 0.f;
  const int kb = chunk * 256 + half * 128;
#pragma unroll 16
  for (int k = kb; k < kb + 128; ++k) s += p.cmp_pos[k] * w1[(size_t)k * 256 + col];
  red[tid] = s;
  __syncthreads();
  if (tid < 256) ((float*)(p.ws + OFF_BIAS1))[(which * 16 + chunk) * 256 + tid] = red[tid] + red[tid + 256];
  __syncthreads();
}

DI void rope_job(const Params& p, int job) {
  const int idx = job * 512 + threadIdx.x, token = idx >> 6, i = idx & 63;
  const float ang = (float)p.pos[token] * c_inv_freq[i];
  double t = (double)ang * 0.15915494309189535;
  t -= floor(t + 0.5);
  const float tf = (float)t;
  ((float*)(p.ws + OFF_COS))[idx] = __builtin_amdgcn_cosf(tf);
  ((float*)(p.ws + OFF_SIN))[idx] = __builtin_amdgcn_sinf(tf);
}

DI void phase0(const Params& p) {
  transpose_all(p);
  constexpr int J_MOD = 192, J_B1 = 32, J_ROPE = 1024;
  for (int job = blockIdx.x; job < J_MOD + J_B1 + J_ROPE; job += gridDim.x) {
    if (job < J_MOD) mod_job(p, job);
    else if (job < J_MOD + J_B1) bias1_job(p, job - J_MOD);
    else rope_job(p, job - J_MOD - J_B1);
  }
}

DI void rmsmod_phase(const float* src, const float* g, const float* mod, int sh_off, int sc_off, bf16_t* dhi, bf16_t* dlo, bool nt_src) {
  const int wave = threadIdx.x >> 6, lane = threadIdx.x & 63;
  for (int row = blockIdx.x * 8 + wave; row < T_TOK; row += gridDim.x * 8) {
    const int b = row >> 12;
    const f32x4* xr = (const f32x4*)(src + (size_t)row * 2048);
    f32x4 v[8]; float ss = 0.f;
#pragma unroll
    for (int i = 0; i < 8; ++i) { v[i] = nt_src ? __builtin_nontemporal_load(xr + lane + i * 64) : xr[lane + i * 64]; ss += v[i][0] * v[i][0] + v[i][1] * v[i][1] + v[i][2] * v[i][2] + v[i][3] * v[i][3]; }
    ss = wave_sum(ss);
    const float rstd = rsqrtf(ss * (1.f / 2048.f) + 1e-6f);
#pragma unroll
    for (int i = 0; i < 8; ++i) {
      const int col = (lane + i * 64) * 4;
      const f32x4 gv = *(const f32x4*)(g + col);
      const f32x4 sc = *(const f32x4*)(mod + b * 12288 + sc_off + col), sh = *(const f32x4*)(mod + b * 12288 + sh_off + col);
      f32x4 u = (v[i] * rstd) * gv; u = u * (1.f + sc) + sh;
      unsigned h0, h1, l0, l1; split2(u[0], u[1], h0, l0); split2(u[2], u[3], h1, l1);
      *(u32x2*)(dhi + (size_t)row * 2048 + col) = (u32x2){h0, h1};
      if (dlo) *(u32x2*)(dlo + (size_t)row * 2048 + col) = (u32x2){l0, l1};
    }
  }
}

DI void ymix_phase(const Params& p) {
  const int wave = threadIdx.x >> 6, lane = threadIdx.x & 63;
  bf16_t* ym = (bf16_t*)(p.ws + OFF_U_HI);
  for (int row = blockIdx.x * 8 + wave; row < T_TOK; row += gridDim.x * 8) {
#pragma unroll
    for (int part = 0; part < 2; ++part) {
      const f32x4* xr = (const f32x4*)((const float*)(p.ws + (part ? OFF_ON32 : OFF_OF32)) + (size_t)row * 1024);
      const float* beta = part ? p.beta_nsa : p.beta_fox;
      f32x4 v[4]; float ss = 0.f;
#pragma unroll
      for (int i = 0; i < 4; ++i) { v[i] = __builtin_nontemporal_load(xr + lane + i * 64); ss += v[i][0] * v[i][0] + v[i][1] * v[i][1] + v[i][2] * v[i][2] + v[i][3] * v[i][3]; }
      ss = wave_sum(ss);
      const float rstd = rsqrtf(ss * (1.f / 1024.f) + 1e-6f);
#pragma unroll
      for (int i = 0; i < 4; ++i) {
        const int col = (lane + i * 64) * 4;
        const f32x4 u = (v[i] * rstd) * *(const f32x4*)(beta + col);
        *(u32x2*)(ym + (size_t)row * 2048 + part * 1024 + col) = (u32x2){pack2(u[0], u[1]), pack2(u[2], u[3])};
      }
    }
  }
}

DI void final_phase(const Params& p) {
  const int wave = threadIdx.x >> 6, lane = threadIdx.x & 63;
  for (int row = blockIdx.x * 8 + wave; row < T_TOK; row += gridDim.x * 8) {
    f32x4* xr = (f32x4*)(p.out + (size_t)row * 2048);
    f32x4 v[8]; float ss = 0.f;
#pragma unroll
    for (int i = 0; i < 8; ++i) { v[i] = __builtin_nontemporal_load(xr + lane + i * 64); ss += v[i][0] * v[i][0] + v[i][1] * v[i][1] + v[i][2] * v[i][2] + v[i][3] * v[i][3]; }
    ss = wave_sum(ss);
    const float rstd = rsqrtf(ss * (1.f / 2048.f) + 1e-6f);
#pragma unroll
    for (int i = 0; i < 8; ++i) __builtin_nontemporal_store((v[i] * rstd) * *(const f32x4*)(p.final_norm + (lane + i * 64) * 4), xr + lane + i * 64);
  }
}

typedef float f32x4_ __attribute__((ext_vector_type(4)));
DI void misc_job(const Params& p, int piece) {
  char* ws = p.ws;
  int tid = threadIdx.x; asm volatile("" : "+v"(tid));
  const int wave = tid >> 6, lane = tid & 63, fr = lane & 15, fq = lane >> 4;
  const bf16_t* A = (const bf16_t*)(ws + OFF_U_HI) + (size_t)(piece * 32 + fr) * 2048 + fq * 8 + wave * 256;
  const bf16_t* B = (const bf16_t*)(ws + OFF_WIN_HI) + (size_t)(5632 + fr) * 2048 + fq * 8 + wave * 256;
  f32x4 acc[2][2] = {};
#pragma unroll
  for (int k = 0; k < 8; ++k) {
    const bf16x8 a0 = *(const bf16x8*)(A + k * 32), a1 = *(const bf16x8*)(A + 16 * 2048 + k * 32);
    const bf16x8 b0 = *(const bf16x8*)(B + k * 32), b1 = *(const bf16x8*)(B + 16 * 2048 + k * 32);
    acc[0][0] = __builtin_amdgcn_mfma_f32_16x16x32_bf16(a0, b0, acc[0][0], 0, 0, 0);
    acc[0][1] = __builtin_amdgcn_mfma_f32_16x16x32_bf16(a0, b1, acc[0][1], 0, 0, 0);
    acc[1][0] = __builtin_amdgcn_mfma_f32_16x16x32_bf16(a1, b0, acc[1][0], 0, 0, 0);
    acc[1][1] = __builtin_amdgcn_mfma_f32_16x16x32_bf16(a1, b1, acc[1][1], 0, 0, 0);
  }
  f32x4* red = (f32x4*)g_smem;
#pragma unroll
  for (int q = 0; q < 4; ++q) red[(wave * 4 + q) * 64 + lane] = acc[q >> 1][q & 1];
  __syncthreads();
  if (tid < 256) {
    const int q = tid >> 6, l = tid & 63, mb = q >> 1, nb = q & 1, fr2 = l & 15, fq2 = l >> 4;
    f32x4 sum = red[q * 64 + l];
#pragma unroll
    for (int w = 1; w < 8; ++w) sum += red[(w * 4 + q) * 64 + l];
    const int col = nb * 16 + fr2;
#pragma unroll
    for (int j = 0; j < 4; ++j) {
      const int token = piece * 32 + mb * 16 + fq2 * 4 + j;
      if (col < 8) ((float*)(ws + OFF_LOGF))[token * 8 + col] = log_sigmoid(sum[j] + p.b_fgate[col]);
      else ((float*)(ws + OFF_GATES))[token * 24 + col - 8] = sigmoidf_(sum[j]);
    }
  }
  __syncthreads();
}
DI void inproj_heavy(const Params& p, int job) {
  char* ws = p.ws;
  const bf16_t* uhi = (const bf16_t*)(ws + OFF_U_HI); const bf16_t* ulo = (const bf16_t*)(ws + OFF_U_LO);
  const bf16_t* whi = (const bf16_t*)(ws + OFF_WIN_HI); const bf16_t* wlo = (const bf16_t*)(ws + OFF_WIN_LO);
  const int pn = 12 + job / 32, pm = job % 32;
  GemmOp g; g.lda = 2048; g.ldb = 2048;
  g.A0 = uhi; g.A1 = uhi; g.A2 = ulo; g.B0 = whi; g.B1 = wlo - (size_t)3072 * 2048; g.B2 = whi; g.nt = 96; g.shift = 5;
  EpiInproj e{&p, pn};
  gemm_tile(g, pm * 256, pn * 256, e);
}
DI void inproj_light(const Params& p, int L) {
  char* ws = p.ws;
  const bf16_t* uhi = (const bf16_t*)(ws + OFF_U_HI); const bf16_t* whi = (const bf16_t*)(ws + OFF_WIN_HI);
  GemmOp g; g.lda = 2048; g.ldb = 2048; g.nt = 32; g.shift = 5;
  if (L < 352) {
    const int t = L / 32, pm = L % 32;
    const int pn = t < 8 ? t : (t == 8 ? 17 : (t == 9 ? 18 : 20));
    g.A0 = g.A1 = g.A2 = uhi; g.B0 = g.B1 = g.B2 = whi;
    EpiInproj e{&p, pn};
    gemm_tile(g, pm * 256, pn * 256, e);
  } else {
    const int j = L - 352, rt = j / 32, tt = j % 32;
    int wrow; bf16_t* dst; int nh, sec0;
    if (rt < 4) { wrow = 2048 + rt * 256; dst = (bf16_t*)(ws + OFF_VFT); nh = 8; sec0 = 2048; }
    else if (rt == 4) { wrow = 4864; dst = (bf16_t*)(ws + OFF_VST); nh = 2; sec0 = 4864; }
    else { wrow = 5376; dst = (bf16_t*)(ws + OFF_VWT); nh = 2; sec0 = 5376; }
    g.A0 = g.A1 = g.A2 = whi; g.B0 = g.B1 = g.B2 = uhi;
    EpiVT e{dst, nh, sec0};
    gemm_tile(g, wrow, tt * 256, e);
  }
}
DI void inproj_phase(const Params& p, bool dry) {
  if (gridDim.x == 256) {
    const int c = blockIdx.x;
    if (c < 160) { inproj_heavy(p, c); inproj_light(p, c); }
    else { for (int i = 0; i < 4; ++i) inproj_light(p, 160 + (c - 160) * 4 + i); }
    if (!dry) misc_job(p, c);
  } else {
    FOR_JOBS(job, 160) inproj_heavy(p, job);
    FOR_JOBS(job, 544) inproj_light(p, job);
    FOR_JOBS(job, 256) misc_job(p, job);
  }
}

constexpr int KSTR = 272, VSTR = 264;
constexpr int ST_K = 0, ST_V = 128 * KSTR, ST_C = ST_V + 128 * VSTR, ST_SIZE = ST_C + 512;
constexpr int LDS_LIST = 2 * ST_SIZE;

DI bf16x8 pack8(const f32x16& x, int s) {
  u32x4 r;
  r[0] = pack2(x[8 * s + 0], x[8 * s + 1]); r[1] = pack2(x[8 * s + 2], x[8 * s + 3]);
  r[2] = pack2(x[8 * s + 4], x[8 * s + 5]); r[3] = pack2(x[8 * s + 6], x[8 * s + 7]);
  return __builtin_bit_cast(bf16x8, r);
}
DI bf16x8 ldv8(const char* p) {
  const u32x2 a = *(const u32x2*)p, b = *(const u32x2*)(p + 16);
  u32x4 r = {a[0], a[1], b[0], b[1]};
  return __builtin_bit_cast(bf16x8, r);
}

constexpr int AS_K = 0, AS_V = 32768, AS_C = 65536, AS_SIZE = 66048;
constexpr int LDS_LIST2 = 2 * AS_SIZE;
DI int pi23(int r) { return (r & ~12) | ((r & 4) << 1) | ((r & 8) >> 1); }
template <int MODE>
DI void attn_unit(const Params& p, int b, int hg, int qt, bool dry = false) {
  char* ws = p.ws;
  int tid = threadIdx.x; asm volatile("" : "+v"(tid));
  const int wave = tid >> 6, lane = tid & 63, l32 = lane & 31, hh = lane >> 5, rg = wave & 3, kh = wave >> 2;
  int token, head; const bf16_t *qrow, *kbase, *vbase; int kstride;
  if (MODE == 0) {
    token = qt * 128 + rg * 32 + l32; head = hg;
    qrow = (const bf16_t*)(ws + OFF_QF) + (size_t)(b * 4096 + token) * 1024 + head * 128;
    kbase = (const bf16_t*)(ws + OFF_KF) + (size_t)b * 4096 * 1024 + head * 128; kstride = 1024;
    vbase = (const bf16_t*)(ws + OFF_VFT) + (size_t)(b * 8 + head) * 128 * 4096;
  } else {
    if (MODE == 1) { token = qt * 32 + l32; head = hg * 4 + rg; }
    else { token = qt * 32 + rg * 8 + (l32 >> 2); head = hg * 4 + (l32 & 3); }
    qrow = (const bf16_t*)(ws + OFF_QN_HI) + (size_t)(b * 4096 + token) * 1024 + head * 128;
    kbase = (const bf16_t*)(ws + (MODE == 1 ? OFF_KW : OFF_KS)) + (size_t)(b * 2 + hg) * 4096 * 128; kstride = 128;
    vbase = (const bf16_t*)(ws + (MODE == 1 ? OFF_VWT : OFF_VST)) + (size_t)(b * 2 + hg) * 128 * 4096;
  }
  const int wtmin = MODE == 0 ? qt * 128 + rg * 32 : (MODE == 1 ? qt * 32 : qt * 32 + rg * 8), wtmax = wtmin + (MODE == 2 ? 7 : 31);
  int nst, kv_start = 0;
  int* list = (int*)(g_smem + LDS_LIST2);
  unsigned long long selmask = 0;
  if (MODE == 0) nst = qt + 1;
  else if (MODE == 1) { int lo = qt * 32 - 511; if (lo < 0) lo = 0; kv_start = lo & ~63; nst = (qt * 32 + 32 - kv_start + 127) >> 7; }
  else {
    const unsigned long long* sel = (const unsigned long long*)(ws + OFF_SEL) + (size_t)(b * 2 + hg) * 4096;
    selmask = sel[token];
    if (wave == 0) {
      const unsigned long long sm0 = sel[qt * 32 + l32];
      unsigned lo = (unsigned)sm0, hi = (unsigned)(sm0 >> 32);
#pragma unroll
      for (int o = 16; o > 0; o >>= 1) { lo |= __shfl_xor(lo, o); hi |= __shfl_xor(hi, o); }
      const unsigned long long um = ((unsigned long long)hi << 32) | lo;
      if ((um >> lane) & 1ull) list[1 + __popcll(um & ((1ull << lane) - 1ull))] = lane;
      if (lane == 0) list[0] = __popcll(um);
    }
    __syncthreads();
    nst = (list[0] + 1) >> 1;
  }
  bf16x8 qf[8];
#pragma unroll
  for (int ks = 0; ks < 8; ++ks) qf[ks] = *(const bf16x8*)(qrow + ks * 16 + hh * 8);
  float cumq = 0.f;
  const float* cumrow = nullptr;
  if (MODE == 0) { cumrow = (const float*)(ws + OFF_CUM) + (size_t)(b * 8 + head) * 4096; cumq = cumrow[token]; }

  f32x16 o[4];
#pragma unroll
  for (int i = 0; i < 4; ++i) o[i] = zero16();
  float mrun = -1e30f, lrun = 0.f;

  auto tile_base = [&](int it, int half) -> int {
    if (MODE == 2) { const int i = 2 * it + half; return i < list[0] ? list[1 + i] * 64 : -1; }
    return kv_start + it * 128 + half * 64;
  };
  const int rsub = lane >> 4, slot = lane & 15;
  unsigned koff[4], voff[4]; bool vhalf[4];
#pragma unroll
  for (int j = 0; j < 4; ++j) {
    const int row = (j * 8 + wave) * 4 + rsub;
    const int c = slot ^ (row & 15);
    koff[j] = (unsigned)(pi23(row & 63) * kstride + c * 8) * 2u;
    vhalf[j] = (c >> 3) != 0;
    voff[j] = MODE == 2 ? (unsigned)(row * 4096 + (c & 7) * 8) * 2u : (unsigned)(row * 4096 + c * 8) * 2u;
  }
  auto issue_stage = [&](int it, int buf) {
    if (DRY_MODE == 2 && dry) return;
    int kb0 = tile_base(it, 0), kb1 = tile_base(it, 1);
    if (kb1 < 0) kb1 = 0;
    char* sb = g_smem + buf * AS_SIZE;
    const char* kp0 = uptr((const char*)(kbase + (size_t)kb0 * kstride));
    const char* kp1 = uptr((const char*)(kbase + (size_t)kb1 * kstride));
    const char* vp0 = uptr((const char*)(vbase + kb0));
    const char* vp1 = uptr((const char*)(vbase + kb1));
#pragma unroll
    for (int j = 0; j < 4; ++j) {
      __builtin_amdgcn_global_load_lds((const unsigned*)((j >> 1 ? kp1 : kp0) + koff[j]), (unsigned*)(sb + AS_K + (j * 8 + wave) * 1024 + lane * 16), 16, 0, 0);
      const char* vsrc = MODE == 2 ? ((vhalf[j] ? vp1 : vp0) + voff[j]) : (vp0 + voff[j]);
      __builtin_amdgcn_global_load_lds((const unsigned*)vsrc, (unsigned*)(sb + AS_V + (j * 8 + wave) * 1024 + lane * 16), 16, 0, 0);
    }
    if (MODE == 0 && wave < 2) {
      const int key = (wave ? kb1 : kb0) + lane;
      __builtin_amdgcn_global_load_lds((const unsigned*)(cumrow + key), (unsigned*)(sb + AS_C + wave * 256 + lane * 4), 4, 0, 0);
    }
  };

  int it0 = 0;
  if (MODE == 0) {
    float q2 = 0.f;
#pragma unroll
    for (int ks = 0; ks < 8; ++ks)
#pragma unroll
      for (int e = 0; e < 8; ++e) { const float f = bf2f((unsigned short)qf[ks][e]); q2 += f * f; }
    q2 = xsum32(q2);
#pragma unroll
    for (int o2 = 16; o2 > 0; o2 >>= 1) q2 = fmaxf(q2, __shfl_xor(q2, o2));
    const float* kn = (const float*)(ws + OFF_KNORM) + (size_t)(b * 8 + head) * 128;
    float k2 = fmaxf(kn[lane], kn[lane + 64]);
#pragma unroll
    for (int o2 = 32; o2 > 0; o2 >>= 1) k2 = fmaxf(k2, __shfl_xor(k2, o2));
    float* qx = (float*)(g_smem + LDS_LIST2);
    if (lane == 0) qx[wave] = q2;
    __syncthreads();
    const float q2m = fmaxf(fmaxf(qx[0], qx[1]), fmaxf(qx[2], qx[3]));
    const float xub = sqrtf(q2m * k2) * (QK_C1 * 1.001f) + 0.01f;
    const float cend = lane < qt ? cumrow[lane * 128 + 127] : cumrow[qt * 128];
    const float bub = (cumrow[qt * 128] - cend) * LOG2E;
    const bool skip = lane < qt && (2.f * xub + bub < -160.f);
    const unsigned long long sk = __ballot(skip);
    it0 = (int)__builtin_ctzll(~sk);
    if (it0 > qt) it0 = qt;
    it0 = __builtin_amdgcn_readfirstlane(it0);
  }
#pragma unroll
  for (int ks = 0; ks < 8; ++ks) asm volatile("" :: "v"(qf[ks]));
  asm volatile("" :: "v"(cumq));
  issue_stage(it0, it0 & 1);
  for (int it = it0; it < nst; ++it) {
    asm volatile("s_waitcnt vmcnt(0)" ::: "memory");
    __builtin_amdgcn_s_barrier();
    if (it + 1 < nst) issue_stage(it + 1, (it + 1) & 1);
    const char* sb = g_smem + (it & 1) * AS_SIZE;
    const int kbh = tile_base(it, kh);
    bool active;
    if (MODE == 0) active = kbh <= wtmax;
    else if (MODE == 1) active = kbh <= wtmax && kbh + 63 >= wtmin - 511;
    else active = kbh >= 0;
    if (DRY_MODE == 1 && dry) active = false;
    const bool selbit = (MODE == 2 && kbh >= 0) ? ((selmask >> (kbh >> 6)) & 1ull) != 0 : true;
    if (MODE == 2) active = active && __any(selbit);
    if (active) {
      f32x16 stA = zero16(), stB = zero16();
      {
        const int row = kh * 64 + l32;
        const char* kp = sb + AS_K + row * 256;
        const int sw = row & 15;
#pragma unroll
        for (int ks = 0; ks < 8; ++ks) stA = mfma32(*(const bf16x8*)(kp + (((ks * 2 + hh) ^ sw) << 4)), qf[ks], stA);
#pragma unroll
        for (int ks = 0; ks < 8; ++ks) stB = mfma32(*(const bf16x8*)(kp + 32 * 256 + (((ks * 2 + hh) ^ sw) << 4)), qf[ks], stB);
      }
      const int tq0 = token - kbh - hh * 8;
      bf16x8 pk0, pk1;
#define ATTN_SOFTMAX(ST, KB2) do { \
        const int kmin = kbh + (KB2) * 32, kmax = kmin + 31; \
        if (MODE == 0) { \
          f32x16 cs16; \
          _Pragma("unroll") for (int gq = 0; gq < 4; ++gq) { \
            const f32x4 cs = *(const f32x4*)(sb + AS_C + (kh * 64 + (KB2) * 32 + (gq >> 1) * 16 + hh * 8 + (gq & 1) * 4) * 4); \
            cs16[gq * 4] = cs[0]; cs16[gq * 4 + 1] = cs[1]; cs16[gq * 4 + 2] = cs[2]; cs16[gq * 4 + 3] = cs[3]; } \
          ST = ST * QK_C1 + (cs16 * (-LOG2E) + cumq * LOG2E); \
        } else ST = ST * QK_C1; \
        bool need_mask; \
        if (MODE == 0) need_mask = kmax > wtmin; \
        else if (MODE == 1) need_mask = kmax > wtmin || wtmax - kmin >= 512; \
        else need_mask = (kbh >> 6) == (wtmin >> 6); \
        if (need_mask) { \
          _Pragma("unroll") for (int gq = 0; gq < 4; ++gq) _Pragma("unroll") for (int j = 0; j < 4; ++j) { \
            const int kofs = (KB2) * 32 + (gq >> 1) * 16 + (gq & 1) * 4 + j; \
            bool valid = kofs <= tq0; \
            if (MODE == 1) valid = valid && (tq0 - kofs < 512); \
            ST[gq * 4 + j] = valid ? ST[gq * 4 + j] : -1e30f; } } \
        float mx = ST[0]; \
        _Pragma("unroll") for (int r = 1; r < 16; ++r) mx = fmaxf(mx, ST[r]); \
        mx = xmax32(mx); \
        if (MODE == 2) mx = selbit ? mx : -1e30f; \
        const float mnew = (mx > mrun + 8.f) ? mx : mrun;        \
        if (__any(mnew != mrun)) { \
          const float alpha = fexp2(mrun - mnew); \
          lrun *= alpha; \
          _Pragma("unroll") for (int i = 0; i < 4; ++i) o[i] = o[i] * alpha; } \
        mrun = mnew; \
        const float msub = (mnew > -1e29f && selbit) ? mnew : 1e30f; \
        ST = ST - msub; \
        float rs = 0.f; \
        _Pragma("unroll") for (int r = 0; r < 16; ++r) { ST[r] = fexp2(ST[r]); rs += ST[r]; } \
        rs = xsum32(rs); \
        lrun += rs; \
        pk0 = pack8(ST, 0); pk1 = pack8(ST, 1); } while (0)
#define ATTN_PV(KB2) do { \
        _Pragma("unroll") for (int dblk = 0; dblk < 4; ++dblk) { \
          const int d = dblk * 32 + l32; \
          const char* vp = sb + AS_V + d * 256; \
          const int sw = d & 15; \
          o[dblk] = mfma32(*(const bf16x8*)(vp + (((kh * 8 + (KB2) * 4 + hh) ^ sw) << 4)), pk0, o[dblk]); \
          o[dblk] = mfma32(*(const bf16x8*)(vp + (((kh * 8 + (KB2) * 4 + 2 + hh) ^ sw) << 4)), pk1, o[dblk]); } } while (0)
      ATTN_SOFTMAX(stA, 0);
      ATTN_PV(0);
      ATTN_SOFTMAX(stB, 1);
      ATTN_PV(1);
#undef ATTN_SOFTMAX
#undef ATTN_PV
    }
  }
  __syncthreads();
  float* X = (float*)g_smem;
  if (kh == 1) {
#pragma unroll
    for (int i = 0; i < 4; ++i)
#pragma unroll
      for (int r = 0; r < 16; ++r) X[(rg * 66 + i * 16 + r) * 64 + lane] = o[i][r];
    X[(rg * 66 + 64) * 64 + lane] = mrun; X[(rg * 66 + 65) * 64 + lane] = lrun;
  }
  __syncthreads();
  float* Tt = (float*)(g_smem + 67584);
  if (kh == 0) {
    const float m1 = X[(rg * 66 + 64) * 64 + lane], l1 = X[(rg * 66 + 65) * 64 + lane];
    const float mf = fmaxf(mrun, m1);
    const float a0 = fexp2(mrun - mf), a1 = fexp2(m1 - mf);
    const float lt = lrun * a0 + l1 * a1;
    float inv = lt > 0.f ? 1.f / lt : 0.f;
    if (MODE != 0) inv *= ((const float*)(ws + OFF_GATES))[(size_t)(b * 4096 + token) * 24 + head * 3 + (MODE == 1 ? 2 : 1)];
    const float s0 = a0 * inv, s1 = a1 * inv;
    float* trow = Tt + (rg * 32 + l32) * 132;
#pragma unroll
    for (int i = 0; i < 4; ++i)
#pragma unroll
      for (int gq = 0; gq < 4; ++gq) {
        f32x4 v;
#pragma unroll
        for (int j = 0; j < 4; ++j) v[j] = o[i][gq * 4 + j] * s0 + X[(rg * 66 + i * 16 + gq * 4 + j) * 64 + lane] * s1;
        *(f32x4*)(trow + i * 32 + 8 * gq + 4 * hh) = v;
      }
  }
  __syncthreads();
  if (!dry) {
    float* obase = (float*)(ws + (MODE == 0 ? OFF_OF32 : OFF_ON32)) + (size_t)b * 4096 * 1024;
#pragma unroll
    for (int k = 0; k < 8; ++k) {
      const int R = wave * 16 + k * 2 + (lane >> 5), rgr = R >> 5, rr = R & 31, c4 = (lane & 31) * 4;
      int tk, hd;
      if (MODE == 0) { tk = qt * 128 + rgr * 32 + rr; hd = hg; }
      else if (MODE == 1) { tk = qt * 32 + rr; hd = hg * 4 + rgr; }
      else { tk = qt * 32 + rgr * 8 + (rr >> 2); hd = hg * 4 + (rr & 3); }
      float* dp = obase + (size_t)tk * 1024 + hd * 128 + c4;
      f32x4 v = *(const f32x4*)(Tt + R * 132 + c4);
      if (MODE == 2) v += *(const f32x4*)dp;
      *(f32x4*)dp = v;
    }
  }
  __syncthreads();
}

constexpr int CV_STR = 520;
constexpr int C_V = 0, C_K = 128 * CV_STR  , C_KLO = C_K + 128 * KSTR, C_EX = C_KLO + 128 * KSTR  ;
DI void cmp_unit(const Params& p, int b, int g, int qt, bool dry = false) {
  char* ws = p.ws;
  int tid = threadIdx.x; asm volatile("" : "+v"(tid));
  const int wave = tid >> 6, lane = tid & 63, l32 = lane & 31, hh = lane >> 5, rg = wave & 3, kh = wave >> 2;
  const int token = qt * 32 + l32, head = g * 4 + rg, bg = b * 2 + g;
  const bf16_t* qh = (const bf16_t*)(ws + OFF_QN_HI) + (size_t)(b * 4096 + token) * 1024 + head * 128;
  const bf16_t* ql = (const bf16_t*)(ws + OFF_QN_LO) + (size_t)(b * 4096 + token) * 1024 + head * 128;
  const bf16_t* kch = (const bf16_t*)(ws + OFF_KC_HI) + (size_t)bg * 256 * 128;
  const bf16_t* kcl = (const bf16_t*)(ws + OFF_KC_LO) + (size_t)bg * 256 * 128;
  const bf16_t* vct = (const bf16_t*)(ws + OFF_VCT) + (size_t)bg * 128 * 256;
  bf16x8 qfh[8], qfl[8];
#pragma unroll
  for (int ks = 0; ks < 8; ++ks) { qfh[ks] = *(const bf16x8*)(qh + ks * 16 + hh * 8); qfl[ks] = *(const bf16x8*)(ql + ks * 16 + hh * 8); }
#pragma unroll
  for (int i = 0; i < 8; ++i) {
    const int c = tid + i * 512, d = c >> 5, cc = c & 31;
    const u32x4 v = *(const u32x4*)(vct + (size_t)d * 256 + cc * 8);
    char* vd = g_smem + C_V + d * CV_STR + cc * 16;
    *(u32x2*)vd = (u32x2){v[0], v[1]}; *(u32x2*)(vd + 8) = (u32x2){v[2], v[3]};
  }
  f32x16 t4[4];
#pragma unroll
  for (int s = 0; s < 2; ++s) {
#pragma unroll
    for (int i = 0; i < 4; ++i) {
      const int c = tid + i * 512, rr = c >> 4, cc = c & 15;
      const int key = (rr >> 6) * 128 + s * 64 + (rr & 63);
      *(u32x4*)(g_smem + C_K + rr * KSTR + cc * 16) = *(const u32x4*)(kch + (size_t)key * 128 + cc * 8);
      *(u32x4*)(g_smem + C_KLO + rr * KSTR + cc * 16) = *(const u32x4*)(kcl + (size_t)key * 128 + cc * 8);
    }
    __syncthreads();
    {
      f32x16 st0 = zero16(), st1 = zero16();
      const int off = (kh * 64 + l32) * KSTR + hh * 16;
      const int tmaxu = qt * 32 + 31;
      const bool act0 = 16 * (kh * 128 + s * 64) + 31 <= tmaxu, act1 = 16 * (kh * 128 + s * 64 + 32) + 31 <= tmaxu;
      if (act0) {
#pragma unroll
        for (int ks = 0; ks < 8; ++ks) {
          const bf16x8 ah0 = *(const bf16x8*)(g_smem + C_K + off + ks * 32), al0 = *(const bf16x8*)(g_smem + C_KLO + off + ks * 32);
          st0 = mfma32(al0, qfh[ks], st0); st0 = mfma32(ah0, qfl[ks], st0); st0 = mfma32(ah0, qfh[ks], st0);
        }
      }
      if (act1) {
#pragma unroll
        for (int ks = 0; ks < 8; ++ks) {
          const bf16x8 ah1 = *(const bf16x8*)(g_smem + C_K + off + 32 * KSTR + ks * 32), al1 = *(const bf16x8*)(g_smem + C_KLO + off + 32 * KSTR + ks * 32);
          st1 = mfma32(al1, qfh[ks], st1); st1 = mfma32(ah1, qfl[ks], st1); st1 = mfma32(ah1, qfh[ks], st1);
        }
      }
#pragma unroll
      for (int r = 0; r < 16; ++r) {
        const int c = kh * 128 + s * 64 + (r & 3) + 8 * (r >> 2) + 4 * hh;
        st0[r] = ((16 * c + 31 <= token) && c < 255) ? st0[r] * QK_C1 : -1e30f;
        st1[r] = ((16 * (c + 32) + 31 <= token) && (c + 32) < 255) ? st1[r] * QK_C1 : -1e30f;
      }
      t4[s * 2 + 0] = st0; t4[s * 2 + 1] = st1;
    }
    __syncthreads();
  }
  float* ex = (float*)(g_smem + C_EX);
  float mx = -1e30f;
#pragma unroll
  for (int i = 0; i < 4; ++i)
#pragma unroll
    for (int r = 0; r < 16; ++r) mx = fmaxf(mx, t4[i][r]);
  mx = xmax32(mx);
  if (hh == 0) ex[(rg * 2 + kh) * 32 + l32] = mx;
  __syncthreads();
  const float mf = fmaxf(ex[(rg * 2 + 0) * 32 + l32], ex[(rg * 2 + 1) * 32 + l32]);
  float rs = 0.f;
#pragma unroll
  for (int i = 0; i < 4; ++i)
#pragma unroll
    for (int r = 0; r < 16; ++r) { const float t = t4[i][r]; const float pv = t > -1e29f ? fexp2(t - mf) : 0.f; t4[i][r] = pv; rs += pv; }
  rs = xsum32(rs);
  if (hh == 0) ex[256 + (rg * 2 + kh) * 32 + l32] = rs;
  __syncthreads();
  const float lt = ex[256 + (rg * 2 + 0) * 32 + l32] + ex[256 + (rg * 2 + 1) * 32 + l32];
  const float inv = lt > 0.f ? 1.f / lt : 0.f;
  float* Ap = (float*)(g_smem + C_K); float* Bp = Ap + 4 * 32 * 64;
#pragma unroll
  for (int i = 0; i < 4; ++i) {
#pragma unroll
    for (int r = 0; r < 16; ++r) t4[i][r] *= inv;
#pragma unroll
    for (int gq = 0; gq < 4; ++gq) {
      const int n = kh * 32 + (i >> 1) * 16 + (i & 1) * 8 + 2 * gq + hh;
      const float p0 = t4[i][gq * 4], p1 = t4[i][gq * 4 + 1], p2 = t4[i][gq * 4 + 2], p3 = t4[i][gq * 4 + 3];
      Ap[(rg * 32 + l32) * 64 + n] = 2.f * (p0 + p1 + p2) + p3;
      Bp[(rg * 32 + l32) * 64 + n] = p3;
    }
  }
  f32x16 o[4];
#pragma unroll
  for (int i = 0; i < 4; ++i) o[i] = zero16();
#pragma unroll
  for (int i = 0; i < 4; ++i) {
    const int keyb = kh * 128 + (i >> 1) * 64 + (i & 1) * 32;
    if (16 * keyb + 31 > qt * 32 + 31) continue;
    const bf16x8 pk0 = pack8(t4[i], 0), pk1 = pack8(t4[i], 1);
#pragma unroll
    for (int dblk = 0; dblk < 4; ++dblk) {
      const char* vp = g_smem + C_V + (dblk * 32 + l32) * CV_STR + (keyb + 4 * hh) * 2;
      o[dblk] = mfma32(ldv8(vp), pk0, o[dblk]);
      o[dblk] = mfma32(ldv8(vp + 32), pk1, o[dblk]);
    }
  }
  __syncthreads();
  float* X = (float*)(g_smem + C_V);
  if (kh == 1) {
#pragma unroll
    for (int i = 0; i < 4; ++i)
#pragma unroll
      for (int r = 0; r < 16; ++r) X[(rg * 64 + i * 16 + r) * 64 + lane] = o[i][r];
  }
  {
    const int n = lane;
#pragma unroll
    for (int i = 0; i < 4; ++i) {
      const int tok = wave * 4 + i, tk = qt * 32 + tok, cur = tk >> 6;
      float imp = 0.f;
#pragma unroll
      for (int r4 = 0; r4 < 4; ++r4) { imp += Ap[(r4 * 32 + tok) * 64 + n]; if (n > 0) imp += Bp[(r4 * 32 + tok) * 64 + n - 1]; }
      const bool causal = n <= cur, forced = n == 0 || n == cur || n == cur - 1;
      const float score = causal ? (forced ? 1e6f : imp) : -1e6f;
      int rank = 0;
#pragma unroll 4
      for (int j = 0; j < 64; ++j) { const float sj = __int_as_float(__builtin_amdgcn_readlane(__float_as_int(score), j)); rank += (sj > score || (sj == score && j < n)) ? 1 : 0; }
      const unsigned long long msk = __ballot(causal && rank < 16);
      if (lane == 0) ((unsigned long long*)(ws + OFF_SEL))[(size_t)bg * 4096 + tk] = msk;
    }
  }
  __syncthreads();
  float* Tt = (float*)(g_smem + C_K);
  if (kh == 0) {
    const float gt = ((const float*)(ws + OFF_GATES))[(size_t)(b * 4096 + token) * 24 + head * 3 + 0];
    float* trow = Tt + (rg * 32 + l32) * 132;
#pragma unroll
    for (int i = 0; i < 4; ++i)
#pragma unroll
      for (int gq = 0; gq < 4; ++gq) {
        f32x4 v;
#pragma unroll
        for (int j = 0; j < 4; ++j) v[j] = (o[i][gq * 4 + j] + X[(rg * 64 + i * 16 + gq * 4 + j) * 64 + lane]) * gt;
        *(f32x4*)(trow + i * 32 + 8 * gq + 4 * hh) = v;
      }
  }
  __syncthreads();
  if (!dry) {
    float* obase = (float*)(ws + OFF_ON32) + (size_t)b * 4096 * 1024;
#pragma unroll
    for (int k = 0; k < 8; ++k) {
      const int R = wave * 16 + k * 2 + (lane >> 5), rgr = R >> 5, rr = R & 31, c4 = (lane & 31) * 4;
      float* dp = obase + (size_t)(qt * 32 + rr) * 1024 + (g * 4 + rgr) * 128 + c4;
      *(f32x4*)dp = *(const f32x4*)dp + *(const f32x4*)(Tt + R * 132 + c4);
    }
  }
  __syncthreads();
}

DI void cumsum_job(const Params& p, int bh) {
  int tid = threadIdx.x; asm volatile("" : "+v"(tid));
  const int b = bh >> 3, h = bh & 7, wave = tid >> 6, lane = tid & 63;
  const float* lf = (const float*)(p.ws + OFF_LOGF) + (size_t)b * 4096 * 8 + h;
  float* cum = (float*)(p.ws + OFF_CUM) + (size_t)bh * 4096;
  float* wt = (float*)g_smem;
  float v[8]; float s = 0.f;
#pragma unroll
  for (int i = 0; i < 8; ++i) { s += lf[(size_t)(tid * 8 + i) * 8]; v[i] = s; }
  float inc = s;
#pragma unroll
  for (int o = 1; o < 64; o <<= 1) { const float t = __shfl_up(inc, o); if (lane >= o) inc += t; }
  if (lane == 63) wt[wave] = inc;
  __syncthreads();
  float base = inc - s;
  for (int w = 0; w < wave; ++w) base += wt[w];
#pragma unroll
  for (int i = 0; i < 8; ++i) cum[tid * 8 + i] = base + v[i];
  __syncthreads();
}

DI void knorm_job(const Params& p, int j) {
  int tid = threadIdx.x; asm volatile("" : "+v"(tid));
  const int pair = tid >> 1, half = tid & 1, tl = pair >> 3, h = pair & 7;
  const bf16_t* kp = (const bf16_t*)(p.ws + OFF_KF) + (size_t)(j * 32 + tl) * 1024 + h * 128 + half * 64;
  float ss = 0.f;
#pragma unroll
  for (int i = 0; i < 8; ++i) {
    const bf16x8 v = *(const bf16x8*)(kp + i * 8);
#pragma unroll
    for (int e = 0; e < 8; ++e) { const float f = bf2f((unsigned short)v[e]); ss += f * f; }
  }
  ss += __shfl_xor(ss, 1);
  float* nr = (float*)g_smem;
  if (half == 0) nr[pair] = ss;
  __syncthreads();
  if (tid < 8) {
    float m = 0.f;
    for (int t = 0; t < 32; ++t) m = fmaxf(m, nr[t * 8 + tid]);
    ((float*)(p.ws + OFF_KNORM))[((j >> 7) * 8 + tid) * 128 + (j & 127)] = m;
  }
  __syncthreads();
}
DI void gemm1_job(const Params& p, int j) {
  char* ws = p.ws;
  GemmOp g; g.lda = 2048; g.ldb = 4096;
  if (j < 64) {
    const int pm = j >> 4, split = j & 15;
    const bf16_t* ah = (const bf16_t*)(ws + OFF_KCIN_HI) + split * 256; const bf16_t* al = (const bf16_t*)(ws + OFF_KCIN_LO) + split * 256;
    const bf16_t* bh = (const bf16_t*)(ws + OFF_W1K_HI) + split * 256; const bf16_t* bl = (const bf16_t*)(ws + OFF_W1K_LO) + split * 256;
    g.A0 = ah; g.A1 = ah; g.A2 = al; g.B0 = bh; g.B1 = bl; g.B2 = bh; g.nt = 12; g.shift = 2;
    EpiF32 e{(float*)(ws + OFF_H1P_K) + (size_t)split * 1024 * 256, 256};
    gemm_tile(g, pm * 256, 0, e);
  } else {
    const int jj = j - 64, pm = jj >> 3, split = jj & 7;
    const bf16_t* ah = (const bf16_t*)(ws + OFF_VCIN) + split * 512; const bf16_t* bh = (const bf16_t*)(ws + OFF_W1V) + split * 512;
    g.A0 = g.A1 = g.A2 = ah; g.B0 = g.B1 = g.B2 = bh; g.nt = 8; g.shift = 3;
    EpiF32 e{(float*)(ws + OFF_H1P_V) + (size_t)split * 1024 * 256, 256};
    gemm_tile(g, pm * 256, 0, e);
  }
}

DI void gemm2_job(const Params& p, int j) {
  char* ws = p.ws;
  int tid = threadIdx.x; asm volatile("" : "+v"(tid));
  const bool isv = j >= 128; const int r0 = (j & 127) * 8;
  const float* part = (const float*)(ws + (isv ? OFF_H1P_V : OFF_H1P_K));
  const float* bias = (const float*)(ws + OFF_BIAS1) + (isv ? 16 * 256 : 0);
  const float* w2 = isv ? p.w_vc2 : p.w_kc2;
  float* hs = (float*)g_smem;
  float* w2s = hs + 2048;
  float* os = w2s;
  {
    const f32x4* w2v = (const f32x4*)w2;
#pragma unroll 16
    for (int i = 0; i < 16; ++i) ((f32x4*)w2s)[tid + i * 512] = w2v[tid + i * 512];
  }
  for (int idx = tid; idx < 2048; idx += 512) {
    const int row = idx >> 8, col = idx & 255;
    float s = 0.f;
#pragma unroll
    for (int c16 = 0; c16 < 16; ++c16) s += bias[c16 * 256 + col];
    const int nsp = isv ? 8 : 16;
    for (int sp = 0; sp < nsp; ++sp) s += part[((size_t)sp * 1024 + r0 + row) * 256 + col];
    hs[idx] = gelu_tanh(s);
  }
  __syncthreads();
  float a0 = 0.f, a1 = 0.f;
  {
    const int col = tid & 127, rp = tid >> 7;
#pragma unroll 8
    for (int k = 0; k < 256; ++k) { const float w = w2s[k * 128 + col]; a0 += hs[(rp * 2) * 256 + k] * w; a1 += hs[(rp * 2 + 1) * 256 + k] * w; }
  }
  __syncthreads();
  { const int col = tid & 127, rp = tid >> 7; os[(rp * 2) * 128 + col] = a0; os[(rp * 2 + 1) * 128 + col] = a1; }
  __syncthreads();
  if (!isv) {
    const int row = tid >> 6, i = tid & 63;
    const int rr = r0 + row, bg = rr >> 8, n = rr & 255;
    float y1 = 0.f, y2 = 0.f;
    if (n < 255) {
      const int tk = (bg >> 1) * 4096 + 16 * n + 31;
      const float cv = ((const float*)(ws + OFF_COS))[(size_t)tk * 64 + i], sv = ((const float*)(ws + OFF_SIN))[(size_t)tk * 64 + i];
      const float x1 = os[row * 128 + i], x2 = os[row * 128 + 64 + i];
      y1 = x1 * cv - x2 * sv; y2 = x2 * cv + x1 * sv;
    }
    bf16_t* kh_ = (bf16_t*)(ws + OFF_KC_HI) + (size_t)rr * 128; bf16_t* kl_ = (bf16_t*)(ws + OFF_KC_LO) + (size_t)rr * 128;
    kh_[i] = f2bf(y1); kh_[i + 64] = f2bf(y2); kl_[i] = f2bf(lo_of(y1)); kl_[i + 64] = f2bf(lo_of(y2));
  } else {
    for (int idx = tid; idx < 1024; idx += 512) {
      const int row = idx & 7, d = idx >> 3;
      const int rr = r0 + row, bg = rr >> 8, n = rr & 255;
      ((bf16_t*)(ws + OFF_VCT))[((size_t)bg * 128 + d) * 256 + n] = n < 255 ? f2bf(os[row * 128 + d]) : (bf16_t)0;
    }
  }
  __syncthreads();
}

DI void phase3(const Params& p) {
  FOR_JOBS(job, 96) gemm1_job(p, job);
  for (int job = (int)gridDim.x - 1 - (int)blockIdx.x; job < 16; job += gridDim.x) cumsum_job(p, job);
  for (int job = (int)gridDim.x - 1 - (int)blockIdx.x; job < 256; job += gridDim.x) knorm_job(p, job);
}
DI void phase4(const Params& p, bool dry) {
  if (!dry) { FOR_JOBS(job, 256) gemm2_job(p, job); }
  unsigned* qctr = (unsigned*)(p.ws + OFF_BAR) + (dry ? 3616 : 3600);
  volatile int* qslot = (volatile int*)(g_smem + 143360 - 32);
  for (;;) {
    if (threadIdx.x == 0) *qslot = (int)__hip_atomic_fetch_add(qctr, 1u, __ATOMIC_RELAXED, __HIP_MEMORY_SCOPE_AGENT);
    __syncthreads();
    const int u = *qslot;
    __syncthreads();
    if (u >= 1024) break;
    if (u < 512) { const int qt = 31 - (u >> 4), bh = u & 15; attn_unit<0>(p, bh >> 3, bh & 7, qt, dry); }
    else { const int v = u - 512; const int qt = 127 - (v >> 2), bg = v & 3; attn_unit<1>(p, bg >> 1, bg & 1, qt, dry); }
  }
}
DI void phase5(const Params& p, bool dry) {
  FOR_JOBS(job, 512) { const int qt = job >> 2, bg = job & 3; cmp_unit(p, bg >> 1, bg & 1, qt, dry); }
}
DI void phase6(const Params& p, bool dry) {
  unsigned* qctr = (unsigned*)(p.ws + OFF_BAR) + (dry ? 3648 : 3632);
  volatile int* qslot = (volatile int*)(g_smem + 143360 - 32);
  for (;;) {
    if (threadIdx.x == 0) *qslot = (int)__hip_atomic_fetch_add(qctr, 1u, __ATOMIC_RELAXED, __HIP_MEMORY_SCOPE_AGENT);
    __syncthreads();
    const int job = *qslot;
    __syncthreads();
    if (job >= 512) break;
    const int qt = 127 - (job >> 2), bg = job & 3; attn_unit<2>(p, bg >> 1, bg & 1, qt, dry);
  }
}

DI void outproj_phase(const Params& p) {
  char* ws = p.ws;
  FOR_JOBS(job, 256) {
    const int pn = job >> 5, pm = job & 31;
    GemmOp g; g.lda = 2048; g.ldb = 2048; g.nt = 32; g.shift = 5;
    g.A0 = g.A1 = g.A2 = (const bf16_t*)(ws + OFF_U_HI); g.B0 = g.B1 = g.B2 = (const bf16_t*)(ws + OFF_WOUT);
    EpiResid e{(float*)(ws + OFF_H1), p.x, (const float*)(ws + OFF_MOD) + 4096};
    gemm_tile(g, pm * 256, pn * 256, e);
  }
}
DI void gateup_phase(const Params& p) {
  char* ws = p.ws;
  FOR_JOBS(job, 44 * 32) {
    const int pn = job >> 5, pm = job & 31;
    GemmOp g; g.lda = 2048; g.ldb = 2048; g.nt = 32; g.shift = 5;
    g.A0 = g.A1 = g.A2 = (const bf16_t*)(ws + OFF_U_HI); g.B0 = g.B1 = g.B2 = (const bf16_t*)(ws + OFF_WGU);
    EpiSwiglu e{(bf16_t*)(ws + OFF_ACT)};
    gemm_tile(g, pm * 256, pn * 256, e);
  }
}
DI void down_phase(const Params& p) {
  char* ws = p.ws;
  FOR_JOBS(job, 256) {
    const int pn = job >> 5, pm = job & 31;
    GemmOp g; g.lda = DFF; g.ldb = DFF; g.nt = 88; g.shift = 20;
    g.A0 = g.A1 = g.A2 = (const bf16_t*)(ws + OFF_ACT); g.B0 = g.B1 = g.B2 = (const bf16_t*)(ws + OFF_WDN);
    EpiResid e{p.out, (const float*)(ws + OFF_H1), (const float*)(ws + OFF_MOD) + 10240};
    gemm_tile(g, pm * 256, pn * 256, e);
  }
}


#define XB_TMO      128
#define XB_XCNT(j)  (256  + 64 * (j))
#define XB_XSUB(j)  (1280 + 64 * (j))
#define XB_XGEN(j)  (2304 + 64 * (j))
#define XB_TOP      3328
#define XB_TOPGEN   3392
#define XCD_BAR_WORDS 3456
#define XB_SPIN_CAP (1u << 22)
#define LAS __attribute__((address_space(3)))
constexpr int LDS_BAR_OFF = 143360 - 16;
DI unsigned xb_ld(unsigned* p) { return __hip_atomic_load(p, __ATOMIC_RELAXED, __HIP_MEMORY_SCOPE_AGENT); }
DI unsigned xb_add(unsigned* p, unsigned v) { return __hip_atomic_fetch_add(p, v, __ATOMIC_RELAXED, __HIP_MEMORY_SCOPE_AGENT); }
DI unsigned xb_xcc_id() { return (unsigned)__builtin_amdgcn_s_getreg((3 << 11) | 20) & 0xFu; }
#define XB_SPIN(cond, bar) do { unsigned _sp = 0; while (cond) { __builtin_amdgcn_s_sleep(1); \
    if ((++_sp & 255u) == 0u) { if (xb_ld(&(bar)[XB_TMO])) break; if (_sp > XB_SPIN_CAP) { atomicAdd(&(bar)[XB_TMO], 1u); break; } } } } while (0)
struct XcdBarrier { unsigned* bar; unsigned x; volatile LAS unsigned* st; };
DI XcdBarrier xcd_barrier_post(unsigned* bar, volatile LAS unsigned* st) {
  XcdBarrier b; b.bar = bar; b.x = xb_xcc_id(); b.st = st;
  if (threadIdx.x == 0) (void)xb_add(&bar[XB_XCNT(b.x)], 1u);
  return b;
}
DI void xcd_barrier_complete(unsigned* bar, unsigned x, unsigned& nloc, unsigned& nx) {
  const unsigned G = gridDim.x * gridDim.y * gridDim.z;
  unsigned sum, cnt, mine, sp = 0u;
  for (;;) {
    sum = 0u; cnt = 0u; mine = 0u;
#pragma unroll
    for (unsigned j = 0; j < 16; ++j) { const unsigned c = xb_ld(&bar[XB_XCNT(j)]); sum += c; cnt += (c > 0u) ? 1u : 0u; mine = (j == x) ? c : mine; }
    if (sum == G) break;
    __builtin_amdgcn_s_sleep(1);
    if ((++sp & 255u) == 0u) { if (xb_ld(&bar[XB_TMO])) break; if (sp > XB_SPIN_CAP) { atomicAdd(&bar[XB_TMO], 1u); break; } }
  }
  nloc = mine > 0u ? mine : 1u; nx = cnt > 0u ? cnt : 1u;
}
DI void xcd_barrier(const XcdBarrier& b) {
  asm volatile("s_waitcnt vmcnt(0)" ::: "memory");
  __syncthreads();
  if (threadIdx.x == 0) {
    unsigned* bar = b.bar;
    __builtin_amdgcn_s_waitcnt(0);
    unsigned nloc = b.st[0], nx = b.st[1];
    if (nloc == 0u) { xcd_barrier_complete(bar, b.x, nloc, nx); b.st[0] = nloc; b.st[1] = nx; }
    const unsigned old = xb_add(&bar[XB_XSUB(b.x)], 1u);
    const unsigned gen = old / nloc;
    if (old + 1u == (gen + 1u) * nloc) {
      __builtin_amdgcn_fence(__ATOMIC_RELEASE, "agent");
      asm volatile("s_waitcnt vmcnt(0)" ::: "memory");
      const unsigned og = xb_add(&bar[XB_TOP], 1u);
      const unsigned tg = og / nx;
      if (og + 1u == (tg + 1u) * nx) xb_add(&bar[XB_TOPGEN], 1u);
      else XB_SPIN(xb_ld(&bar[XB_TOPGEN]) == tg, bar);
      __builtin_amdgcn_fence(__ATOMIC_ACQUIRE, "agent");
      xb_add(&bar[XB_XGEN(b.x)], 1u);
      asm volatile("s_waitcnt vmcnt(0)" ::: "memory");
    } else {
      XB_SPIN(xb_ld(&bar[XB_XGEN(b.x)]) == gen, bar);
      __builtin_amdgcn_fence(__ATOMIC_ACQUIRE, "agent");
      asm volatile("s_waitcnt vmcnt(0)" ::: "memory");
    }
  }
  __syncthreads();
}

#ifdef ONLY_PHASE
#define PH_ON(k) ((k) == ONLY_PHASE)
#else
#define PH_ON(k) 1
#endif
#ifndef REP_MASK
#define REP_MASK 0
#endif
#define RUN_PHASE(k, call) do { if (PH_ON(k) && ph0 <= (k) && (k) < ph1) { \
    _Pragma("unroll 1") for (int _r = 0; _r <= ((REP_MASK >> (k)) & 1); ++_r) { const bool _dry = ((REP_MASK >> (k)) & 1) && _r == 0; (void)_dry; if ((k) > ph0 || _r) GRID_SYNC(); call; } } } while (0)
#ifndef NSYNC_EXTRA
#define NSYNC_EXTRA 0
#endif
#define GRID_SYNC() xcd_barrier(xb)
__global__ void __launch_bounds__(512) hymba_mega(Params p, int ph0, int ph1) {
  volatile LAS unsigned* xst = (volatile LAS unsigned*)(g_smem + LDS_BAR_OFF);
  if (threadIdx.x == 0) { xst[0] = 0u; xst[1] = 0u; }
  __syncthreads();
  const XcdBarrier xb = xcd_barrier_post((unsigned*)(p.ws + OFF_BAR), xst);
  if (ph1 > 1000) cg::this_grid().sync();
  RUN_PHASE(0, phase0(p));
  RUN_PHASE(1, rmsmod_phase(p.x, p.norm_attn, (const float*)(p.ws + OFF_MOD), 0, 2048, (bf16_t*)(p.ws + OFF_U_HI), (bf16_t*)(p.ws + OFF_U_LO), true));
  RUN_PHASE(2, inproj_phase(p, _dry));
  RUN_PHASE(3, phase3(p));
  RUN_PHASE(4, phase4(p, _dry));
  RUN_PHASE(5, phase5(p, _dry));
  RUN_PHASE(6, phase6(p, _dry));
  RUN_PHASE(7, ymix_phase(p));
  RUN_PHASE(8, outproj_phase(p));
  RUN_PHASE(9, rmsmod_phase((const float*)(p.ws + OFF_H1), p.norm_ffn, (const float*)(p.ws + OFF_MOD), 6144, 8192, (bf16_t*)(p.ws + OFF_U_HI), nullptr, true));
  RUN_PHASE(10, gateup_phase(p));
  RUN_PHASE(11, down_phase(p));
  RUN_PHASE(12, final_phase(p));
  _Pragma("unroll 1") for (int i = 0; i < NSYNC_EXTRA; ++i) GRID_SYNC();
}

extern "C" void kernel_launch(void* const* d_in, const int* in_sizes, int n_in, void* d_out, int out_size, void* d_ws, size_t ws_size,
                              hipStream_t stream) {
  Params p{};
  p.x = (const float*)d_in[0]; p.c = (const float*)d_in[1]; p.pos = (const int*)d_in[2];
  p.w_ada = (const float*)d_in[3]; p.b_ada = (const float*)d_in[4]; p.norm_attn = (const float*)d_in[5]; p.norm_ffn = (const float*)d_in[6];
  p.w_in = (const float*)d_in[7]; p.b_fgate = (const float*)d_in[8]; p.cmp_pos = (const float*)d_in[9];
  p.w_kc1 = (const float*)d_in[10]; p.w_kc2 = (const float*)d_in[11]; p.w_vc1 = (const float*)d_in[12]; p.w_vc2 = (const float*)d_in[13];
  p.beta_fox = (const float*)d_in[14]; p.beta_nsa = (const float*)d_in[15]; p.w_out = (const float*)d_in[16];
  p.w_gate = (const float*)d_in[17]; p.w_up = (const float*)d_in[18]; p.w_down = (const float*)d_in[19]; p.final_norm = (const float*)d_in[20];
  p.out = (float*)d_out; p.ws = (char*)d_ws;
  static int grid_blocks = 0;
  if (!grid_blocks) {
    hipFuncSetAttribute((const void*)hymba_mega, hipFuncAttributeMaxDynamicSharedMemorySize, LDS_BYTES);
    int dev = 0, cus = 0, per_cu = 0;
    hipGetDevice(&dev);
    hipDeviceGetAttribute(&cus, hipDeviceAttributeMultiprocessorCount, dev);
    hipOccupancyMaxActiveBlocksPerMultiprocessor(&per_cu, hymba_mega, 512, LDS_BYTES);
    if (per_cu < 1) per_cu = 1;
    grid_blocks = cus * per_cu;
    if (ws_size < WS_END) fprintf(stderr, "workspace too small: %zu < %zu\n", ws_size, (size_t)WS_END);
  }
  hipMemsetAsync((char*)d_ws + OFF_BAR, 0, 16384, stream);
#if N_LAUNCH_MODE == 1
  int ph0 = 0, ph1 = NPH;
  void* args[] = {&p, &ph0, &ph1};
  hipError_t e = hipLaunchCooperativeKernel((const void*)hymba_mega, dim3(grid_blocks), dim3(512), args, LDS_BYTES, stream);
  if (e != hipSuccess) fprintf(stderr, "cooperative launch failed: %s (grid %d)\n", hipGetErrorString(e), grid_blocks);
#else
  for (int ph = 0; ph < NPH; ++ph) hipLaunchKernelGGL(hymba_mega, dim3(grid_blocks), dim3(512), LDS_BYTES, stream, p, ph, ph + 1);
#endif
}
```

```cpp
#include <hip/hip_runtime.h>
#include <hip/hip_cooperative_groups.h>
#include <stdint.h>
#include <cstdio>
namespace cg = cooperative_groups;

#define DI __device__ __forceinline__
typedef unsigned short bf16_t;
typedef short bf16x8 __attribute__((ext_vector_type(8)));
typedef short s16x4 __attribute__((ext_vector_type(4)));
typedef float f32x4 __attribute__((ext_vector_type(4)));
typedef float f32x16 __attribute__((ext_vector_type(16)));
typedef unsigned u32x2 __attribute__((ext_vector_type(2)));
typedef unsigned u32x4 __attribute__((ext_vector_type(4)));

#ifndef DRY_MODE
#define DRY_MODE 0
#endif
#ifndef ATTN_PREFETCH
#define ATTN_PREFETCH 0
#endif
#ifndef N_LAUNCH_MODE
#define N_LAUNCH_MODE 1
#endif

constexpr int T_TOK = 8192, SEQ = 4096, DM = 2048, DFF = 5632, DIN = 5664;
constexpr int NPH = 13;
constexpr float LOG2E = 1.4426950408889634f;
constexpr float QK_C1 = 0.08838834764831845f * 1.4426950408889634f;

constexpr size_t al256(size_t x) { return (x + 255) & ~(size_t)255; }
constexpr size_t OFF_WIN_HI = 0;
constexpr size_t OFF_WIN_LO = OFF_WIN_HI + al256((size_t)5888 * 2048 * 2);
constexpr size_t OFF_WOUT = OFF_WIN_LO + al256((size_t)1280 * 2048 * 2);
constexpr size_t OFF_WGU = OFF_WOUT + al256((size_t)2048 * 2048 * 2);
constexpr size_t OFF_WDN = OFF_WGU + al256((size_t)11264 * 2048 * 2);
constexpr size_t OFF_W1K_HI = OFF_WDN + al256((size_t)2048 * 5632 * 2);
constexpr size_t OFF_W1K_LO = OFF_W1K_HI + al256((size_t)256 * 4096 * 2);
constexpr size_t OFF_W1V = OFF_W1K_LO + al256((size_t)256 * 4096 * 2);
constexpr size_t OFF_MOD = OFF_W1V + al256((size_t)256 * 4096 * 2);
constexpr size_t OFF_COS = OFF_MOD + al256((size_t)2 * 12288 * 4);
constexpr size_t OFF_SIN = OFF_COS + al256((size_t)8192 * 64 * 4);
constexpr size_t OFF_BIAS1 = OFF_SIN + al256((size_t)8192 * 64 * 4);
constexpr size_t OFF_U_HI = OFF_BIAS1 + al256((size_t)2 * 16 * 256 * 4);
constexpr size_t OFF_LOGF = OFF_U_HI + al256((size_t)8192 * 2048 * 2);
constexpr size_t OFF_CUM = OFF_LOGF + al256((size_t)8192 * 8 * 4);
constexpr size_t OFF_GATES = OFF_CUM + al256((size_t)16 * 4096 * 4);
constexpr size_t KCIN_BYTES = al256((size_t)(4 * 4096 + 64) * 128 * 2);
constexpr size_t OFF_KCIN_HI = OFF_GATES + al256((size_t)8192 * 24 * 4);
constexpr size_t OFF_KCIN_LO = OFF_KCIN_HI + KCIN_BYTES;
constexpr size_t OFF_VCIN = OFF_KCIN_LO + KCIN_BYTES;
constexpr size_t KV4_BYTES = (size_t)4 * 4096 * 128 * 2;
constexpr size_t OFF_KS = OFF_VCIN + KCIN_BYTES;
constexpr size_t OFF_VST = OFF_KS + KV4_BYTES;
constexpr size_t OFF_KW = OFF_VST + KV4_BYTES;
constexpr size_t OFF_VWT = OFF_KW + KV4_BYTES;
constexpr size_t OFF_H1P_K = OFF_VWT + KV4_BYTES;
constexpr size_t OFF_H1P_V = OFF_H1P_K + (size_t)16 * 1024 * 256 * 4;
constexpr size_t OFF_KC_HI = OFF_H1P_V + (size_t)8 * 1024 * 256 * 4;
constexpr size_t OFF_KC_LO = OFF_KC_HI + (size_t)4 * 256 * 128 * 2;
constexpr size_t OFF_VCT = OFF_KC_LO + (size_t)4 * 256 * 128 * 2;
constexpr size_t OFF_SEL = OFF_VCT + (size_t)4 * 256 * 128 * 2;
constexpr size_t OFF_OF32 = OFF_SEL + (size_t)4 * 4096 * 8;
constexpr size_t OFF_ON32 = OFF_OF32 + (size_t)8192 * 1024 * 4;
constexpr size_t OFF_H1 = OFF_OF32;
constexpr size_t OFF_RA = OFF_ON32 + (size_t)8192 * 1024 * 4;
constexpr size_t OFF_U_LO = OFF_RA;
constexpr size_t OFF_QF = OFF_U_LO + (size_t)8192 * 2048 * 2;
constexpr size_t OFF_KF = OFF_QF + (size_t)8192 * 1024 * 2;
constexpr size_t OFF_VFT = OFF_KF + (size_t)8192 * 1024 * 2;
constexpr size_t OFF_QN_HI = OFF_VFT + (size_t)8192 * 1024 * 2;
constexpr size_t OFF_QN_LO = OFF_QN_HI + (size_t)8192 * 1024 * 2;
constexpr size_t OFF_ACT = OFF_RA;
constexpr size_t OFF_KNORM = OFF_QN_LO + (size_t)8192 * 1024 * 2;
constexpr size_t OFF_BAR = OFF_KNORM + 8192;
constexpr size_t WS_END = OFF_BAR + 16384;

struct Params {
  const float *x, *c; const int* pos;
  const float *w_ada, *b_ada, *norm_attn, *norm_ffn, *w_in, *b_fgate, *cmp_pos, *w_kc1, *w_kc2, *w_vc1, *w_vc2,
      *beta_fox, *beta_nsa, *w_out, *w_gate, *w_up, *w_down, *final_norm;
  float* out; char* ws;
};

extern __shared__ __attribute__((aligned(16))) char g_smem[];
constexpr int LDS_BYTES = 143360;

__device__ const float c_inv_freq[64] = {
1.000000000e+00f,8.659643531e-01f,7.498942614e-01f,6.493816376e-01f,5.623413324e-01f,4.869675338e-01f,4.216965139e-01f,3.651741147e-01f,3.162277639e-01f,2.738419771e-01f,2.371373773e-01f,2.053525001e-01f,1.778279394e-01f,1.539926529e-01f,1.333521307e-01f,1.154782027e-01f,1.000000015e-01f,8.659642935e-02f,7.498941571e-02f,6.493816525e-02f,5.623413250e-02f,4.869675264e-02f,4.216965288e-02f,3.651741147e-02f,3.162277490e-02f,2.738419734e-02f,2.371373773e-02f,2.053525113e-02f,1.778279431e-02f,1.539926510e-02f,1.333521493e-02f,1.154782064e-02f,9.999999776e-03f,8.659643121e-03f,7.498941850e-03f,6.493816152e-03f,5.623413250e-03f,4.869675264e-03f,4.216964822e-03f,3.651741194e-03f,3.162277630e-03f,2.738419687e-03f,2.371373586e-03f,2.053524833e-03f,1.778279431e-03f,1.539926510e-03f,1.333521446e-03f,1.154781901e-03f,1.000000047e-03f,8.659643354e-04f,7.498942432e-04f,6.493816618e-04f,5.623413017e-04f,4.869675322e-04f,4.216965172e-04f,3.651741426e-04f,3.162277571e-04f,2.738419571e-04f,2.371373703e-04f,2.053525095e-04f,1.778279402e-04f,1.539926452e-04f,1.333521504e-04f,1.154782003e-04f};

DI unsigned short f2bf(float x) { unsigned u = __float_as_uint(x); u += 0x7fffu + ((u >> 16) & 1u); return (unsigned short)(u >> 16); }
DI float bf2f(unsigned short h) { return __uint_as_float(((unsigned)h) << 16); }
typedef float f32x2 __attribute__((ext_vector_type(2)));
typedef __bf16 bf16v2 __attribute__((ext_vector_type(2)));
DI unsigned pack2(float a, float b) { const f32x2 v = {a, b}; return __builtin_bit_cast(unsigned, __builtin_convertvector(v, bf16v2)); }
DI void split2(float a, float b, unsigned& hi, unsigned& lo) {
  hi = pack2(a, b);
  lo = pack2(a - __uint_as_float(hi << 16), b - __uint_as_float(hi & 0xffff0000u));
}
DI float lo_of(float x) { return x - bf2f(f2bf(x)); }
DI float wave_sum(float v) {
#pragma unroll
  for (int o = 32; o > 0; o >>= 1) v += __shfl_xor(v, o);
  return v;
}
DI float xmax32(float v) { auto r = __builtin_amdgcn_permlane32_swap(__float_as_uint(v), __float_as_uint(v), false, false); return fmaxf(__uint_as_float(r[0]), __uint_as_float(r[1])); }
DI float xsum32(float v) { auto r = __builtin_amdgcn_permlane32_swap(__float_as_uint(v), __float_as_uint(v), false, false); return __uint_as_float(r[0]) + __uint_as_float(r[1]); }
DI float fexp2(float x) { return __builtin_amdgcn_exp2f(x); }
DI float sigmoidf_(float x) { return 1.f / (1.f + __expf(-x)); }
DI float siluf_(float x) { return x / (1.f + __expf(-x)); }
DI float silu_fast(float x) { return x * __builtin_amdgcn_rcpf(1.f + __builtin_amdgcn_exp2f(-LOG2E * x)); }
DI float gelu_tanh(float x) { float u = 0.7978845608028654f * (x + 0.044715f * x * x * x); float e = __expf(2.f * u); float t = 1.f - 2.f / (e + 1.f); return 0.5f * x * (1.f + t); }
DI float log_sigmoid(float x) { return fminf(x, 0.f) - log1pf(__expf(-fabsf(x))); }
DI f32x16 mfma32(bf16x8 a, bf16x8 b, f32x16 c) { return __builtin_amdgcn_mfma_f32_32x32x16_bf16(a, b, c, 0, 0, 0); }
DI f32x16 zero16() { f32x16 z;
#pragma unroll
  for (int i = 0; i < 16; ++i) z[i] = 0.f; return z; }
DI int perm_gu(int w) { const int r = w & 31; return (w & 96) + ((r >> 2) & 1) * 16 + (r >> 3) * 4 + (r & 3); }
DI int perm256(int w) { const int hl = (w >> 7) & 1, d = w & 127, bj = d >> 6, q = (d & 63) >> 3, n = (d >> 2) & 1, j = d & 3; return bj * 128 + (hl * 2 + (q >> 2)) * 32 + n * 16 + (q & 3) * 4 + j; }
DI int perm128(int d) { return ((d >> 4) & 3) * 32 + (d >> 6) * 16 + (d & 15); }

#define FOR_JOBS(job, njobs) \
  for (int _r = 0, job; _r * (int)gridDim.x < (njobs); ++_r) \
    if ((job = _r * (int)gridDim.x + ((_r & 1) ? ((int)gridDim.x - 1 - (int)blockIdx.x) : (int)blockIdx.x)) < (njobs))

constexpr int BM = 256, BK = 64, HALF = 128, HTB = HALF * BK * 2;
DI int lds_byte(int r, int c) { int st = (r >> 4) * 2 + (c >> 5), rr = r & 15, cc = c & 31, ob = rr * 64 + cc * 2; return st * 1024 + (ob ^ (((ob >> 9) & 1) << 5)); }
DI void stage_rc(int b, int& R, int& C) { int st = b / 1024, sb = b % 1024, swz = sb ^ (((sb >> 9) & 1) << 5); R = (st >> 1) * 16 + swz / 64; C = (st & 1) * 32 + (swz % 64) / 2; }

DI const char* uptr(const char* p) {
  const unsigned long long v = (unsigned long long)p;
  const unsigned lo = __builtin_amdgcn_readfirstlane((unsigned)v), hi = __builtin_amdgcn_readfirstlane((unsigned)(v >> 32));
  return (const char*)(((unsigned long long)hi << 32) | lo);
}
struct GemmOp { const bf16_t *A0, *A1, *A2, *B0, *B1, *B2; int lda, ldb, nt, shift; };

template <class Epi>
DI void gemm_tile(const GemmOp& g, int brow, int bcol, const Epi& epi) {
#define SA(b, h) (g_smem + ((b) * 2 + (h)) * HTB)
#define SB(b, h) (g_smem + (4 + (b) * 2 + (h)) * HTB)
  int tid = threadIdx.x; asm volatile("" : "+v"(tid));
  const int wid = tid >> 6, lane = tid & 63, wr = wid >> 2, wc = wid & 3, fr = lane & 15, fq = lane >> 4;
  int r0, c0, r1, c1; stage_rc(tid * 16, r0, c0); stage_rc(tid * 16 + 8192, r1, c1);
  const unsigned oa0 = (unsigned)(r0 * g.lda + c0) * 2u, oa1 = (unsigned)(r1 * g.lda + c1) * 2u, ob0 = (unsigned)(r0 * g.ldb + c0) * 2u, ob1 = (unsigned)(r1 * g.ldb + c1) * 2u;
  const int mask = (1 << g.shift) - 1;
#define STAGE_A(P, half, kt) do { const int _s = (kt) >> g.shift; const char* _b = uptr((const char*)((_s == 0 ? g.A0 : (_s == 1 ? g.A1 : g.A2)) + (size_t)(brow + (half) * HALF) * g.lda + (size_t)((kt) & mask) * BK)); \
    __builtin_amdgcn_global_load_lds((const unsigned*)(_b + oa0), (unsigned*)((P) + tid * 16), 16, 0, 0); \
    __builtin_amdgcn_global_load_lds((const unsigned*)(_b + oa1), (unsigned*)((P) + tid * 16 + 8192), 16, 0, 0); } while (0)
#define STAGE_B(P, half, kt) do { const int _s = (kt) >> g.shift; const char* _b = uptr((const char*)((_s == 0 ? g.B0 : (_s == 1 ? g.B1 : g.B2)) + (size_t)(bcol + (half) * HALF) * g.ldb + (size_t)((kt) & mask) * BK)); \
    __builtin_amdgcn_global_load_lds((const unsigned*)(_b + ob0), (unsigned*)((P) + tid * 16), 16, 0, 0); \
    __builtin_amdgcn_global_load_lds((const unsigned*)(_b + ob1), (unsigned*)((P) + tid * 16 + 8192), 16, 0, 0); } while (0)
#define LDA(dst, b, h) for (int m = 0; m < 4; ++m) for (int k = 0; k < 2; ++k) \
    dst[m][k] = *reinterpret_cast<const bf16x8*>(SA(b, h) + lds_byte(wr * 64 + m * 16 + fr, k * 32 + fq * 8))
#define LDB(dst, b, h) for (int n = 0; n < 2; ++n) for (int k = 0; k < 2; ++k) \
    dst[n][k] = *reinterpret_cast<const bf16x8*>(SB(b, h) + lds_byte(wc * 32 + n * 16 + fr, k * 32 + fq * 8))
#define MMA(ai, bj, At_, Bt_) do { __builtin_amdgcn_s_setprio(1); \
    for (int m = 0; m < 4; ++m) for (int n = 0; n < 2; ++n) for (int k = 0; k < 2; ++k) \
      acc[ai][bj][m][n] = __builtin_amdgcn_mfma_f32_16x16x32_bf16(Bt_[n][k], At_[m][k], acc[ai][bj][m][n], 0, 0, 0); \
    __builtin_amdgcn_s_setprio(0); } while (0)
#define WAIT_V(n) asm volatile("s_waitcnt vmcnt(" #n ")" ::: "memory")
#define WAIT_L(n) asm volatile("s_waitcnt lgkmcnt(" #n ")" ::: "memory")
#define BAR __builtin_amdgcn_s_barrier()
#define SCHED __builtin_amdgcn_sched_barrier(0)
  f32x4 acc[2][2][4][2] = {};
  bf16x8 At[4][2], B0[2][2], B1[2][2];
  const int nt = g.nt;
  STAGE_B(SB(0, 0), 0, 0); STAGE_A(SA(0, 0), 0, 0);
  STAGE_B(SB(0, 1), 1, 0); STAGE_A(SA(0, 1), 1, 0);
  if (wr == 1) BAR;
  WAIT_V(4); BAR;
  STAGE_B(SB(1, 0), 0, 1); STAGE_A(SA(1, 0), 0, 1); STAGE_B(SB(1, 1), 1, 1);
  WAIT_V(6); BAR;
  for (int t = 0; t < nt - 2; t += 2) {
    LDB(B0, 0, 0); SCHED; LDA(At, 0, 0); STAGE_A(SA(1, 1), 1, t + 1);
    WAIT_L(8); BAR; WAIT_L(0); MMA(0, 0, At, B0); BAR; SCHED;
    LDB(B1, 0, 1); STAGE_B(SB(0, 0), 0, t + 2);
    BAR; WAIT_L(0); MMA(0, 1, At, B1); BAR;
    LDA(At, 0, 1); STAGE_A(SA(0, 0), 0, t + 2);
    BAR; WAIT_L(0); MMA(1, 0, At, B0); BAR; SCHED;
    STAGE_B(SB(0, 1), 1, t + 2);
    WAIT_V(6); BAR; MMA(1, 1, At, B1); BAR;
    LDB(B0, 1, 0); SCHED; LDA(At, 1, 0); STAGE_A(SA(0, 1), 1, t + 2);
    WAIT_L(8); BAR; WAIT_L(0); MMA(0, 0, At, B0); BAR; SCHED;
    LDB(B1, 1, 1); STAGE_B(SB(1, 0), 0, t + 3);
    BAR; WAIT_L(0); MMA(0, 1, At, B1); BAR;
    LDA(At, 1, 1); STAGE_A(SA(1, 0), 0, t + 3);
    BAR; WAIT_L(0); MMA(1, 0, At, B0); BAR; SCHED;
    STAGE_B(SB(1, 1), 1, t + 3);
    WAIT_V(6); BAR; MMA(1, 1, At, B1); BAR;
  }
  { LDB(B0, 0, 0); LDA(At, 0, 0); STAGE_A(SA(1, 1), 1, nt - 1);
    BAR; WAIT_L(0); MMA(0, 0, At, B0); BAR;
    LDB(B1, 0, 1); BAR; WAIT_L(0); MMA(0, 1, At, B1); BAR;
    LDA(At, 0, 1); WAIT_V(4); BAR; WAIT_L(0); MMA(1, 0, At, B0); MMA(1, 1, At, B1); BAR; }
  { LDB(B0, 1, 0); LDA(At, 1, 0); WAIT_V(2); BAR; WAIT_L(0); MMA(0, 0, At, B0); BAR;
    LDB(B1, 1, 1); WAIT_V(0); BAR; WAIT_L(0); MMA(0, 1, At, B1); BAR;
    LDA(At, 1, 1); BAR; WAIT_L(0); MMA(1, 0, At, B0); MMA(1, 1, At, B1); BAR; }
  if (wr == 0) BAR;
  { int t2 = tid; asm volatile("" : "+v"(t2)); const int w2 = t2 >> 6, l2 = t2 & 63; epi(acc, brow, bcol, w2 >> 2, w2 & 3, l2 & 15, l2 >> 4); }
  __syncthreads();
#undef SA
#undef SB
}

typedef f32x4 AccT[2][2][4][2];

struct EpiInproj {
  const Params* p; int pn;
  DI void operator()(const AccT& acc, int brow, int bcol, int wr, int wc, int fr, int fq) const {
    char* ws = p->ws;
    const float* cs = (const float*)(ws + OFF_COS); const float* sn = (const float*)(ws + OFF_SIN);
    const int hl = wc >> 1, dlo = ((wc & 1) * 4 + fq) * 8;
    const bool rope = (pn >= 12 && pn < 16) || pn == 18 || pn == 20;
#pragma unroll
    for (int ai = 0; ai < 2; ++ai)
#pragma unroll
      for (int m = 0; m < 4; ++m) {
        const int token = brow + ai * 128 + wr * 64 + m * 16 + fr;
        const int b = token >> 12, s = token & 4095;
        f32x4 a0 = acc[ai][0][m][0], a1 = acc[ai][0][m][1], b0 = acc[ai][1][m][0], b1 = acc[ai][1][m][1];
        if (rope) {
          const f32x4 c0 = *(const f32x4*)(cs + (size_t)token * 64 + dlo), c1 = *(const f32x4*)(cs + (size_t)token * 64 + dlo + 4);
          const f32x4 s0 = *(const f32x4*)(sn + (size_t)token * 64 + dlo), s1 = *(const f32x4*)(sn + (size_t)token * 64 + dlo + 4);
          const f32x4 y0 = a0 * c0 - b0 * s0, y1 = a1 * c1 - b1 * s1, z0 = b0 * c0 + a0 * s0, z1 = b1 * c1 + a1 * s1;
          a0 = y0; a1 = y1; b0 = z0; b1 = z1;
        }
        unsigned h[8], l[8];
        split2(a0[0], a0[1], h[0], l[0]); split2(a0[2], a0[3], h[1], l[1]); split2(a1[0], a1[1], h[2], l[2]); split2(a1[2], a1[3], h[3], l[3]);
        split2(b0[0], b0[1], h[4], l[4]); split2(b0[2], b0[3], h[5], l[5]); split2(b1[0], b1[1], h[6], l[6]); split2(b1[2], b1[3], h[7], l[7]);
        size_t o; size_t off_hi; size_t off_lo = 0; bool has_lo = false;
        if (pn < 8) { o = (size_t)token * 1024 + ((pn & 3) * 2 + hl) * 128 + dlo; off_hi = pn < 4 ? OFF_QF : OFF_KF; }
        else if (pn < 16) { o = (size_t)token * 1024 + ((pn - 12) * 2 + hl) * 128 + dlo; off_hi = OFF_QN_HI; off_lo = OFF_QN_LO; has_lo = true; }
        else {
          o = ((size_t)(b * 2 + hl) * 4096 + s) * 128 + dlo;
          off_hi = pn == 16 ? OFF_KCIN_HI : (pn == 17 ? OFF_VCIN : (pn == 18 ? OFF_KS : OFF_KW));
          if (pn == 16) { off_lo = OFF_KCIN_LO; has_lo = true; }
        }
        bf16_t* dh = (bf16_t*)(ws + off_hi) + o;
        *(u32x4*)dh = (u32x4){h[0], h[1], h[2], h[3]};
        *(u32x4*)(dh + 64) = (u32x4){h[4], h[5], h[6], h[7]};
        if (has_lo) {
          bf16_t* dl = (bf16_t*)(ws + off_lo) + o;
          *(u32x4*)dl = (u32x4){l[0], l[1], l[2], l[3]};
          *(u32x4*)(dl + 64) = (u32x4){l[4], l[5], l[6], l[7]};
        }
      }
  }
};

struct EpiVT {
  bf16_t* dst; int nheads; int sec_row0;
  DI void operator()(const AccT& acc, int brow, int bcol, int wr, int wc, int fr, int fq) const {
#pragma unroll
    for (int ai = 0; ai < 2; ++ai)
#pragma unroll
      for (int m = 0; m < 4; ++m) {
        const int vr = brow - sec_row0 + ai * 128 + wr * 64 + m * 16 + fr;
        const int head = vr >> 7, d = vr & 127;
#pragma unroll
        for (int bj = 0; bj < 2; ++bj)
#pragma unroll
          for (int n = 0; n < 2; ++n) {
            const int tk = bcol + bj * 128 + wc * 32 + n * 16 + fq * 4;
            const int b = tk >> 12, s = tk & 4095;
            const f32x4 v = acc[ai][bj][m][n];
            *(u32x2*)(dst + ((size_t)(b * nheads + head) * 128 + d) * 4096 + s) = (u32x2){pack2(v[0], v[1]), pack2(v[2], v[3])};
          }
      }
  }
};

struct EpiF32 {
  float* dst; int ld;
  DI void operator()(const AccT& acc, int brow, int bcol, int wr, int wc, int fr, int fq) const {
#pragma unroll
    for (int ai = 0; ai < 2; ++ai)
#pragma unroll
      for (int m = 0; m < 4; ++m) {
        const int row = brow + ai * 128 + wr * 64 + m * 16 + fr;
#pragma unroll
        for (int bj = 0; bj < 2; ++bj)
#pragma unroll
          for (int n = 0; n < 2; ++n)
            *(f32x4*)(dst + (size_t)row * ld + bcol + bj * 128 + wc * 32 + n * 16 + fq * 4) = acc[ai][bj][m][n];
      }
  }
};

struct EpiResid {
  float* dst; const float* base; const float* gate;
  DI void operator()(const AccT& acc, int brow, int bcol, int wr, int wc, int fr, int fq) const {
#pragma unroll
    for (int ai = 0; ai < 2; ++ai)
#pragma unroll
      for (int m = 0; m < 4; ++m) {
        const int row = brow + ai * 128 + wr * 64 + m * 16 + fr;
        const int b = row >> 12;
#pragma unroll
        for (int bj = 0; bj < 2; ++bj)
#pragma unroll
          for (int n = 0; n < 2; ++n) {
            const int col = bcol + bj * 128 + wc * 32 + n * 16 + fq * 4;
            const f32x4 xv = __builtin_nontemporal_load((const f32x4*)(base + (size_t)row * 2048 + col));
            const f32x4 gv = *(const f32x4*)(gate + b * 12288 + col);
            *(f32x4*)(dst + (size_t)row * 2048 + col) = xv + gv * acc[ai][bj][m][n];
          }
      }
  }
};

struct EpiSwiglu {
  bf16_t* act;
  DI void operator()(const AccT& acc, int brow, int bcol, int wr, int wc, int fr, int fq) const {
    const int pn = bcol >> 8;
#pragma unroll
    for (int ai = 0; ai < 2; ++ai)
#pragma unroll
      for (int m = 0; m < 4; ++m) {
        const int row = brow + ai * 128 + wr * 64 + m * 16 + fr;
        float r[8];
#pragma unroll
        for (int n = 0; n < 2; ++n) {
          const f32x4 gt = acc[ai][0][m][n], up = acc[ai][1][m][n];
#pragma unroll
          for (int j = 0; j < 4; ++j) r[n * 4 + j] = silu_fast(gt[j]) * up[j];
        }
        *(u32x4*)(act + (size_t)row * DFF + pn * 128 + wc * 32 + fq * 8) = (u32x4){pack2(r[0], r[1]), pack2(r[2], r[3]), pack2(r[4], r[5]), pack2(r[6], r[7])};
      }
  }
};

DI int map_win(int c, int& lo_row) {
  lo_row = -1;
  if (c < 2048) return (c & ~255) + perm256(c & 255);
  if (c < 3072) return c;
  if (c < 3080) return 5632 + (c - 3072);
  if (c < 4104) { int cc = c - 3080; int d = 3072 + (cc & ~255) + perm256(cc & 255); lo_row = d - 3072; return d; }
  if (c < 4360) { int cc = c - 4104; int d = 4096 + perm256(cc); lo_row = d - 3072; return d; }
  if (c < 4616) { int cc = c - 4360; return 4352 + perm256(cc); }
  if (c < 4872) { int cc = c - 4616; return 4608 + perm256(cc); }
  if (c < 5128) return 4864 + (c - 4872);
  if (c < 5384) { int cc = c - 5128; return 5120 + perm256(cc); }
  if (c < 5640) return 5376 + (c - 5384);
  return c;
}

struct TInfo { const float* src; bf16_t* dh; bf16_t* dl; int N, Kd, mat, k0, n0; };
constexpr int TJ_WIN = 16 * 89, TJ_WOUT = 16 * 32, TJ_WG = 16 * 88, TJ_WD = 44 * 32, TJ_W1 = 32 * 4;
constexpr int TE0 = TJ_WIN, TE1 = TE0 + TJ_WOUT, TE2 = TE1 + TJ_WG, TE3 = TE2 + TJ_WG, TE4 = TE3 + TJ_WD, TE5 = TE4 + TJ_W1, TE6 = TE5 + TJ_W1;
DI void tile_info(const Params& p, int t, TInfo& ti) {
  char* ws = p.ws; ti.dl = nullptr; int nn;
  if (t < TE0) { ti.mat = 0; ti.src = p.w_in; ti.N = DIN; ti.Kd = 2048; ti.dh = (bf16_t*)(ws + OFF_WIN_HI); ti.dl = (bf16_t*)(ws + OFF_WIN_LO); nn = 89; }
  else if (t < TE1) { t -= TE0; ti.mat = 1; ti.src = p.w_out; ti.N = 2048; ti.Kd = 2048; ti.dh = (bf16_t*)(ws + OFF_WOUT); nn = 32; }
  else if (t < TE2) { t -= TE1; ti.mat = 2; ti.src = p.w_gate; ti.N = DFF; ti.Kd = 2048; ti.dh = (bf16_t*)(ws + OFF_WGU); nn = 88; }
  else if (t < TE3) { t -= TE2; ti.mat = 3; ti.src = p.w_up; ti.N = DFF; ti.Kd = 2048; ti.dh = (bf16_t*)(ws + OFF_WGU); nn = 88; }
  else if (t < TE4) { t -= TE3; ti.mat = 4; ti.src = p.w_down; ti.N = 2048; ti.Kd = DFF; ti.dh = (bf16_t*)(ws + OFF_WDN); nn = 32; }
  else if (t < TE5) { t -= TE4; ti.mat = 5; ti.src = p.w_kc1; ti.N = 256; ti.Kd = 4096; ti.dh = (bf16_t*)(ws + OFF_W1K_HI); ti.dl = (bf16_t*)(ws + OFF_W1K_LO); nn = 4; }
  else { t -= TE5; ti.mat = 6; ti.src = p.w_vc1; ti.N = 256; ti.Kd = 4096; ti.dh = (bf16_t*)(ws + OFF_W1V); nn = 4; }
  ti.k0 = (t / nn) * 128; ti.n0 = (t % nn) * 64;
}
DI void tr_load(const TInfo& ti, int tid, f32x4 (&r)[4]) {
#pragma unroll
  for (int i = 0; i < 4; ++i) {
    const int idx = tid + i * 512, k = idx >> 4, col = ti.n0 + (idx & 15) * 4;
    r[i] = col < ti.N ? __builtin_nontemporal_load((const f32x4*)(ti.src + (size_t)(ti.k0 + k) * ti.N + col)) : (f32x4){0.f, 0.f, 0.f, 0.f};
  }
}
DI void tr_lds_write(float* tile, int tid, const f32x4 (&r)[4]) {
#pragma unroll
  for (int i = 0; i < 4; ++i) {
    const int idx = tid + i * 512, k = idx >> 4, c = (idx & 15) * 4;
#pragma unroll
    for (int j = 0; j < 4; ++j) tile[k * 65 + c + j] = r[i][j];
  }
}
DI void tr_store(const TInfo& ti, const float* tile, int tid) {
#pragma unroll
  for (int i = 0; i < 2; ++i) {
    const int idx = tid + i * 512, nr = idx >> 4, kc = idx & 15, col = ti.n0 + nr;
    if (col < ti.N) {
      int row, lrow = -1;
      if (ti.mat == 0) row = map_win(col, lrow);
      else if (ti.mat == 2) row = (col >> 7) * 256 + perm_gu(col & 127);
      else if (ti.mat == 3) row = (col >> 7) * 256 + 128 + perm_gu(col & 127);
      else { row = col; if (ti.mat == 5) lrow = col; }
      float v[8];
#pragma unroll
      for (int e = 0; e < 8; ++e) v[e] = tile[(kc * 8 + e) * 65 + nr];
      const u32x4 hv = (u32x4){pack2(v[0], v[1]), pack2(v[2], v[3]), pack2(v[4], v[5]), pack2(v[6], v[7])};
      if (ti.mat >= 1 && ti.mat <= 4) __builtin_nontemporal_store(hv, (u32x4*)(ti.dh + (size_t)row * ti.Kd + ti.k0 + kc * 8));
      else *(u32x4*)(ti.dh + (size_t)row * ti.Kd + ti.k0 + kc * 8) = hv;
      if (lrow >= 0)
        *(u32x4*)(ti.dl + (size_t)lrow * ti.Kd + ti.k0 + kc * 8) = (u32x4){pack2(lo_of(v[0]), lo_of(v[1])), pack2(lo_of(v[2]), lo_of(v[3])), pack2(lo_of(v[4]), lo_of(v[5])), pack2(lo_of(v[6]), lo_of(v[7]))};
    }
  }
}
DI void transpose_all(const Params& p) {
  float* lds = (float*)g_smem;
  int tid = threadIdx.x; asm volatile("" : "+v"(tid));
  const int G = gridDim.x;
  int t0 = blockIdx.x, t1 = t0 + G;
  TInfo ia, ib; f32x4 ra[4], rb[4];
  if (t0 < TE6) { tile_info(p, t0, ia); tr_load(ia, tid, ra); }
  if (t1 < TE6) { tile_info(p, t1, ib); tr_load(ib, tid, rb); }
  while (t0 < TE6) {
    tr_lds_write(lds, tid, ra);
    __syncthreads();
    const TInfo cura = ia;
    const int t2 = t0 + 2 * G;
    if (t2 < TE6) { tile_info(p, t2, ia); tr_load(ia, tid, ra); }
    tr_store(cura, lds, tid);
    if (t1 >= TE6) break;
    tr_lds_write(lds + 128 * 65, tid, rb);
    __syncthreads();
    const TInfo curb = ib;
    const int t3 = t1 + 2 * G;
    if (t3 < TE6) { tile_info(p, t3, ib); tr_load(ib, tid, rb); }
    tr_store(curb, lds + 128 * 65, tid);
    t0 = t2; t1 = t3;
  }
  __syncthreads();
}

DI void mod_job(const Params& p, int job) {
  float* sc = (float*)g_smem;
  float* red = sc + 4096;
  const int tid = threadIdx.x, wave = tid >> 6, lane = tid & 63;
  for (int i = tid; i < 4096; i += 512) sc[i] = siluf_(p.c[i]);
  __syncthreads();
  const int n0 = job * 64, cgp = lane & 15, kr = lane >> 4;
  f32x4 a0 = {0.f, 0.f, 0.f, 0.f}, a1 = {0.f, 0.f, 0.f, 0.f};
#pragma unroll 8
  for (int k = wave * 4 + kr; k < 2048; k += 32) {
    const f32x4 wv = __builtin_nontemporal_load((const f32x4*)(p.w_ada + (size_t)k * 12288 + n0 + cgp * 4));
    a0 += wv * sc[k]; a1 += wv * sc[2048 + k];
  }
#pragma unroll
  for (int j = 0; j < 4; ++j) {
    a0[j] += __shfl_xor(a0[j], 16); a0[j] += __shfl_xor(a0[j], 32);
    a1[j] += __shfl_xor(a1[j], 16); a1[j] += __shfl_xor(a1[j], 32);
  }
  if (kr == 0) {
#pragma unroll
    for (int j = 0; j < 4; ++j) { red[(wave * 2 + 0) * 64 + cgp * 4 + j] = a0[j]; red[(wave * 2 + 1) * 64 + cgp * 4 + j] = a1[j]; }
  }
  __syncthreads();
  if (tid < 128) {
    const int b = tid >> 6, col = tid & 63;
    float s = p.b_ada[n0 + col];
#pragma unroll
    for (int w = 0; w < 8; ++w) s += red[(w * 2 + b) * 64 + col];
    ((float*)(p.ws + OFF_MOD))[b * 12288 + n0 + col] = s;
  }
  __syncthreads();
}

DI void bias1_job(const Params& p, int j) {
  const int which = j >> 4, chunk = j & 15;
  const float* w1 = which ? p.w_vc1 : p.w_kc1;
  float* red = (float*)g_smem;
  const int tid = threadIdx.x, col = tid & 255, half = tid >> 8;
  float s = 0.f;
  const int kb = chunk * 256 + half * 128;
#pragma unroll 16
  for (int k = kb; k < kb + 128; ++k) s += p.cmp_pos[k] * w1[(size_t)k * 256 + col];
  red[tid] = s;
  __syncthreads();
  if (tid < 256) ((float*)(p.ws + OFF_BIAS1))[(which * 16 + chunk) * 256 + tid] = red[tid] + red[tid + 256];
  __syncthreads();
}

DI void rope_job(const Params& p, int job) {
  const int idx = job * 512 + threadIdx.x, token = idx >> 6, i = idx & 63;
  const float ang = (float)p.pos[token] * c_inv_freq[i];
  double t = (double)ang * 0.15915494309189535;
  t -= floor(t + 0.5);
  const float tf = (float)t;
  ((float*)(p.ws + OFF_COS))[idx] = __builtin_amdgcn_cosf(tf);
  ((float*)(p.ws + OFF_SIN))[idx] = __builtin_amdgcn_sinf(tf);
}

DI void phase0(const Params& p) {
  transpose_all(p);
  constexpr int J_MOD = 192, J_B1 = 32, J_ROPE = 1024;
  for (int job = blockIdx.x; job < J_MOD + J_B1 + J_ROPE; job += gridDim.x) {
    if (job < J_MOD) mod_job(p, job);
    else if (job < J_MOD + J_B1) bias1_job(p, job - J_MOD);
    else rope_job(p, job - J_MOD - J_B1);
  }
}

DI void rmsmod_phase(const float* src, const float* g, const float* mod, int sh_off, int sc_off, bf16_t* dhi, bf16_t* dlo, bool nt_src) {
  const int wave = threadIdx.x >> 6, lane = threadIdx.x & 63;
  for (int row = blockIdx.x * 8 + wave; row < T_TOK; row += gridDim.x * 8) {
    const int b = row >> 12;
    const f32x4* xr = (const f32x4*)(src + (size_t)row * 2048);
    f32x4 v[8]; float ss = 0.f;
#pragma unroll
    for (int i = 0; i < 8; ++i) { v[i] = nt_src ? __builtin_nontemporal_load(xr + lane + i * 64) : xr[lane + i * 64]; ss += v[i][0] * v[i][0] + v[i][1] * v[i][1] + v[i][2] * v[i][2] + v[i][3] * v[i][3]; }
    ss = wave_sum(ss);
    const float rstd = rsqrtf(ss * (1.f / 2048.f) + 1e-6f);
#pragma unroll
    for (int i = 0; i < 8; ++i) {
      const int col = (lane + i * 64) * 4;
      const f32x4 gv = *(const f32x4*)(g + col);
      const f32x4 sc = *(const f32x4*)(mod + b * 12288 + sc_off + col), sh = *(const f32x4*)(mod + b * 12288 + sh_off + col);
      f32x4 u = (v[i] * rstd) * gv; u = u * (1.f + sc) + sh;
      unsigned h0, h1, l0, l1; split2(u[0], u[1], h0, l0); split2(u[2], u[3], h1, l1);
      *(u32x2*)(dhi + (size_t)row * 2048 + col) = (u32x2){h0, h1};
      if (dlo) *(u32x2*)(dlo + (size_t)row * 2048 + col) = (u32x2){l0, l1};
    }
  }
}

DI void ymix_phase(const Params& p) {
  const int wave = threadIdx.x >> 6, lane = threadIdx.x & 63;
  bf16_t* ym = (bf16_t*)(p.ws + OFF_U_HI);
  for (int row = blockIdx.x * 8 + wave; row < T_TOK; row += gridDim.x * 8) {
#pragma unroll
    for (int part = 0; part < 2; ++part) {
      const f32x4* xr = (const f32x4*)((const float*)(p.ws + (part ? OFF_ON32 : OFF_OF32)) + (size_t)row * 1024);
      const float* beta = part ? p.beta_nsa : p.beta_fox;
      f32x4 v[4]; float ss = 0.f;
#pragma unroll
      for (int i = 0; i < 4; ++i) { v[i] = __builtin_nontemporal_load(xr + lane + i * 64); ss += v[i][0] * v[i][0] + v[i][1] * v[i][1] + v[i][2] * v[i][2] + v[i][3] * v[i][3]; }
      ss = wave_sum(ss);
      const float rstd = rsqrtf(ss * (1.f / 1024.f) + 1e-6f);
#pragma unroll
      for (int i = 0; i < 4; ++i) {
        const int col = (lane + i * 64) * 4;
        const f32x4 u = (v[i] * rstd) * *(const f32x4*)(beta + col);
        *(u32x2*)(ym + (size_t)row * 2048 + part * 1024 + col) = (u32x2){pack2(u[0], u[1]), pack2(u[2], u[3])};
      }
    }
  }
}

DI void final_phase(const Params& p) {
  const int wave = threadIdx.x >> 6, lane = threadIdx.x & 63;
  for (int row = blockIdx.x * 8 + wave; row < T_TOK; row += gridDim.x * 8) {
    f32x4* xr = (f32x4*)(p.out + (size_t)row * 2048);
    f32x4 v[8]; float ss = 0.f;
#pragma unroll
    for (int i = 0; i < 8; ++i) { v[i] = __builtin_nontemporal_load(xr + lane + i * 64); ss += v[i][0] * v[i][0] + v[i][1] * v[i][1] + v[i][2] * v[i][2] + v[i][3] * v[i][3]; }
    ss = wave_sum(ss);
    const float rstd = rsqrtf(ss * (1.f / 2048.f) + 1e-6f);
#pragma unroll
    for (int i = 0; i < 8; ++i) __builtin_nontemporal_store((v[i] * rstd) * *(const f32x4*)(p.final_norm + (lane + i * 64) * 4), xr + lane + i * 64);
  }
}

typedef float f32x4_ __attribute__((ext_vector_type(4)));
DI void misc_job(const Params& p, int piece) {
  char* ws = p.ws;
  int tid = threadIdx.x; asm volatile("" : "+v"(tid));
  const int wave = tid >> 6, lane = tid & 63, fr = lane & 15, fq = lane >> 4;
  const bf16_t* A = (const bf16_t*)(ws + OFF_U_HI) + (size_t)(piece * 32 + fr) * 2048 + fq * 8 + wave * 256;
  const bf16_t* B = (const bf16_t*)(ws + OFF_WIN_HI) + (size_t)(5632 + fr) * 2048 + fq * 8 + wave * 256;
  f32x4 acc[2][2] = {};
#pragma unroll
  for (int k = 0; k < 8; ++k) {
    const bf16x8 a0 = *(const bf16x8*)(A + k * 32), a1 = *(const bf16x8*)(A + 16 * 2048 + k * 32);
    const bf16x8 b0 = *(const bf16x8*)(B + k * 32), b1 = *(const bf16x8*)(B + 16 * 2048 + k * 32);
    acc[0][0] = __builtin_amdgcn_mfma_f32_16x16x32_bf16(a0, b0, acc[0][0], 0, 0, 0);
    acc[0][1] = __builtin_amdgcn_mfma_f32_16x16x32_bf16(a0, b1, acc[0][1], 0, 0, 0);
    acc[1][0] = __builtin_amdgcn_mfma_f32_16x16x32_bf16(a1, b0, acc[1][0], 0, 0, 0);
    acc[1][1] = __builtin_amdgcn_mfma_f32_16x16x32_bf16(a1, b1, acc[1][1], 0, 0, 0);
  }
  f32x4* red = (f32x4*)g_smem;
#pragma unroll
  for (int q = 0; q < 4; ++q) red[(wave * 4 + q) * 64 + lane] = acc[q >> 1][q & 1];
  __syncthreads();
  if (tid < 256) {
    const int q = tid >> 6, l = tid & 63, mb = q >> 1, nb = q & 1, fr2 = l & 15, fq2 = l >> 4;
    f32x4 sum = red[q * 64 + l];
#pragma unroll
    for (int w = 1; w < 8; ++w) sum += red[(w * 4 + q) * 64 + l];
    const int col = nb * 16 + fr2;
#pragma unroll
    for (int j = 0; j < 4; ++j) {
      const int token = piece * 32 + mb * 16 + fq2 * 4 + j;
      if (col < 8) ((float*)(ws + OFF_LOGF))[token * 8 + col] = log_sigmoid(sum[j] + p.b_fgate[col]);
      else ((float*)(ws + OFF_GATES))[token * 24 + col - 8] = sigmoidf_(sum[j]);
    }
  }
  __syncthreads();
}
DI void inproj_heavy(const Params& p, int job) {
  char* ws = p.ws;
  const bf16_t* uhi = (const bf16_t*)(ws + OFF_U_HI); const bf16_t* ulo = (const bf16_t*)(ws + OFF_U_LO);
  const bf16_t* whi = (const bf16_t*)(ws + OFF_WIN_HI); const bf16_t* wlo = (const bf16_t*)(ws + OFF_WIN_LO);
  const int pn = 12 + job / 32, pm = job % 32;
  GemmOp g; g.lda = 2048; g.ldb = 2048;
  g.A0 = uhi; g.A1 = uhi; g.A2 = ulo; g.B0 = whi; g.B1 = wlo - (size_t)3072 * 2048; g.B2 = whi; g.nt = 96; g.shift = 5;
  EpiInproj e{&p, pn};
  gemm_tile(g, pm * 256, pn * 256, e);
}
DI void inproj_light(const Params& p, int L) {
  char* ws = p.ws;
  const bf16_t* uhi = (const bf16_t*)(ws + OFF_U_HI); const bf16_t* whi = (const bf16_t*)(ws + OFF_WIN_HI);
  GemmOp g; g.lda = 2048; g.ldb = 2048; g.nt = 32; g.shift = 5;
  if (L < 352) {
    const int t = L / 32, pm = L % 32;
    const int pn = t < 8 ? t : (t == 8 ? 17 : (t == 9 ? 18 : 20));
    g.A0 = g.A1 = g.A2 = uhi; g.B0 = g.B1 = g.B2 = whi;
    EpiInproj e{&p, pn};
    gemm_tile(g, pm * 256, pn * 256, e);
  } else {
    const int j = L - 352, rt = j / 32, tt = j % 32;
    int wrow; bf16_t* dst; int nh, sec0;
    if (rt < 4) { wrow = 2048 + rt * 256; dst = (bf16_t*)(ws + OFF_VFT); nh = 8; sec0 = 2048; }
    else if (rt == 4) { wrow = 4864; dst = (bf16_t*)(ws + OFF_VST); nh = 2; sec0 = 4864; }
    else { wrow = 5376; dst = (bf16_t*)(ws + OFF_VWT); nh = 2; sec0 = 5376; }
    g.A0 = g.A1 = g.A2 = whi; g.B0 = g.B1 = g.B2 = uhi;
    EpiVT e{dst, nh, sec0};
    gemm_tile(g, wrow, tt * 256, e);
  }
}
DI void inproj_phase(const Params& p, bool dry) {
  if (gridDim.x == 256) {
    const int c = blockIdx.x;
    if (c < 160) { inproj_heavy(p, c); inproj_light(p, c); }
    else { for (int i = 0; i < 4; ++i) inproj_light(p, 160 + (c - 160) * 4 + i); }
    if (!dry) misc_job(p, c);
  } else {
    FOR_JOBS(job, 160) inproj_heavy(p, job);
    FOR_JOBS(job, 544) inproj_light(p, job);
    FOR_JOBS(job, 256) misc_job(p, job);
  }
}

constexpr int KSTR = 272, VSTR = 264;
constexpr int ST_K = 0, ST_V = 128 * KSTR, ST_C = ST_V + 128 * VSTR, ST_SIZE = ST_C + 512;
constexpr int LDS_LIST = 2 * ST_SIZE;

DI bf16x8 pack8(const f32x16& x, int s) {
  u32x4 r;
  r[0] = pack2(x[8 * s + 0], x[8 * s + 1]); r[1] = pack2(x[8 * s + 2], x[8 * s + 3]);
  r[2] = pack2(x[8 * s + 4], x[8 * s + 5]); r[3] = pack2(x[8 * s + 6], x[8 * s + 7]);
  return __builtin_bit_cast(bf16x8, r);
}
DI bf16x8 ldv8(const char* p) {
  const u32x2 a = *(const u32x2*)p, b = *(const u32x2*)(p + 16);
  u32x4 r = {a[0], a[1], b[0], b[1]};
  return __builtin_bit_cast(bf16x8, r);
}

constexpr int AS_K = 0, AS_V = 32768, AS_C = 65536, AS_SIZE = 66048;
constexpr int LDS_LIST2 = 2 * AS_SIZE;
DI int pi23(int r) { return (r & ~12) | ((r & 4) << 1) | ((r & 8) >> 1); }
template <int MODE>
DI void attn_unit(const Params& p, int b, int hg, int qt, bool dry = false) {
  char* ws = p.ws;
  int tid = threadIdx.x; asm volatile("" : "+v"(tid));
  const int wave = tid >> 6, lane = tid & 63, l32 = lane & 31, hh = lane >> 5, rg = wave & 3, kh = wave >> 2;
  int token, head; const bf16_t *qrow, *kbase, *vbase; int kstride;
  if (MODE == 0) {
    token = qt * 128 + rg * 32 + l32; head = hg;
    qrow = (const bf16_t*)(ws + OFF_QF) + (size_t)(b * 4096 + token) * 1024 + head * 128;
    kbase = (const bf16_t*)(ws + OFF_KF) + (size_t)b * 4096 * 1024 + head * 128; kstride = 1024;
    vbase = (const bf16_t*)(ws + OFF_VFT) + (size_t)(b * 8 + head) * 128 * 4096;
  } else {
    if (MODE == 1) { token = qt * 32 + l32; head = hg * 4 + rg; }
    else { token = qt * 32 + rg * 8 + (l32 >> 2); head = hg * 4 + (l32 & 3); }
    qrow = (const bf16_t*)(ws + OFF_QN_HI) + (size_t)(b * 4096 + token) * 1024 + head * 128;
    kbase = (const bf16_t*)(ws + (MODE == 1 ? OFF_KW : OFF_KS)) + (size_t)(b * 2 + hg) * 4096 * 128; kstride = 128;
    vbase = (const bf16_t*)(ws + (MODE == 1 ? OFF_VWT : OFF_VST)) + (size_t)(b * 2 + hg) * 128 * 4096;
  }
  const int wtmin = MODE == 0 ? qt * 128 + rg * 32 : (MODE == 1 ? qt * 32 : qt * 32 + rg * 8), wtmax = wtmin + (MODE == 2 ? 7 : 31);
  int nst, kv_start = 0;
  int* list = (int*)(g_smem + LDS_LIST2);
  unsigned long long selmask = 0;
  if (MODE == 0) nst = qt + 1;
  else if (MODE == 1) { int lo = qt * 32 - 511; if (lo < 0) lo = 0; kv_start = lo & ~63; nst = (qt * 32 + 32 - kv_start + 127) >> 7; }
  else {
    const unsigned long long* sel = (const unsigned long long*)(ws + OFF_SEL) + (size_t)(b * 2 + hg) * 4096;
    selmask = sel[token];
    if (wave == 0) {
      const unsigned long long sm0 = sel[qt * 32 + l32];
      unsigned lo = (unsigned)sm0, hi = (unsigned)(sm0 >> 32);
#pragma unroll
      for (int o = 16; o > 0; o >>= 1) { lo |= __shfl_xor(lo, o); hi |= __shfl_xor(hi, o); }
      const unsigned long long um = ((unsigned long long)hi << 32) | lo;
      if ((um >> lane) & 1ull) list[1 + __popcll(um & ((1ull << lane) - 1ull))] = lane;
      if (lane == 0) list[0] = __popcll(um);
    }
    __syncthreads();
    nst = (list[0] + 1) >> 1;
  }
  bf16x8 qf[8];
#pragma unroll
  for (int ks = 0; ks < 8; ++ks) qf[ks] = *(const bf16x8*)(qrow + ks * 16 + hh * 8);
  float cumq = 0.f;
  const float* cumrow = nullptr;
  if (MODE == 0) { cumrow = (const float*)(ws + OFF_CUM) + (size_t)(b * 8 + head) * 4096; cumq = cumrow[token]; }

  f32x16 o[4];
#pragma unroll
  for (int i = 0; i < 4; ++i) o[i] = zero16();
  float mrun = -1e30f, lrun = 0.f;

  auto tile_base = [&](int it, int half) -> int {
    if (MODE == 2) { const int i = 2 * it + half; return i < list[0] ? list[1 + i] * 64 : -1; }
    return kv_start + it * 128 + half * 64;
  };
  const int rsub = lane >> 4, slot = lane & 15;
  unsigned koff[4], voff[4]; bool vhalf[4];
#pragma unroll
  for (int j = 0; j < 4; ++j) {
    const int row = (j * 8 + wave) * 4 + rsub;
    const int c = slot ^ (row & 15);
    koff[j] = (unsigned)(pi23(row & 63) * kstride + c * 8) * 2u;
    vhalf[j] = (c >> 3) != 0;
    voff[j] = MODE == 2 ? (unsigned)(row * 4096 + (c & 7) * 8) * 2u : (unsigned)(row * 4096 + c * 8) * 2u;
  }
  auto issue_stage = [&](int it, int buf) {
    if (DRY_MODE == 2 && dry) return;
    int kb0 = tile_base(it, 0), kb1 = tile_base(it, 1);
    if (kb1 < 0) kb1 = 0;
    char* sb = g_smem + buf * AS_SIZE;
    const char* kp0 = uptr((const char*)(kbase + (size_t)kb0 * kstride));
    const char* kp1 = uptr((const char*)(kbase + (size_t)kb1 * kstride));
    const char* vp0 = uptr((const char*)(vbase + kb0));
    const char* vp1 = uptr((const char*)(vbase + kb1));
#pragma unroll
    for (int j = 0; j < 4; ++j) {
      __builtin_amdgcn_global_load_lds((const unsigned*)((j >> 1 ? kp1 : kp0) + koff[j]), (unsigned*)(sb + AS_K + (j * 8 + wave) * 1024 + lane * 16), 16, 0, 0);
      const char* vsrc = MODE == 2 ? ((vhalf[j] ? vp1 : vp0) + voff[j]) : (vp0 + voff[j]);
      __builtin_amdgcn_global_load_lds((const unsigned*)vsrc, (unsigned*)(sb + AS_V + (j * 8 + wave) * 1024 + lane * 16), 16, 0, 0);
    }
    if (MODE == 0 && wave < 2) {
      const int key = (wave ? kb1 : kb0) + lane;
      __builtin_amdgcn_global_load_lds((const unsigned*)(cumrow + key), (unsigned*)(sb + AS_C + wave * 256 + lane * 4), 4, 0, 0);
    }
  };

  int it0 = 0;
  if (MODE == 0) {
    float q2 = 0.f;
#pragma unroll
    for (int ks = 0; ks < 8; ++ks)
#pragma unroll
      for (int e = 0; e < 8; ++e) { const float f = bf2f((unsigned short)qf[ks][e]); q2 += f * f; }
    q2 = xsum32(q2);
#pragma unroll
    for (int o2 = 16; o2 > 0; o2 >>= 1) q2 = fmaxf(q2, __shfl_xor(q2, o2));
    const float* kn = (const float*)(ws + OFF_KNORM) + (size_t)(b * 8 + head) * 128;
    float k2 = fmaxf(kn[lane], kn[lane + 64]);
#pragma unroll
    for (int o2 = 32; o2 > 0; o2 >>= 1) k2 = fmaxf(k2, __shfl_xor(k2, o2));
    float* qx = (float*)(g_smem + LDS_LIST2);
    if (lane == 0) qx[wave] = q2;
    __syncthreads();
    const float q2m = fmaxf(fmaxf(qx[0], qx[1]), fmaxf(qx[2], qx[3]));
    const float xub = sqrtf(q2m * k2) * (QK_C1 * 1.001f) + 0.01f;
    const float cend = lane < qt ? cumrow[lane * 128 + 127] : cumrow[qt * 128];
    const float bub = (cumrow[qt * 128] - cend) * LOG2E;
    const bool skip = lane < qt && (2.f * xub + bub < -160.f);
    const unsigned long long sk = __ballot(skip);
    it0 = (int)__builtin_ctzll(~sk);
    if (it0 > qt) it0 = qt;
    it0 = __builtin_amdgcn_readfirstlane(it0);
  }
#pragma unroll
  for (int ks = 0; ks < 8; ++ks) asm volatile("" :: "v"(qf[ks]));
  asm volatile("" :: "v"(cumq));
  issue_stage(it0, it0 & 1);
  for (int it = it0; it < nst; ++it) {
    asm volatile("s_waitcnt vmcnt(0)" ::: "memory");
    __builtin_amdgcn_s_barrier();
    if (it + 1 < nst) issue_stage(it + 1, (it + 1) & 1);
    const char* sb = g_smem + (it & 1) * AS_SIZE;
    const int kbh = tile_base(it, kh);
    bool active;
    if (MODE == 0) active = kbh <= wtmax;
    else if (MODE == 1) active = kbh <= wtmax && kbh + 63 >= wtmin - 511;
    else active = kbh >= 0;
    if (DRY_MODE == 1 && dry) active = false;
    const bool selbit = (MODE == 2 && kbh >= 0) ? ((selmask >> (kbh >> 6)) & 1ull) != 0 : true;
    if (MODE == 2) active = active && __any(selbit);
    if (active) {
      f32x16 stA = zero16(), stB = zero16();
      {
        const int row = kh * 64 + l32;
        const char* kp = sb + AS_K + row * 256;
        const int sw = row & 15;
#pragma unroll
        for (int ks = 0; ks < 8; ++ks) stA = mfma32(*(const bf16x8*)(kp + (((ks * 2 + hh) ^ sw) << 4)), qf[ks], stA);
#pragma unroll
        for (int ks = 0; ks < 8; ++ks) stB = mfma32(*(const bf16x8*)(kp + 32 * 256 + (((ks * 2 + hh) ^ sw) << 4)), qf[ks], stB);
      }
      const int tq0 = token - kbh - hh * 8;
      bf16x8 pk0, pk1;
#define ATTN_SOFTMAX(ST, KB2) do { \
        const int kmin = kbh + (KB2) * 32, kmax = kmin + 31; \
        if (MODE == 0) { \
          f32x16 cs16; \
          _Pragma("unroll") for (int gq = 0; gq < 4; ++gq) { \
            const f32x4 cs = *(const f32x4*)(sb + AS_C + (kh * 64 + (KB2) * 32 + (gq >> 1) * 16 + hh * 8 + (gq & 1) * 4) * 4); \
            cs16[gq * 4] = cs[0]; cs16[gq * 4 + 1] = cs[1]; cs16[gq * 4 + 2] = cs[2]; cs16[gq * 4 + 3] = cs[3]; } \
          ST = ST * QK_C1 + (cs16 * (-LOG2E) + cumq * LOG2E); \
        } else ST = ST * QK_C1; \
        bool need_mask; \
        if (MODE == 0) need_mask = kmax > wtmin; \
        else if (MODE == 1) need_mask = kmax > wtmin || wtmax - kmin >= 512; \
        else need_mask = (kbh >> 6) == (wtmin >> 6); \
        if (need_mask) { \
          _Pragma("unroll") for (int gq = 0; gq < 4; ++gq) _Pragma("unroll") for (int j = 0; j < 4; ++j) { \
            const int kofs = (KB2) * 32 + (gq >> 1) * 16 + (gq & 1) * 4 + j; \
            bool valid = kofs <= tq0; \
            if (MODE == 1) valid = valid && (tq0 - kofs < 512); \
            ST[gq * 4 + j] = valid ? ST[gq * 4 + j] : -1e30f; } } \
        float mx = ST[0]; \
        _Pragma("unroll") for (int r = 1; r < 16; ++r) mx = fmaxf(mx, ST[r]); \
        mx = xmax32(mx); \
        if (MODE == 2) mx = selbit ? mx : -1e30f; \
        const float mnew = (mx > mrun + 8.f) ? mx : mrun;        \
        if (__any(mnew != mrun)) { \
          const float alpha = fexp2(mrun - mnew); \
          lrun *= alpha; \
          _Pragma("unroll") for (int i = 0; i < 4; ++i) o[i] = o[i] * alpha; } \
        mrun = mnew; \
        const float msub = (mnew > -1e29f && selbit) ? mnew : 1e30f; \
        ST = ST - msub; \
        float rs = 0.f; \
        _Pragma("unroll") for (int r = 0; r < 16; ++r) { ST[r] = fexp2(ST[r]); rs += ST[r]; } \
        rs = xsum32(rs); \
        lrun += rs; \
        pk0 = pack8(ST, 0); pk1 = pack8(ST, 1); } while (0)
#define ATTN_PV(KB2) do { \
        _Pragma("unroll") for (int dblk = 0; dblk < 4; ++dblk) { \
          const int d = dblk * 32 + l32; \
          const char* vp = sb + AS_V + d * 256; \
          const int sw = d & 15; \
          o[dblk] = mfma32(*(const bf16x8*)(vp + (((kh * 8 + (KB2) * 4 + hh) ^ sw) << 4)), pk0, o[dblk]); \
          o[dblk] = mfma32(*(const bf16x8*)(vp + (((kh * 8 + (KB2) * 4 + 2 + hh) ^ sw) << 4)), pk1, o[dblk]); } } while (0)
      ATTN_SOFTMAX(stA, 0);
      ATTN_PV(0);
      ATTN_SOFTMAX(stB, 1);
      ATTN_PV(1);
#undef ATTN_SOFTMAX
#undef ATTN_PV
    }
  }
  __syncthreads();
  float* X = (float*)g_smem;
  if (kh == 1) {
#pragma unroll
    for (int i = 0; i < 4; ++i)
#pragma unroll
      for (int r = 0; r < 16; ++r) X[(rg * 66 + i * 16 + r) * 64 + lane] = o[i][r];
    X[(rg * 66 + 64) * 64 + lane] = mrun; X[(rg * 66 + 65) * 64 + lane] = lrun;
  }
  __syncthreads();
  float* Tt = (float*)(g_smem + 67584);
  if (kh == 0) {
    const float m1 = X[(rg * 66 + 64) * 64 + lane], l1 = X[(rg * 66 + 65) * 64 + lane];
    const float mf = fmaxf(mrun, m1);
    const float a0 = fexp2(mrun - mf), a1 = fexp2(m1 - mf);
    const float lt = lrun * a0 + l1 * a1;
    float inv = lt > 0.f ? 1.f / lt : 0.f;
    if (MODE != 0) inv *= ((const float*)(ws + OFF_GATES))[(size_t)(b * 4096 + token) * 24 + head * 3 + (MODE == 1 ? 2 : 1)];
    const float s0 = a0 * inv, s1 = a1 * inv;
    float* trow = Tt + (rg * 32 + l32) * 132;
#pragma unroll
    for (int i = 0; i < 4; ++i)
#pragma unroll
      for (int gq = 0; gq < 4; ++gq) {
        f32x4 v;
#pragma unroll
        for (int j = 0; j < 4; ++j) v[j] = o[i][gq * 4 + j] * s0 + X[(rg * 66 + i * 16 + gq * 4 + j) * 64 + lane] * s1;
        *(f32x4*)(trow + i * 32 + 8 * gq + 4 * hh) = v;
      }
  }
  __syncthreads();
  if (!dry) {
    float* obase = (float*)(ws + (MODE == 0 ? OFF_OF32 : OFF_ON32)) + (size_t)b * 4096 * 1024;
#pragma unroll
    for (int k = 0; k < 8; ++k) {
      const int R = wave * 16 + k * 2 + (lane >> 5), rgr = R >> 5, rr = R & 31, c4 = (lane & 31) * 4;
      int tk, hd;
      if (MODE == 0) { tk = qt * 128 + rgr * 32 + rr; hd = hg; }
      else if (MODE == 1) { tk = qt * 32 + rr; hd = hg * 4 + rgr; }
      else { tk = qt * 32 + rgr * 8 + (rr >> 2); hd = hg * 4 + (rr & 3); }
      float* dp = obase + (size_t)tk * 1024 + hd * 128 + c4;
      f32x4 v = *(const f32x4*)(Tt + R * 132 + c4);
      if (MODE == 2) v += *(const f32x4*)dp;
      if (MODE == 0) __builtin_nontemporal_store(v, (f32x4*)dp);
      else *(f32x4*)dp = v;
    }
  }
  __syncthreads();
}

constexpr int CV_STR = 520;
constexpr int C_V = 0, C_K = 128 * CV_STR  , C_KLO = C_K + 128 * KSTR, C_EX = C_KLO + 128 * KSTR  ;
DI void cmp_unit(const Params& p, int b, int g, int qt, bool dry = false) {
  char* ws = p.ws;
  int tid = threadIdx.x; asm volatile("" : "+v"(tid));
  const int wave = tid >> 6, lane = tid & 63, l32 = lane & 31, hh = lane >> 5, rg = wave & 3, kh = wave >> 2;
  const int token = qt * 32 + l32, head = g * 4 + rg, bg = b * 2 + g;
  const bf16_t* qh = (const bf16_t*)(ws + OFF_QN_HI) + (size_t)(b * 4096 + token) * 1024 + head * 128;
  const bf16_t* ql = (const bf16_t*)(ws + OFF_QN_LO) + (size_t)(b * 4096 + token) * 1024 + head * 128;
  const bf16_t* kch = (const bf16_t*)(ws + OFF_KC_HI) + (size_t)bg * 256 * 128;
  const bf16_t* kcl = (const bf16_t*)(ws + OFF_KC_LO) + (size_t)bg * 256 * 128;
  const bf16_t* vct = (const bf16_t*)(ws + OFF_VCT) + (size_t)bg * 128 * 256;
  bf16x8 qfh[8], qfl[8];
#pragma unroll
  for (int ks = 0; ks < 8; ++ks) { qfh[ks] = *(const bf16x8*)(qh + ks * 16 + hh * 8); qfl[ks] = *(const bf16x8*)(ql + ks * 16 + hh * 8); }
#pragma unroll
  for (int i = 0; i < 8; ++i) {
    const int c = tid + i * 512, d = c >> 5, cc = c & 31;
    const u32x4 v = *(const u32x4*)(vct + (size_t)d * 256 + cc * 8);
    char* vd = g_smem + C_V + d * CV_STR + cc * 16;
    *(u32x2*)vd = (u32x2){v[0], v[1]}; *(u32x2*)(vd + 8) = (u32x2){v[2], v[3]};
  }
  f32x16 t4[4];
#pragma unroll
  for (int s = 0; s < 2; ++s) {
#pragma unroll
    for (int i = 0; i < 4; ++i) {
      const int c = tid + i * 512, rr = c >> 4, cc = c & 15;
      const int key = (rr >> 6) * 128 + s * 64 + (rr & 63);
      *(u32x4*)(g_smem + C_K + rr * KSTR + cc * 16) = *(const u32x4*)(kch + (size_t)key * 128 + cc * 8);
      *(u32x4*)(g_smem + C_KLO + rr * KSTR + cc * 16) = *(const u32x4*)(kcl + (size_t)key * 128 + cc * 8);
    }
    __syncthreads();
    {
      f32x16 st0 = zero16(), st1 = zero16();
      const int off = (kh * 64 + l32) * KSTR + hh * 16;
      const int tmaxu = qt * 32 + 31;
      const bool act0 = 16 * (kh * 128 + s * 64) + 31 <= tmaxu, act1 = 16 * (kh * 128 + s * 64 + 32) + 31 <= tmaxu;
      if (act0) {
#pragma unroll
        for (int ks = 0; ks < 8; ++ks) {
          const bf16x8 ah0 = *(const bf16x8*)(g_smem + C_K + off + ks * 32), al0 = *(const bf16x8*)(g_smem + C_KLO + off + ks * 32);
          st0 = mfma32(al0, qfh[ks], st0); st0 = mfma32(ah0, qfl[ks], st0); st0 = mfma32(ah0, qfh[ks], st0);
        }
      }
      if (act1) {
#pragma unroll
        for (int ks = 0; ks < 8; ++ks) {
          const bf16x8 ah1 = *(const bf16x8*)(g_smem + C_K + off + 32 * KSTR + ks * 32), al1 = *(const bf16x8*)(g_smem + C_KLO + off + 32 * KSTR + ks * 32);
          st1 = mfma32(al1, qfh[ks], st1); st1 = mfma32(ah1, qfl[ks], st1); st1 = mfma32(ah1, qfh[ks], st1);
        }
      }
#pragma unroll
      for (int r = 0; r < 16; ++r) {
        const int c = kh * 128 + s * 64 + (r & 3) + 8 * (r >> 2) + 4 * hh;
        st0[r] = ((16 * c + 31 <= token) && c < 255) ? st0[r] * QK_C1 : -1e30f;
        st1[r] = ((16 * (c + 32) + 31 <= token) && (c + 32) < 255) ? st1[r] * QK_C1 : -1e30f;
      }
      t4[s * 2 + 0] = st0; t4[s * 2 + 1] = st1;
    }
    __syncthreads();
  }
  float* ex = (float*)(g_smem + C_EX);
  float mx = -1e30f;
#pragma unroll
  for (int i = 0; i < 4; ++i)
#pragma unroll
    for (int r = 0; r < 16; ++r) mx = fmaxf(mx, t4[i][r]);
  mx = xmax32(mx);
  if (hh == 0) ex[(rg * 2 + kh) * 32 + l32] = mx;
  __syncthreads();
  const float mf = fmaxf(ex[(rg * 2 + 0) * 32 + l32], ex[(rg * 2 + 1) * 32 + l32]);
  float rs = 0.f;
#pragma unroll
  for (int i = 0; i < 4; ++i)
#pragma unroll
    for (int r = 0; r < 16; ++r) { const float t = t4[i][r]; const float pv = t > -1e29f ? fexp2(t - mf) : 0.f; t4[i][r] = pv; rs += pv; }
  rs = xsum32(rs);
  if (hh == 0) ex[256 + (rg * 2 + kh) * 32 + l32] = rs;
  __syncthreads();
  const float lt = ex[256 + (rg * 2 + 0) * 32 + l32] + ex[256 + (rg * 2 + 1) * 32 + l32];
  const float inv = lt > 0.f ? 1.f / lt : 0.f;
  float* Ap = (float*)(g_smem + C_K); float* Bp = Ap + 4 * 32 * 64;
#pragma unroll
  for (int i = 0; i < 4; ++i) {
#pragma unroll
    for (int r = 0; r < 16; ++r) t4[i][r] *= inv;
#pragma unroll
    for (int gq = 0; gq < 4; ++gq) {
      const int n = kh * 32 + (i >> 1) * 16 + (i & 1) * 8 + 2 * gq + hh;
      const float p0 = t4[i][gq * 4], p1 = t4[i][gq * 4 + 1], p2 = t4[i][gq * 4 + 2], p3 = t4[i][gq * 4 + 3];
      Ap[(rg * 32 + l32) * 64 + n] = 2.f * (p0 + p1 + p2) + p3;
      Bp[(rg * 32 + l32) * 64 + n] = p3;
    }
  }
  f32x16 o[4];
#pragma unroll
  for (int i = 0; i < 4; ++i) o[i] = zero16();
#pragma unroll
  for (int i = 0; i < 4; ++i) {
    const int keyb = kh * 128 + (i >> 1) * 64 + (i & 1) * 32;
    if (16 * keyb + 31 > qt * 32 + 31) continue;
    const bf16x8 pk0 = pack8(t4[i], 0), pk1 = pack8(t4[i], 1);
#pragma unroll
    for (int dblk = 0; dblk < 4; ++dblk) {
      const char* vp = g_smem + C_V + (dblk * 32 + l32) * CV_STR + (keyb + 4 * hh) * 2;
      o[dblk] = mfma32(ldv8(vp), pk0, o[dblk]);
      o[dblk] = mfma32(ldv8(vp + 32), pk1, o[dblk]);
    }
  }
  __syncthreads();
  float* X = (float*)(g_smem + C_V);
  if (kh == 1) {
#pragma unroll
    for (int i = 0; i < 4; ++i)
#pragma unroll
      for (int r = 0; r < 16; ++r) X[(rg * 64 + i * 16 + r) * 64 + lane] = o[i][r];
  }
  {
    const int n = lane;
#pragma unroll
    for (int i = 0; i < 4; ++i) {
      const int tok = wave * 4 + i, tk = qt * 32 + tok, cur = tk >> 6;
      float imp = 0.f;
#pragma unroll
      for (int r4 = 0; r4 < 4; ++r4) { imp += Ap[(r4 * 32 + tok) * 64 + n]; if (n > 0) imp += Bp[(r4 * 32 + tok) * 64 + n - 1]; }
      const bool causal = n <= cur, forced = n == 0 || n == cur || n == cur - 1;
      const float score = causal ? (forced ? 1e6f : imp) : -1e6f;
      int rank = 0;
#pragma unroll 4
      for (int j = 0; j < 64; ++j) { const float sj = __int_as_float(__builtin_amdgcn_readlane(__float_as_int(score), j)); rank += (sj > score || (sj == score && j < n)) ? 1 : 0; }
      const unsigned long long msk = __ballot(causal && rank < 16);
      if (lane == 0) ((unsigned long long*)(ws + OFF_SEL))[(size_t)bg * 4096 + tk] = msk;
    }
  }
  __syncthreads();
  float* Tt = (float*)(g_smem + C_K);
  if (kh == 0) {
    const float gt = ((const float*)(ws + OFF_GATES))[(size_t)(b * 4096 + token) * 24 + head * 3 + 0];
    float* trow = Tt + (rg * 32 + l32) * 132;
#pragma unroll
    for (int i = 0; i < 4; ++i)
#pragma unroll
      for (int gq = 0; gq < 4; ++gq) {
        f32x4 v;
#pragma unroll
        for (int j = 0; j < 4; ++j) v[j] = (o[i][gq * 4 + j] + X[(rg * 64 + i * 16 + gq * 4 + j) * 64 + lane]) * gt;
        *(f32x4*)(trow + i * 32 + 8 * gq + 4 * hh) = v;
      }
  }
  __syncthreads();
  if (!dry) {
    float* obase = (float*)(ws + OFF_ON32) + (size_t)b * 4096 * 1024;
#pragma unroll
    for (int k = 0; k < 8; ++k) {
      const int R = wave * 16 + k * 2 + (lane >> 5), rgr = R >> 5, rr = R & 31, c4 = (lane & 31) * 4;
      float* dp = obase + (size_t)(qt * 32 + rr) * 1024 + (g * 4 + rgr) * 128 + c4;
      *(f32x4*)dp = *(const f32x4*)dp + *(const f32x4*)(Tt + R * 132 + c4);
    }
  }
  __syncthreads();
}

DI void cumsum_job(const Params& p, int bh) {
  int tid = threadIdx.x; asm volatile("" : "+v"(tid));
  const int b = bh >> 3, h = bh & 7, wave = tid >> 6, lane = tid & 63;
  const float* lf = (const float*)(p.ws + OFF_LOGF) + (size_t)b * 4096 * 8 + h;
  float* cum = (float*)(p.ws + OFF_CUM) + (size_t)bh * 4096;
  float* wt = (float*)g_smem;
  float v[8]; float s = 0.f;
#pragma unroll
  for (int i = 0; i < 8; ++i) { s += lf[(size_t)(tid * 8 + i) * 8]; v[i] = s; }
  float inc = s;
#pragma unroll
  for (int o = 1; o < 64; o <<= 1) { const float t = __shfl_up(inc, o); if (lane >= o) inc += t; }
  if (lane == 63) wt[wave] = inc;
  __syncthreads();
  float base = inc - s;
  for (int w = 0; w < wave; ++w) base += wt[w];
#pragma unroll
  for (int i = 0; i < 8; ++i) cum[tid * 8 + i] = base + v[i];
  __syncthreads();
}

DI void knorm_job(const Params& p, int j) {
  int tid = threadIdx.x; asm volatile("" : "+v"(tid));
  const int pair = tid >> 1, half = tid & 1, tl = pair >> 3, h = pair & 7;
  const bf16_t* kp = (const bf16_t*)(p.ws + OFF_KF) + (size_t)(j * 32 + tl) * 1024 + h * 128 + half * 64;
  float ss = 0.f;
#pragma unroll
  for (int i = 0; i < 8; ++i) {
    const bf16x8 v = *(const bf16x8*)(kp + i * 8);
#pragma unroll
    for (int e = 0; e < 8; ++e) { const float f = bf2f((unsigned short)v[e]); ss += f * f; }
  }
  ss += __shfl_xor(ss, 1);
  float* nr = (float*)g_smem;
  if (half == 0) nr[pair] = ss;
  __syncthreads();
  if (tid < 8) {
    float m = 0.f;
    for (int t = 0; t < 32; ++t) m = fmaxf(m, nr[t * 8 + tid]);
    ((float*)(p.ws + OFF_KNORM))[((j >> 7) * 8 + tid) * 128 + (j & 127)] = m;
  }
  __syncthreads();
}
DI void gemm1_job(const Params& p, int j) {
  char* ws = p.ws;
  GemmOp g; g.lda = 2048; g.ldb = 4096;
  if (j < 64) {
    const int pm = j >> 4, split = j & 15;
    const bf16_t* ah = (const bf16_t*)(ws + OFF_KCIN_HI) + split * 256; const bf16_t* al = (const bf16_t*)(ws + OFF_KCIN_LO) + split * 256;
    const bf16_t* bh = (const bf16_t*)(ws + OFF_W1K_HI) + split * 256; const bf16_t* bl = (const bf16_t*)(ws + OFF_W1K_LO) + split * 256;
    g.A0 = ah; g.A1 = ah; g.A2 = al; g.B0 = bh; g.B1 = bl; g.B2 = bh; g.nt = 12; g.shift = 2;
    EpiF32 e{(float*)(ws + OFF_H1P_K) + (size_t)split * 1024 * 256, 256};
    gemm_tile(g, pm * 256, 0, e);
  } else {
    const int jj = j - 64, pm = jj >> 3, split = jj & 7;
    const bf16_t* ah = (const bf16_t*)(ws + OFF_VCIN) + split * 512; const bf16_t* bh = (const bf16_t*)(ws + OFF_W1V) + split * 512;
    g.A0 = g.A1 = g.A2 = ah; g.B0 = g.B1 = g.B2 = bh; g.nt = 8; g.shift = 3;
    EpiF32 e{(float*)(ws + OFF_H1P_V) + (size_t)split * 1024 * 256, 256};
    gemm_tile(g, pm * 256, 0, e);
  }
}

DI void gemm2_job(const Params& p, int j) {
  char* ws = p.ws;
  int tid = threadIdx.x; asm volatile("" : "+v"(tid));
  const bool isv = j >= 128; const int r0 = (j & 127) * 8;
  const float* part = (const float*)(ws + (isv ? OFF_H1P_V : OFF_H1P_K));
  const float* bias = (const float*)(ws + OFF_BIAS1) + (isv ? 16 * 256 : 0);
  const float* w2 = isv ? p.w_vc2 : p.w_kc2;
  float* hs = (float*)g_smem;
  float* w2s = hs + 2048;
  float* os = w2s;
  {
    const f32x4* w2v = (const f32x4*)w2;
#pragma unroll 16
    for (int i = 0; i < 16; ++i) ((f32x4*)w2s)[tid + i * 512] = w2v[tid + i * 512];
  }
  for (int idx = tid; idx < 2048; idx += 512) {
    const int row = idx >> 8, col = idx & 255;
    float s = 0.f;
#pragma unroll
    for (int c16 = 0; c16 < 16; ++c16) s += bias[c16 * 256 + col];
    const int nsp = isv ? 8 : 16;
    for (int sp = 0; sp < nsp; ++sp) s += __builtin_nontemporal_load(part + ((size_t)sp * 1024 + r0 + row) * 256 + col);
    hs[idx] = gelu_tanh(s);
  }
  __syncthreads();
  float a0 = 0.f, a1 = 0.f;
  {
    const int col = tid & 127, rp = tid >> 7;
#pragma unroll 8
    for (int k = 0; k < 256; ++k) { const float w = w2s[k * 128 + col]; a0 += hs[(rp * 2) * 256 + k] * w; a1 += hs[(rp * 2 + 1) * 256 + k] * w; }
  }
  __syncthreads();
  { const int col = tid & 127, rp = tid >> 7; os[(rp * 2) * 128 + col] = a0; os[(rp * 2 + 1) * 128 + col] = a1; }
  __syncthreads();
  if (!isv) {
    const int row = tid >> 6, i = tid & 63;
    const int rr = r0 + row, bg = rr >> 8, n = rr & 255;
    float y1 = 0.f, y2 = 0.f;
    if (n < 255) {
      const int tk = (bg >> 1) * 4096 + 16 * n + 31;
      const float cv = ((const float*)(ws + OFF_COS))[(size_t)tk * 64 + i], sv = ((const float*)(ws + OFF_SIN))[(size_t)tk * 64 + i];
      const float x1 = os[row * 128 + i], x2 = os[row * 128 + 64 + i];
      y1 = x1 * cv - x2 * sv; y2 = x2 * cv + x1 * sv;
    }
    bf16_t* kh_ = (bf16_t*)(ws + OFF_KC_HI) + (size_t)rr * 128; bf16_t* kl_ = (bf16_t*)(ws + OFF_KC_LO) + (size_t)rr * 128;
    kh_[i] = f2bf(y1); kh_[i + 64] = f2bf(y2); kl_[i] = f2bf(lo_of(y1)); kl_[i + 64] = f2bf(lo_of(y2));
  } else {
    for (int idx = tid; idx < 1024; idx += 512) {
      const int row = idx & 7, d = idx >> 3;
      const int rr = r0 + row, bg = rr >> 8, n = rr & 255;
      ((bf16_t*)(ws + OFF_VCT))[((size_t)bg * 128 + d) * 256 + n] = n < 255 ? f2bf(os[row * 128 + d]) : (bf16_t)0;
    }
  }
  __syncthreads();
}

DI void phase3(const Params& p) {
  FOR_JOBS(job, 96) gemm1_job(p, job);
  for (int job = (int)gridDim.x - 1 - (int)blockIdx.x; job < 16; job += gridDim.x) cumsum_job(p, job);
  for (int job = (int)gridDim.x - 1 - (int)blockIdx.x; job < 256; job += gridDim.x) knorm_job(p, job);
}
DI void phase4(const Params& p, bool dry) {
  if (!dry) { FOR_JOBS(job, 256) gemm2_job(p, job); }
  unsigned* qctr = (unsigned*)(p.ws + OFF_BAR) + (dry ? 3616 : 3600);
  volatile int* qslot = (volatile int*)(g_smem + 143360 - 32);
  for (;;) {
    if (threadIdx.x == 0) *qslot = (int)__hip_atomic_fetch_add(qctr, 1u, __ATOMIC_RELAXED, __HIP_MEMORY_SCOPE_AGENT);
    __syncthreads();
    const int u = *qslot;
    __syncthreads();
    if (u >= 1024) break;
    if (u < 512) { const int qt = 31 - (u >> 4), bh = u & 15; attn_unit<0>(p, bh >> 3, bh & 7, qt, dry); }
    else { const int v = u - 512; const int qt = 127 - (v >> 2), bg = v & 3; attn_unit<1>(p, bg >> 1, bg & 1, qt, dry); }
  }
}
DI void phase5(const Params& p, bool dry) {
  FOR_JOBS(job, 512) { const int qt = job >> 2, bg = job & 3; cmp_unit(p, bg >> 1, bg & 1, qt, dry); }
}
DI void phase6(const Params& p, bool dry) {
  unsigned* qctr = (unsigned*)(p.ws + OFF_BAR) + (dry ? 3648 : 3632);
  volatile int* qslot = (volatile int*)(g_smem + 143360 - 32);
  for (;;) {
    if (threadIdx.x == 0) *qslot = (int)__hip_atomic_fetch_add(qctr, 1u, __ATOMIC_RELAXED, __HIP_MEMORY_SCOPE_AGENT);
    __syncthreads();
    const int job = *qslot;
    __syncthreads();
    if (job >= 512) break;
    const int qt = 127 - (job >> 2), bg = job & 3; attn_unit<2>(p, bg >> 1, bg & 1, qt, dry);
  }
}

DI void outproj_phase(const Params& p) {
  char* ws = p.ws;
  FOR_JOBS(job, 256) {
    const int pn = job >> 5, pm = job & 31;
    GemmOp g; g.lda = 2048; g.ldb = 2048; g.nt = 32; g.shift = 5;
    g.A0 = g.A1 = g.A2 = (const bf16_t*)(ws + OFF_U_HI); g.B0 = g.B1 = g.B2 = (const bf16_t*)(ws + OFF_WOUT);
    EpiResid e{(float*)(ws + OFF_H1), p.x, (const float*)(ws + OFF_MOD) + 4096};
    gemm_tile(g, pm * 256, pn * 256, e);
  }
}
DI void gateup_phase(const Params& p) {
  char* ws = p.ws;
  FOR_JOBS(job, 44 * 32) {
    const int pn = job >> 5, pm = job & 31;
    GemmOp g; g.lda = 2048; g.ldb = 2048; g.nt = 32; g.shift = 5;
    g.A0 = g.A1 = g.A2 = (const bf16_t*)(ws + OFF_U_HI); g.B0 = g.B1 = g.B2 = (const bf16_t*)(ws + OFF_WGU);
    EpiSwiglu e{(bf16_t*)(ws + OFF_ACT)};
    gemm_tile(g, pm * 256, pn * 256, e);
  }
}
DI void down_phase(const Params& p) {
  char* ws = p.ws;
  FOR_JOBS(job, 256) {
    const int pn = job >> 5, pm = job & 31;
    GemmOp g; g.lda = DFF; g.ldb = DFF; g.nt = 88; g.shift = 20;
    g.A0 = g.A1 = g.A2 = (const bf16_t*)(ws + OFF_ACT); g.B0 = g.B1 = g.B2 = (const bf16_t*)(ws + OFF_WDN);
    EpiResid e{p.out, (const float*)(ws + OFF_H1), (const float*)(ws + OFF_MOD) + 10240};
    gemm_tile(g, pm * 256, pn * 256, e);
  }
}


#define XB_TMO      128
#define XB_XCNT(j)  (256  + 64 * (j))
#define XB_XSUB(j)  (1280 + 64 * (j))
#define XB_XGEN(j)  (2304 + 64 * (j))
#define XB_TOP      3328
#define XB_TOPGEN   3392
#define XCD_BAR_WORDS 3456
#define XB_SPIN_CAP (1u << 22)
#define LAS __attribute__((address_space(3)))
constexpr int LDS_BAR_OFF = 143360 - 16;
DI unsigned xb_ld(unsigned* p) { return __hip_atomic_load(p, __ATOMIC_RELAXED, __HIP_MEMORY_SCOPE_AGENT); }
DI unsigned xb_add(unsigned* p, unsigned v) { return __hip_atomic_fetch_add(p, v, __ATOMIC_RELAXED, __HIP_MEMORY_SCOPE_AGENT); }
DI unsigned xb_xcc_id() { return (unsigned)__builtin_amdgcn_s_getreg((3 << 11) | 20) & 0xFu; }
#define XB_SPIN(cond, bar) do { unsigned _sp = 0; while (cond) { __builtin_amdgcn_s_sleep(1); \
    if ((++_sp & 255u) == 0u) { if (xb_ld(&(bar)[XB_TMO])) break; if (_sp > XB_SPIN_CAP) { atomicAdd(&(bar)[XB_TMO], 1u); break; } } } } while (0)
struct XcdBarrier { unsigned* bar; unsigned x; volatile LAS unsigned* st; };
DI XcdBarrier xcd_barrier_post(unsigned* bar, volatile LAS unsigned* st) {
  XcdBarrier b; b.bar = bar; b.x = xb_xcc_id(); b.st = st;
  if (threadIdx.x == 0) (void)xb_add(&bar[XB_XCNT(b.x)], 1u);
  return b;
}
DI void xcd_barrier_complete(unsigned* bar, unsigned x, unsigned& nloc, unsigned& nx) {
  const unsigned G = gridDim.x * gridDim.y * gridDim.z;
  unsigned sum, cnt, mine, sp = 0u;
  for (;;) {
    sum = 0u; cnt = 0u; mine = 0u;
#pragma unroll
    for (unsigned j = 0; j < 16; ++j) { const unsigned c = xb_ld(&bar[XB_XCNT(j)]); sum += c; cnt += (c > 0u) ? 1u : 0u; mine = (j == x) ? c : mine; }
    if (sum == G) break;
    __builtin_amdgcn_s_sleep(1);
    if ((++sp & 255u) == 0u) { if (xb_ld(&bar[XB_TMO])) break; if (sp > XB_SPIN_CAP) { atomicAdd(&bar[XB_TMO], 1u); break; } }
  }
  nloc = mine > 0u ? mine : 1u; nx = cnt > 0u ? cnt : 1u;
}
DI void xcd_barrier(const XcdBarrier& b) {
  asm volatile("s_waitcnt vmcnt(0)" ::: "memory");
  __syncthreads();
  if (threadIdx.x == 0) {
    unsigned* bar = b.bar;
    __builtin_amdgcn_s_waitcnt(0);
    unsigned nloc = b.st[0], nx = b.st[1];
    if (nloc == 0u) { xcd_barrier_complete(bar, b.x, nloc, nx); b.st[0] = nloc; b.st[1] = nx; }
    const unsigned old = xb_add(&bar[XB_XSUB(b.x)], 1u);
    const unsigned gen = old / nloc;
    if (old + 1u == (gen + 1u) * nloc) {
      __builtin_amdgcn_fence(__ATOMIC_RELEASE, "agent");
      asm volatile("s_waitcnt vmcnt(0)" ::: "memory");
      const unsigned og = xb_add(&bar[XB_TOP], 1u);
      const unsigned tg = og / nx;
      if (og + 1u == (tg + 1u) * nx) xb_add(&bar[XB_TOPGEN], 1u);
      else XB_SPIN(xb_ld(&bar[XB_TOPGEN]) == tg, bar);
      __builtin_amdgcn_fence(__ATOMIC_ACQUIRE, "agent");
      xb_add(&bar[XB_XGEN(b.x)], 1u);
      asm volatile("s_waitcnt vmcnt(0)" ::: "memory");
    } else {
      XB_SPIN(xb_ld(&bar[XB_XGEN(b.x)]) == gen, bar);
      __builtin_amdgcn_fence(__ATOMIC_ACQUIRE, "agent");
      asm volatile("s_waitcnt vmcnt(0)" ::: "memory");
    }
  }
  __syncthreads();
}

#ifdef ONLY_PHASE
#define PH_ON(k) ((k) == ONLY_PHASE)
#else
#define PH_ON(k) 1
#endif
#ifndef REP_MASK
#define REP_MASK 0
#endif
#define RUN_PHASE(k, call) do { if (PH_ON(k) && ph0 <= (k) && (k) < ph1) { \
    _Pragma("unroll 1") for (int _r = 0; _r <= ((REP_MASK >> (k)) & 1); ++_r) { const bool _dry = ((REP_MASK >> (k)) & 1) && _r == 0; (void)_dry; if ((k) > ph0 || _r) GRID_SYNC(); call; } } } while (0)
#ifndef NSYNC_EXTRA
#define NSYNC_EXTRA 0
#endif
#define GRID_SYNC() xcd_barrier(xb)
__global__ void __launch_bounds__(512) hymba_mega(Params p, int ph0, int ph1) {
  volatile LAS unsigned* xst = (volatile LAS unsigned*)(g_smem + LDS_BAR_OFF);
  if (threadIdx.x == 0) { xst[0] = 0u; xst[1] = 0u; }
  __syncthreads();
  const XcdBarrier xb = xcd_barrier_post((unsigned*)(p.ws + OFF_BAR), xst);
  if (ph1 > 1000) cg::this_grid().sync();
  RUN_PHASE(0, phase0(p));
  RUN_PHASE(1, rmsmod_phase(p.x, p.norm_attn, (const float*)(p.ws + OFF_MOD), 0, 2048, (bf16_t*)(p.ws + OFF_U_HI), (bf16_t*)(p.ws + OFF_U_LO), true));
  RUN_PHASE(2, inproj_phase(p, _dry));
  RUN_PHASE(3, phase3(p));
  RUN_PHASE(4, phase4(p, _dry));
  RUN_PHASE(5, phase5(p, _dry));
  RUN_PHASE(6, phase6(p, _dry));
  RUN_PHASE(7, ymix_phase(p));
  RUN_PHASE(8, outproj_phase(p));
  RUN_PHASE(9, rmsmod_phase((const float*)(p.ws + OFF_H1), p.norm_ffn, (const float*)(p.ws + OFF_MOD), 6144, 8192, (bf16_t*)(p.ws + OFF_U_HI), nullptr, true));
  RUN_PHASE(10, gateup_phase(p));
  RUN_PHASE(11, down_phase(p));
  RUN_PHASE(12, final_phase(p));
  _Pragma("unroll 1") for (int i = 0; i < NSYNC_EXTRA; ++i) GRID_SYNC();
}

extern "C" void kernel_launch(void* const* d_in, const int* in_sizes, int n_in, void* d_out, int out_size, void* d_ws, size_t ws_size,
                              hipStream_t stream) {
  Params p{};
  p.x = (const float*)d_in[0]; p.c = (const float*)d_in[1]; p.pos = (const int*)d_in[2];
  p.w_ada = (const float*)d_in[3]; p.b_ada = (const float*)d_in[4]; p.norm_attn = (const float*)d_in[5]; p.norm_ffn = (const float*)d_in[6];
  p.w_in = (const float*)d_in[7]; p.b_fgate = (const float*)d_in[8]; p.cmp_pos = (const float*)d_in[9];
  p.w_kc1 = (const float*)d_in[10]; p.w_kc2 = (const float*)d_in[11]; p.w_vc1 = (const float*)d_in[12]; p.w_vc2 = (const float*)d_in[13];
  p.beta_fox = (const float*)d_in[14]; p.beta_nsa = (const float*)d_in[15]; p.w_out = (const float*)d_in[16];
  p.w_gate = (const float*)d_in[17]; p.w_up = (const float*)d_in[18]; p.w_down = (const float*)d_in[19]; p.final_norm = (const float*)d_in[20];
  p.out = (float*)d_out; p.ws = (char*)d_ws;
  static int grid_blocks = 0;
  if (!grid_blocks) {
    hipFuncSetAttribute((const void*)hymba_mega, hipFuncAttributeMaxDynamicSharedMemorySize, LDS_BYTES);
    int dev = 0, cus = 0, per_cu = 0;
    hipGetDevice(&dev);
    hipDeviceGetAttribute(&cus, hipDeviceAttributeMultiprocessorCount, dev);
    hipOccupancyMaxActiveBlocksPerMultiprocessor(&per_cu, hymba_mega, 512, LDS_BYTES);
    if (per_cu < 1) per_cu = 1;
    grid_blocks = cus * per_cu;
    if (ws_size < WS_END) fprintf(stderr, "workspace too small: %zu < %zu\n", ws_size, (size_t)WS_END);
  }
  hipMemsetAsync((char*)d_ws + OFF_BAR, 0, 16384, stream);
#if N_LAUNCH_MODE == 1
  int ph0 = 0, ph1 = NPH;
  void* args[] = {&p, &ph0, &ph1};
  hipError_t e = hipLaunchCooperativeKernel((const void*)hymba_mega, dim3(grid_blocks), dim3(512), args, LDS_BYTES, stream);
  if (e != hipSuccess) fprintf(stderr, "cooperative launch failed: %s (grid %d)\n", hipGetErrorString(e), grid_blocks);
#else
  for (int ph = 0; ph < NPH; ++ph) hipLaunchKernelGGL(hymba_mega, dim3(grid_blocks), dim3(512), LDS_BYTES, stream, p, ph, ph + 1);
#endif
}
```
